# Optimizing an MI355X kernel written in HIP

```python
import math
import jax
import jax.numpy as jnp
from jax import lax
import numpy as np

D_MODEL = 2048
BATCH = 2
SEQ = 16384
DEPTH = 2

MEM_LEN = 256
HALF_MIX = D_MODEL // 2
MIX_WIDTH = 2 * HALF_MIX
IN_WIDTH = 5 * HALF_MIX
DIFF_HEADS = 4
DIFF_HEAD_DIM = HALF_MIX // (2 * DIFF_HEADS)
DIFF_V_DIM = 2 * DIFF_HEAD_DIM
ROPE_DIM = DIFF_HEAD_DIM // 4
ROPE_THETA = 500000.0
Q_BLOCK = 128
CONF_WIDTH = HALF_MIX
CONF_KERNEL = 31
SGU_WIDTH = HALF_MIX
SGU_GROUPS = 4
SGU_GROUP_DIM = SGU_WIDTH // SGU_GROUPS
SGU_CHUNK = 128
SC_WIDTH = HALF_MIX
SC_KERNEL = 3
CROSS_HEADS = 4
CROSS_HEAD_DIM = 128
CROSS_WIDTH = CROSS_HEADS * CROSS_HEAD_DIM
N_GROUPS = 4
EXPERTS_PER_GROUP = 8
N_EXPERTS = N_GROUPS * EXPERTS_PER_GROUP
TOP_K = 2
EXPERT_FF = D_MODEL // 4
MOE_BLOCK = 128
N_EVEN = (DEPTH + 1) // 2
N_ODD = DEPTH // 2
ALPHA = (2 * DEPTH) ** 0.25
BETA = (8 * DEPTH) ** -0.25
LN_EPS = 1e-5

kernel_name = 'hybrid_diffattn_conformer_sgu_shortconv_hmoe'


def layer_norm(x, g, b):
    xf = x.astype(jnp.float32)
    mu = jnp.mean(xf, axis=-1, keepdims=True)
    var = jnp.mean(jnp.square(xf - mu), axis=-1, keepdims=True)
    y = (xf - mu) * lax.rsqrt(var + LN_EPS) * g.astype(jnp.float32) + b.astype(jnp.float32)
    return y.astype(x.dtype)


def rms_norm(x, g):
    xf = x.astype(jnp.float32)
    y = xf * lax.rsqrt(jnp.mean(jnp.square(xf), axis=-1, keepdims=True) + LN_EPS) * g.astype(jnp.float32)
    return y.astype(x.dtype)


def rope_tables(positions, dtype):
    inv_freq = ROPE_THETA ** (-jnp.arange(0, ROPE_DIM, 2, dtype=jnp.float32) / ROPE_DIM)
    ang = positions.astype(jnp.float32)[..., None] * inv_freq
    return jnp.cos(ang)[:, :, None, :].astype(dtype), jnp.sin(ang)[:, :, None, :].astype(dtype)


def partial_rope(t, cos, sin):
    half = ROPE_DIM // 2
    t1 = t[..., :half]
    t2 = t[..., half:ROPE_DIM]
    return jnp.concatenate([t1 * cos - t2 * sin, t2 * cos + t1 * sin, t[..., ROPE_DIM:]], axis=-1)


def causal_depthwise_conv(x, w):
    k = w.shape[0]
    xp = jnp.pad(x, ((0, 0), (k - 1, 0), (0, 0)))
    return lax.conv_general_dilated(xp, w[:, None, :].astype(x.dtype), window_strides=(1,), padding='VALID',
                                    dimension_numbers=('NWC', 'WIO', 'NWC'), feature_group_count=x.shape[-1])


def diff_attention(q1, q2, k1, k2, v, lam):
    bsz, heads, seq, dh = q1.shape
    nb = seq // Q_BLOCK
    scale = dh ** -0.5
    kpos = jnp.arange(seq)

    def to_blocks(q):
        return q.reshape(bsz, heads, nb, Q_BLOCK, dh).transpose(2, 0, 1, 3, 4)

    def one_block(args):
        i, a1, a2 = args
        qpos = i * Q_BLOCK + jnp.arange(Q_BLOCK)
        mask = kpos[None, :] <= qpos[:, None]

        def attn_map(a, k):
            s = jnp.einsum('bhqd,bhkd->bhqk', a, k).astype(jnp.float32) * scale
            return jax.nn.softmax(jnp.where(mask, s, -jnp.inf), axis=-1)

        p = attn_map(a1, k1) - lam * attn_map(a2, k2)
        return jnp.einsum('bhqk,bhkd->bhqd', p.astype(v.dtype), v)

    out = lax.map(one_block, (jnp.arange(nb), to_blocks(q1), to_blocks(q2)))
    return out.transpose(1, 2, 0, 3, 4).reshape(bsz, heads, seq, v.shape[-1])


def even_mixer(h, cos, sin, layer_idx, lq1, lk1, lq2, lk2, subln_g, conv_w, conv_b, cln_g, cln_b):
    bsz, seq, _ = h.shape
    hd = DIFF_HEADS
    q = h[..., 0:HALF_MIX].reshape(bsz, seq, 2 * hd, DIFF_HEAD_DIM)
    k = h[..., HALF_MIX:2 * HALF_MIX].reshape(bsz, seq, 2 * hd, DIFF_HEAD_DIM)
    v = h[..., 2 * HALF_MIX:3 * HALF_MIX].reshape(bsz, seq, hd, DIFF_V_DIM).transpose(0, 2, 1, 3)
    glu_in = h[..., 3 * HALF_MIX:]

    def split_maps(t):
        t = partial_rope(t, cos, sin).transpose(0, 2, 1, 3).reshape(bsz, hd, 2, seq, DIFF_HEAD_DIM)
        return t[:, :, 0], t[:, :, 1]

    q1, q2 = split_maps(q)
    k1, k2 = split_maps(k)
    lam_init = 0.8 - 0.6 * math.exp(-0.3 * layer_idx)
    lam = (jnp.exp(jnp.sum(lq1.astype(jnp.float32) * lk1.astype(jnp.float32)))
           - jnp.exp(jnp.sum(lq2.astype(jnp.float32) * lk2.astype(jnp.float32))) + lam_init)
    o = diff_attention(q1, q2, k1, k2, v, lam)
    o = rms_norm(o, subln_g) * (1.0 - lam_init)
    o = o.transpose(0, 2, 1, 3).reshape(bsz, seq, hd * DIFF_V_DIM)
    a, g = jnp.split(glu_in, 2, axis=-1)
    c = a * jax.nn.sigmoid(g)
    c = causal_depthwise_conv(c, conv_w) + conv_b.astype(c.dtype)
    c = jax.nn.silu(layer_norm(c, cln_g, cln_b))
    return jnp.concatenate([o, c], axis=-1)


def odd_mixer(h, ln_g, ln_b, sgu_w, sgu_b, sc_w):
    bsz, seq, _ = h.shape
    nc = seq // SGU_CHUNK
    z = jax.nn.gelu(h[..., :2 * SGU_WIDTH], approximate=False)
    u, vg = jnp.split(z, 2, axis=-1)
    vg = layer_norm(vg, ln_g, ln_b).reshape(bsz, nc, SGU_CHUNK, SGU_GROUPS, SGU_GROUP_DIM)
    w_causal = sgu_w * jnp.tril(jnp.ones((SGU_CHUNK, SGU_CHUNK), sgu_w.dtype))
    sv = jnp.einsum('gts,bnsgc->bntgc', w_causal, vg) + sgu_b.T[:, :, None].astype(vg.dtype)
    spatial = u * sv.reshape(bsz, seq, SGU_WIDTH)
    gb, gc, xin = jnp.split(h[..., 2 * SGU_WIDTH:], 3, axis=-1)
    conv = gb * causal_depthwise_conv(gc * xin, sc_w)
    return jnp.concatenate([spatial, conv], axis=-1)


def memory_cross_attention(x, mem_k, mem_v, wq, wo):
    bsz, seq, _ = x.shape
    q = (x @ wq).reshape(bsz, seq, CROSS_HEADS, CROSS_HEAD_DIM)
    s = jnp.einsum('bshd,bmhd->bhsm', q, mem_k).astype(jnp.float32) * CROSS_HEAD_DIM ** -0.5
    p = jax.nn.softmax(s, axis=-1).astype(x.dtype)
    o = jnp.einsum('bhsm,bmhd->bshd', p, mem_v).reshape(bsz, seq, CROSS_WIDTH)
    return o @ wo


def hier_moe(x, rg_w, rg_b, re_w, re_b, w1, w3, w2):
    bsz, seq, d = x.shape
    xt = x.reshape(-1, d)
    n_tok = xt.shape[0]
    g_logits = (xt @ rg_w + rg_b).astype(jnp.float32)
    grp = jnp.argmax(g_logits, axis=-1)
    g_gate = jnp.take_along_axis(jax.nn.softmax(g_logits, axis=-1), grp[:, None], axis=1)[:, 0]
    e_logits = (xt @ re_w + re_b).astype(jnp.float32).reshape(n_tok, N_GROUPS, EXPERTS_PER_GROUP)
    e_logits = jnp.take_along_axis(e_logits, grp[:, None, None], axis=1)[:, 0]
    top_v, top_i = lax.top_k(e_logits, TOP_K)
    gate = jax.nn.softmax(top_v, axis=-1) * g_gate[:, None]
    eid = (grp[:, None] * EXPERTS_PER_GROUP + top_i).reshape(-1).astype(jnp.int32)
    n_assign = eid.shape[0]
    tok = jnp.repeat(jnp.arange(n_tok, dtype=jnp.int32), TOP_K)
    wgt = gate.reshape(-1)
    order = jnp.argsort(eid, stable=True)
    se, stok, sw = eid[order], tok[order], wgt[order]
    counts = jnp.bincount(eid, length=N_EXPERTS)
    padded = (counts + MOE_BLOCK - 1) // MOE_BLOCK * MOE_BLOCK
    start = jnp.cumsum(counts) - counts
    pend = jnp.cumsum(padded)
    pstart = pend - padded
    dest = pstart[se] + jnp.arange(n_assign, dtype=jnp.int32) - start[se]
    n_blocks = -(-n_assign // MOE_BLOCK) + N_EXPERTS
    buf_tok = jnp.zeros((n_blocks * MOE_BLOCK,), jnp.int32).at[dest].set(stok)
    buf_w = jnp.zeros((n_blocks * MOE_BLOCK,), jnp.float32).at[dest].set(sw)
    blk_e = jnp.minimum(jnp.searchsorted(pend, jnp.arange(n_blocks, dtype=jnp.int32) * MOE_BLOCK, side='right'),
                        N_EXPERTS - 1)

    def run(args):
        e, ti, wi = args
        xb = xt[ti]
        hb = jax.nn.silu(xb @ w1[e]) * (xb @ w3[e])
        return (hb @ w2[e]) * wi[:, None].astype(xb.dtype)

    y = lax.map(run, (blk_e, buf_tok.reshape(n_blocks, MOE_BLOCK), buf_w.reshape(n_blocks, MOE_BLOCK)))
    out = jax.ops.segment_sum(y.reshape(-1, d), buf_tok, num_segments=n_tok)
    return out.reshape(bsz, seq, d)


def setup_inputs(seed: int = 0) -> dict:
    key = jax.random.key(seed)
    ks = iter(jax.random.split(key, 40))

    def nrm(shape, scale):
        return jax.random.normal(next(ks), shape, jnp.float32) * scale

    L = DEPTH
    x = nrm((BATCH, SEQ, D_MODEL), 1.0)
    mem = nrm((BATCH, MEM_LEN, D_MODEL), 1.0)
    positions = (jax.random.randint(next(ks), (BATCH, 1), 0, 4096, jnp.int32)
                 + jnp.arange(SEQ, dtype=jnp.int32)[None, :])
    w_in = nrm((L, D_MODEL, IN_WIDTH), D_MODEL ** -0.5)
    w_in = w_in.at[0::2, :, 2 * HALF_MIX:3 * HALF_MIX].multiply(BETA)
    w_out = nrm((L, MIX_WIDTH, D_MODEL), BETA * MIX_WIDTH ** -0.5)
    ln_mix_g = 1.0 + nrm((L, D_MODEL), 0.02)
    ln_mix_b = nrm((L, D_MODEL), 0.02)
    ln_mem_g = 1.0 + nrm((L, D_MODEL), 0.02)
    ln_mem_b = nrm((L, D_MODEL), 0.02)
    ln_ffn_g = 1.0 + nrm((L, D_MODEL), 0.02)
    ln_ffn_b = nrm((L, D_MODEL), 0.02)
    lam_q1 = nrm((N_EVEN, DIFF_HEAD_DIM), 0.1)
    lam_k1 = nrm((N_EVEN, DIFF_HEAD_DIM), 0.1)
    lam_q2 = nrm((N_EVEN, DIFF_HEAD_DIM), 0.1)
    lam_k2 = nrm((N_EVEN, DIFF_HEAD_DIM), 0.1)
    diff_subln_g = 1.0 + nrm((N_EVEN, DIFF_V_DIM), 0.02)
    conv_w = nrm((N_EVEN, CONF_KERNEL, CONF_WIDTH), CONF_KERNEL ** -0.5)
    conv_b = nrm((N_EVEN, CONF_WIDTH), 0.02)
    conv_ln_g = 1.0 + nrm((N_EVEN, CONF_WIDTH), 0.02)
    conv_ln_b = nrm((N_EVEN, CONF_WIDTH), 0.02)
    sgu_ln_g = 1.0 + nrm((N_ODD, SGU_WIDTH), 0.02)
    sgu_ln_b = nrm((N_ODD, SGU_WIDTH), 0.02)
    sgu_w = nrm((N_ODD, SGU_GROUPS, SGU_CHUNK, SGU_CHUNK), SGU_CHUNK ** -0.5)
    sgu_b = 1.0 + nrm((N_ODD, SGU_GROUPS, SGU_CHUNK), 0.02)
    sc_w = nrm((N_ODD, SC_KERNEL, SC_WIDTH), SC_KERNEL ** -0.5)
    mem_kv_w = nrm((D_MODEL, 2 * CROSS_WIDTH), D_MODEL ** -0.5)
    mem_kv_w = mem_kv_w.at[:, CROSS_WIDTH:].multiply(BETA)
    xq_w = nrm((L, D_MODEL, CROSS_WIDTH), D_MODEL ** -0.5)
    xo_w = nrm((L, CROSS_WIDTH, D_MODEL), BETA * CROSS_WIDTH ** -0.5)
    rg_w = nrm((L, D_MODEL, N_GROUPS), D_MODEL ** -0.5)
    rg_b = nrm((L, N_GROUPS), 0.01)
    re_w = nrm((L, D_MODEL, N_EXPERTS), D_MODEL ** -0.5)
    re_b = nrm((L, N_EXPERTS), 0.01)
    e_w1 = nrm((L, N_EXPERTS, D_MODEL, EXPERT_FF), D_MODEL ** -0.5)
    e_w3 = nrm((L, N_EXPERTS, D_MODEL, EXPERT_FF), D_MODEL ** -0.5)
    e_w2 = nrm((L, N_EXPERTS, EXPERT_FF, D_MODEL), BETA * EXPERT_FF ** -0.5)
    return {'x': x, 'mem': mem, 'positions': positions, 'w_in': w_in, 'w_out': w_out,
            'ln_mix_g': ln_mix_g, 'ln_mix_b': ln_mix_b, 'ln_mem_g': ln_mem_g, 'ln_mem_b': ln_mem_b,
            'ln_ffn_g': ln_ffn_g, 'ln_ffn_b': ln_ffn_b,
            'lam_q1': lam_q1, 'lam_k1': lam_k1, 'lam_q2': lam_q2, 'lam_k2': lam_k2, 'diff_subln_g': diff_subln_g,
            'conv_w': conv_w, 'conv_b': conv_b, 'conv_ln_g': conv_ln_g, 'conv_ln_b': conv_ln_b,
            'sgu_ln_g': sgu_ln_g, 'sgu_ln_b': sgu_ln_b, 'sgu_w': sgu_w, 'sgu_b': sgu_b, 'sc_w': sc_w,
            'mem_kv_w': mem_kv_w, 'xq_w': xq_w, 'xo_w': xo_w,
            'rg_w': rg_w, 'rg_b': rg_b, 're_w': re_w, 're_b': re_b, 'e_w1': e_w1, 'e_w3': e_w3, 'e_w2': e_w2}


def reference(x, mem, positions, w_in, w_out, ln_mix_g, ln_mix_b, ln_mem_g, ln_mem_b, ln_ffn_g, ln_ffn_b,
              lam_q1, lam_k1, lam_q2, lam_k2, diff_subln_g, conv_w, conv_b, conv_ln_g, conv_ln_b,
              sgu_ln_g, sgu_ln_b, sgu_w, sgu_b, sc_w, mem_kv_w, xq_w, xo_w,
              rg_w, rg_b, re_w, re_b, e_w1, e_w3, e_w2):
    bsz = x.shape[0]
    n_mem = mem.shape[1]
    cos, sin = rope_tables(positions, x.dtype)
    kv = (mem @ mem_kv_w).reshape(bsz, n_mem, 2, CROSS_HEADS, CROSS_HEAD_DIM)
    mem_k, mem_v = kv[:, :, 0], kv[:, :, 1]
    for l in range(DEPTH):
        h = x @ w_in[l]
        j = l // 2
        if l % 2 == 0:
            mix = even_mixer(h, cos, sin, l, lam_q1[j], lam_k1[j], lam_q2[j], lam_k2[j], diff_subln_g[j],
                             conv_w[j], conv_b[j], conv_ln_g[j], conv_ln_b[j])
        else:
            mix = odd_mixer(h, sgu_ln_g[j], sgu_ln_b[j], sgu_w[j], sgu_b[j], sc_w[j])
        x = layer_norm(ALPHA * x + mix @ w_out[l], ln_mix_g[l], ln_mix_b[l])
        x = layer_norm(ALPHA * x + memory_cross_attention(x, mem_k, mem_v, xq_w[l], xo_w[l]),
                       ln_mem_g[l], ln_mem_b[l])
        x = layer_norm(ALPHA * x + hier_moe(x, rg_w[l], rg_b[l], re_w[l], re_b[l], e_w1[l], e_w3[l], e_w2[l]),
                       ln_ffn_g[l], ln_ffn_b[l])
    return x
```

```cpp
#define DUPMASK (0)
#include <hip/hip_runtime.h>
#include <hip/hip_bf16.h>
#include <cstdio>
#include <cstdint>
#include <cmath>

namespace pg8 {
#define PG8_LAS __attribute__((address_space(3)))
typedef unsigned short bf16_t;
typedef short bf16x8 __attribute__((ext_vector_type(8)));
typedef float f32x4 __attribute__((ext_vector_type(4)));
typedef float f32x2 __attribute__((ext_vector_type(2)));
typedef unsigned u32x4 __attribute__((ext_vector_type(4)));
constexpr int BM = 256, BK = 64, HALF = 128, HTB = HALF * BK * 2  , STAGE_BYTES = 8 * HTB, NXCD = 8, WGM = 8;

__host__ __device__ __forceinline__ int lds_byte(int r, int c) { const int st = (r >> 4) * 2 + (c >> 5), rr = r & 15, cc = c & 31, ob = rr * 64 + cc * 2; return st * 1024 + (ob ^ (((ob >> 9) & 1) << 5)); }
__host__ __device__ __forceinline__ void stage_rc(int b, int& R, int& C) { const int st = b / 1024, sb = b % 1024, swz = sb ^ (((sb >> 9) & 1) << 5); R = (st >> 1) * 16 + swz / 64; C = (st & 1) * 32 + (swz % 64) / 2; }
__host__ __device__ __forceinline__ int perm32(int rho) { const int n = rho >> 4, i = rho & 15; return 8 * (i >> 2) + 4 * n + (i & 3); }

struct Unit { int pm, pn, pb, ko; };
struct Gemm { const bf16_t* A; const bf16_t* Bt; int M, N, K, ld; };

struct StaticOrder {
    int nM, nN, nwg, G, c, skip_lo = 1 << 30, skip_n = 0;
    __host__ __device__ void init(int M, int N, int G_, int c_) { nM = M / BM; nN = N / BM; nwg = nM * nN; G = G_; c = c_; }
    __host__ __device__ __forceinline__ bool next(int i, Unit& u) const {
        const long L = (long)i * G + c; if (L >= nwg) return false;
        int wgid = (int)L; { const int q = nwg / NXCD, r = nwg % NXCD, xcd = wgid % NXCD, off = wgid / NXCD; wgid = (xcd < r ? xcd * (q + 1) : r * (q + 1) + (xcd - r) * q) + off; }
        const int nig = WGM * nN, gid = wgid / nig, fm = gid * WGM, gsz = (nM - fm) < WGM ? (nM - fm) : WGM;
        u.pm = fm + ((wgid % nig) % gsz); u.pn = (wgid % nig) / gsz; if (u.pn >= skip_lo) u.pn += skip_n; u.pb = u.pn; u.ko = 0; return true;
    }
    __device__ __forceinline__ void a_ready(const Unit&) const {}
    __device__ __forceinline__ void done(const Unit&) const {}
};
struct SplitK2Order {
    int nM, G, c, khalf;
    __device__ __forceinline__ bool next(int i, Unit& u) const { const int L = i * G + c; if (L >= 2 * nM) return false; u.pm = L >> 1; u.pn = L & 1; u.pb = 0; u.ko = (L & 1) * khalf; return true; }
    __device__ __forceinline__ void a_ready(const Unit&) const {}
    __device__ __forceinline__ void done(const Unit&) const {}
};
struct MoeOrder {
    const int* tile_e; int n_units, NT, G, c; const PG8_LAS int* rtab;
    __device__ __forceinline__ bool next(int i, Unit& u) const {
        int rt, pn;
        if (G % (8 * NT) == 0) { const int x = c & 7, k = c >> 3, per_x = (G >> 3) / NT; rt = i * (G / NT) + x * per_x + k / NT; pn = k % NT; if (rt * NT >= n_units) return false; }
        else { const long L = (long)i * G + c; if (L >= n_units) return false; rt = (int)L / NT; pn = (int)L % NT; }
        u.pm = rt; u.pn = pn; u.pb = tile_e[rt] * NT + pn; u.ko = 0; return true;
    }
    __device__ __forceinline__ void a_ready(const Unit&) const {}
    __device__ __forceinline__ void done(const Unit&) const {}
};

struct MoeOrder1H {
    const int* tile_e; int ntile, G, c; const PG8_LAS int* rtab; unsigned* cnt; unsigned* full;
    __device__ __forceinline__ bool next(int i, Unit& u) const {
        int rt, pn;
        if (G == 256) { const int x = c & 7, k = c >> 3, R1 = ntile >> 6, rem = ntile & 63;
            if (i < R1) rt = i * 64 + x * 8 + (k >> 2);
            else if (i == R1) { const int j = (k >> 2) * 8 + x; if (j >= rem) return false; rt = R1 * 64 + j; }
            else return false;
            pn = k & 3; }
        else { const long L = (long)i * G + c; if (L >= (long)ntile * 4) return false; rt = (int)(L >> 2); pn = (int)(L & 3); }
        u.pm = rt; u.pn = pn; u.pb = tile_e[rt] * 4 + pn; u.ko = 0; return true; }
    __device__ __forceinline__ void a_ready(const Unit&) const {}
    __device__ __forceinline__ void done(const Unit& u) const {
        asm volatile("s_waitcnt vmcnt(0)" ::: "memory");
        if ((threadIdx.x & 63) == 0) { (void)__hip_atomic_fetch_add(cnt + 64 * u.pm, 1u, __ATOMIC_RELAXED, __HIP_MEMORY_SCOPE_AGENT);
            if (G == 256 && (u.pm >> 6) == (ntile >> 6) - 1) (void)__hip_atomic_fetch_add(full + 64 * (c & 7), 1u, __ATOMIC_RELAXED, __HIP_MEMORY_SCOPE_AGENT); } }
};
struct MoeOrder2H {
    const int* tile_e; int ntile, G, c; unsigned* cnt; unsigned need; unsigned* full; mutable bool fd = false;
    __device__ __forceinline__ bool next(int i, Unit& u) const {
        int rt, pn;
        if (G == 256) { const int x = c & 7, k = c >> 3, R1 = ntile >> 6, rem = ntile & 63;
            int ntx = rem > x ? (rem - x + 7) >> 3 : 0; if (ntx > 7) ntx = 0;
            const int U = 8 * (8 * R1 + ntx), Hc = 4 * ntx, Lc = 32 - Hc;
            int ra = (U - 2 * Lc) >> 5; if (ra < 0) ra = 0;
            int idx;
            if (i < ra) idx = i * 32 + k; else { if (k < Hc) return false; idx = ra * 32 + (i - ra) * Lc + (k - Hc); }
            if (idx >= U) return false;
            const int rp = idx >> 3; pn = idx & 7;
            rt = rp < 8 * R1 ? ((rp >> 3) * 64 + x * 8 + (rp & 7)) : (R1 * 64 + (rp - 8 * R1) * 8 + x); }
        else { const long L = (long)i * G + c; if (L >= (long)ntile * 8) return false; rt = (int)(L >> 3); pn = (int)(L & 7); }
        u.pm = rt; u.pn = pn; u.pb = tile_e[rt] * 8 + pn; u.ko = 0; return true; }
#ifdef HO_NOWAIT
    __device__ __forceinline__ void a_ready(const Unit&) const {}
#else
    __device__ __forceinline__ void a_ready(const Unit& u) const {
        const bool fr_ = (G == 256) && u.pm < ((ntile >> 6) << 6);
        if (fr_ && fd) return;
        const unsigned* w_ = fr_ ? full + 64 * (c & 7) : cnt + 64 * u.pm; const unsigned nd_ = fr_ ? 256u : need;
        if (threadIdx.x < 64) { unsigned polls = 0;
            while ((unsigned)__builtin_amdgcn_readfirstlane(__hip_atomic_load(w_, __ATOMIC_RELAXED, __HIP_MEMORY_SCOPE_AGENT)) < nd_) {
                __builtin_amdgcn_s_sleep(2); if (++polls > (1u << 22)) break; }
            __builtin_amdgcn_fence(__ATOMIC_ACQUIRE, "agent");
            asm volatile("s_waitcnt vmcnt(0)" ::: "memory"); }
        asm volatile("" ::: "memory"); __builtin_amdgcn_s_barrier(); asm volatile("" ::: "memory");
        if (fr_) fd = true; }
#endif
    __device__ __forceinline__ void done(const Unit&) const {}
};

__device__ __forceinline__ unsigned cvt_pk_bf16(float lo, float hi) { unsigned r; asm volatile("v_cvt_pk_bf16_f32 %0, %1, %2" : "=v"(r) : "v"(lo), "v"(hi)); return r; }
__device__ __forceinline__ float bf_lo(unsigned w) { return __uint_as_float(w << 16); }
__device__ __forceinline__ float bf_hi(unsigned w) { return __uint_as_float(w & 0xffff0000u); }
__device__ __forceinline__ f32x2 gelu_pk(f32x2 v) {
    const f32x2 av = __builtin_elementwise_abs(v), d = av * 0.2316418882f + 1.0f;
    f32x2 t; t.x = __builtin_amdgcn_rcpf(d.x); t.y = __builtin_amdgcn_rcpf(d.y);
    f32x2 q = t * 0.5307027145f + (-0.7265760135f); q = q * t + 0.7107068705f; q = q * t + (-0.142248368f); q = q * t + 0.127414796f; q = q * t;
    const f32x2 s = (v * v) * (-0.72134752044f);
    f32x2 e; e.x = __builtin_amdgcn_exp2f(s.x); e.y = __builtin_amdgcn_exp2f(s.y);
    const f32x2 m = v * (q * e), r = v - m;
    f32x2 o; o.x = v.x < 0.f ? m.x : r.x; o.y = v.y < 0.f ? m.y : r.y; return o;
}
__device__ __forceinline__ float silu_f(float x) { return x * __builtin_amdgcn_rcpf(1.0f + __builtin_amdgcn_exp2f(-1.4426950408889634f * x)); }

enum { EM_PLAIN = 0, EM_WIN = 1, EM_RESID = 2, EM_LOGITS = 3, EM_SWIGLU = 4, EM_ROWSCALE = 5, EM_VT8 = 7, EM_RESID_ST = 8, EM_XQ = 9, EM_RESID_LN = 10, EM_SWIGLU_WT = 11   };
typedef unsigned u32x2 __attribute__((ext_vector_type(2)));
__device__ __forceinline__ unsigned pk_fp8x4(float a, float b, float c, float d) { int w = __builtin_amdgcn_cvt_pk_fp8_f32(a, b, __builtin_bit_cast(int, a), false); w = __builtin_amdgcn_cvt_pk_fp8_f32(c, d, w, true); return (unsigned)w; }
__device__ __forceinline__ unsigned pk_fp8x4o(float a, float b, float c, float d, int old) { int w = __builtin_amdgcn_cvt_pk_fp8_f32(a, b, old, false); w = __builtin_amdgcn_cvt_pk_fp8_f32(c, d, w, true); return (unsigned)w; }
template <int MODE> struct Epi {
    static constexpr bool PERM = true, AFTER_DRAIN = false;
    bf16_t* O; int ldc;
    const bf16_t* R;
    const float* aux;
    float* OF;
    int lyr;
    float alpha;
    const float* aux2 = nullptr; const float* aux3 = nullptr;
    __device__ __forceinline__ void store8(bf16_t* p, f32x4 v0, f32x4 v1) const {
        u32x4 w; w.x = cvt_pk_bf16(v0[0], v0[1]); w.y = cvt_pk_bf16(v0[2], v0[3]); w.z = cvt_pk_bf16(v1[0], v1[1]); w.w = cvt_pk_bf16(v1[2], v1[3]); *(u32x4*)p = w; }
    __device__ __forceinline__ void store8_wt(bf16_t* p, f32x4 v0, f32x4 v1) const {
        u32x4 w; w.x = cvt_pk_bf16(v0[0], v0[1]); w.y = cvt_pk_bf16(v0[2], v0[3]); w.z = cvt_pk_bf16(v1[0], v1[1]); w.w = cvt_pk_bf16(v1[2], v1[3]);
        asm volatile("global_store_dwordx4 %0, %1, off sc1\n\ts_nop 1" :: "v"(p), "v"(w) : "memory"); }
    __device__ __forceinline__ void operator()(const f32x4 (&acc)[2][2][4][2], const Unit& u, int wr, int wc, int fr, int fq) const {
        const int row0 = u.pm * BM + wr * 64 + fr;
        if constexpr (MODE == EM_LOGITS) {
            if (wc < 2) {
#pragma unroll
                for (int ai = 0; ai < 2; ++ai)
#pragma unroll
                    for (int m = 0; m < 4; ++m) { float* p = OF + (size_t)u.pn * (32768 * 64) + (size_t)(row0 + ai * HALF + m * 16) * 64 + wc * 32 + 8 * fq;
                        *(f32x4*)p = acc[ai][0][m][0]; *(f32x4*)(p + 4) = acc[ai][0][m][1]; }
            }
        } else if constexpr (MODE == EM_VT8) {
            unsigned char* O8 = (unsigned char*)O;
#pragma unroll
            for (int ai = 0; ai < 2; ++ai)
#pragma unroll
                for (int m = 0; m < 4; ++m) { const int row = row0 + ai * HALF + m * 16;
#pragma unroll
                    for (int bj = 0; bj < 2; ++bj) { const int col0 = u.pn * BM + bj * HALF + wc * 32 + 8 * fq; const f32x4 v0 = acc[ai][bj][m][0] * alpha, v1 = acc[ai][bj][m][1] * alpha;
                        u32x2 w; w.x = pk_fp8x4(v0[0], v0[1], v0[2], v0[3]); w.y = pk_fp8x4(v1[0], v1[1], v1[2], v1[3]);
                        unsigned char* bp = O8 + ((size_t)(col0 >> 14) * 1024 + row) * 16384 + (col0 & 16383 & ~63); const int g = (col0 & 63) >> 2, d = 4 * (g >> 3) + ((g & 7) >> 1);
                        *(unsigned*)(bp + 4 * d) = w.x; *(unsigned*)(bp + 4 * d + 32) = w.y; } }
        } else if constexpr (MODE == EM_SWIGLU || MODE == EM_SWIGLU_WT) {
            const int col0 = u.pn * HALF + wc * 32 + 8 * fq;
#pragma unroll
            for (int ai = 0; ai < 2; ++ai)
#pragma unroll
                for (int m = 0; m < 4; ++m) { f32x4 v0, v1;
#pragma unroll
                    for (int j = 0; j < 4; ++j) { v0[j] = silu_f(acc[ai][0][m][0][j]) * acc[ai][1][m][0][j]; v1[j] = silu_f(acc[ai][0][m][1][j]) * acc[ai][1][m][1][j]; }
                    if constexpr (MODE == EM_SWIGLU_WT) store8_wt(O + (size_t)(row0 + ai * HALF + m * 16) * ldc + col0, v0, v1);
                    else store8(O + (size_t)(row0 + ai * HALF + m * 16) * ldc + col0, v0, v1); }
        } else {
            const int col0 = u.pn * BM + wc * 32 + 8 * fq;
            const bool rope = (MODE == EM_WIN) && lyr == 0 && u.pn < 8 && wc == 0;
            const bool gelu = (MODE == EM_WIN) && lyr == 1 && u.pn < 8;
            const bool glu = (MODE == EM_WIN) && lyr == 0 && u.pn >= 12;
            f32x4 cA[2][2], cB[2][2];
            if constexpr (MODE == EM_XQ) {
#pragma unroll
                for (int bj = 0; bj < 2; ++bj)
#pragma unroll
                    for (int n = 0; n < 2; ++n) { cA[bj][n] = *(const f32x4*)(OF + col0 + bj * HALF + 4 * n); cB[bj][n] = *(const f32x4*)(OF + 512 + col0 + bj * HALF + 4 * n); } }
            if constexpr (MODE == EM_RESID_LN) {
#pragma unroll
                for (int bj = 0; bj < 2; ++bj)
#pragma unroll
                    for (int n = 0; n < 2; ++n) { cA[bj][n] = *(const f32x4*)(aux2 + col0 + bj * HALF + 4 * n) * alpha; cB[bj][n] = *(const f32x4*)(aux3 + col0 + bj * HALF + 4 * n) * alpha; } }
#pragma unroll
            for (int ai = 0; ai < 2; ++ai)
#pragma unroll
                for (int m = 0; m < 4; ++m) { const int row = row0 + ai * HALF + m * 16; bf16_t* rowp = O + (size_t)row * ldc + col0;
                    float rs = 1.f; if constexpr (MODE == EM_ROWSCALE) rs = aux[row];
                    f32x2 mr = (f32x2){0.f, 1.f}; if constexpr (MODE == EM_XQ || MODE == EM_RESID_LN) mr = *(const f32x2*)(aux + 2 * (size_t)row);
                    float s1 = 0.f, s2 = 0.f;
                    f32x4 cs0, cs1, sn0, sn1;
                    if constexpr (MODE == EM_WIN) { if (rope) { const float* cp = aux + (size_t)row * 32 + (fq & 1) * 8; cs0 = *(const f32x4*)cp; cs1 = *(const f32x4*)(cp + 4); sn0 = *(const f32x4*)(cp + 16); sn1 = *(const f32x4*)(cp + 20); } }
                    if (MODE == EM_WIN && glu) { f32x4 c0, c1;
#pragma unroll
                        for (int j = 0; j < 4; ++j) { c0[j] = acc[ai][0][m][0][j] * __builtin_amdgcn_rcpf(1.0f + __builtin_amdgcn_exp2f(-1.4426950408889634f * acc[ai][1][m][0][j]));
                                                      c1[j] = acc[ai][0][m][1][j] * __builtin_amdgcn_rcpf(1.0f + __builtin_amdgcn_exp2f(-1.4426950408889634f * acc[ai][1][m][1][j])); }
                        store8(O + (size_t)row * ldc + 3072 + (u.pn - 12) * HALF + wc * 32 + 8 * fq, c0, c1); continue; }
#pragma unroll
                    for (int bj = 0; bj < 2; ++bj) { f32x4 v0 = acc[ai][bj][m][0], v1 = acc[ai][bj][m][1];
                        if constexpr (MODE == EM_WIN) {
                            if (rope) {
                                f32x4 p0, p1;
#pragma unroll
                                for (int j = 0; j < 4; ++j) { p0[j] = __shfl_xor(v0[j], 32); p1[j] = __shfl_xor(v1[j], 32); }
                                const float sg = (fq < 2) ? -1.f : 1.f;
#pragma unroll
                                for (int j = 0; j < 4; ++j) { v0[j] = v0[j] * cs0[j] + sg * p0[j] * sn0[j]; v1[j] = v1[j] * cs1[j] + sg * p1[j] * sn1[j]; }
                            } else if (gelu) {
                                f32x2 a = gelu_pk((f32x2){v0[0], v0[1]}), b = gelu_pk((f32x2){v0[2], v0[3]}), c = gelu_pk((f32x2){v1[0], v1[1]}), d = gelu_pk((f32x2){v1[2], v1[3]});
                                v0 = (f32x4){a.x, a.y, b.x, b.y}; v1 = (f32x4){c.x, c.y, d.x, d.y};
                            }
                        }
                        if constexpr (MODE == EM_XQ) { const float t = -mr.x * mr.y; v0 = v0 * mr.y + (cA[bj][0] * t + cB[bj][0]); v1 = v1 * mr.y + (cA[bj][1] * t + cB[bj][1]); }
                        if constexpr (MODE == EM_RESID_LN) { const u32x4 rw = __builtin_nontemporal_load((const u32x4*)(R + (size_t)row * ldc + col0 + bj * HALF));
                            const f32x4 y0 = ((f32x4){bf_lo(rw.x), bf_hi(rw.x), bf_lo(rw.y), bf_hi(rw.y)} - mr.x) * mr.y, y1 = ((f32x4){bf_lo(rw.z), bf_hi(rw.z), bf_lo(rw.w), bf_hi(rw.w)} - mr.x) * mr.y;
                            v0 = v0 + (y0 * cA[bj][0] + cB[bj][0]); v1 = v1 + (y1 * cA[bj][1] + cB[bj][1]); }
                        if constexpr (MODE == EM_RESID || MODE == EM_RESID_ST) { const u32x4 rw = __builtin_nontemporal_load((const u32x4*)(R + (size_t)row * ldc + col0 + bj * HALF));
                            v0[0] += alpha * bf_lo(rw.x); v0[1] += alpha * bf_hi(rw.x); v0[2] += alpha * bf_lo(rw.y); v0[3] += alpha * bf_hi(rw.y);
                            v1[0] += alpha * bf_lo(rw.z); v1[1] += alpha * bf_hi(rw.z); v1[2] += alpha * bf_lo(rw.w); v1[3] += alpha * bf_hi(rw.w); }
                        if constexpr (MODE == EM_RESID_ST) { s1 += ((v0[0] + v0[1]) + (v0[2] + v0[3])) + ((v1[0] + v1[1]) + (v1[2] + v1[3]));
                            s2 += ((v0[0] * v0[0] + v0[1] * v0[1]) + (v0[2] * v0[2] + v0[3] * v0[3])) + ((v1[0] * v1[0] + v1[1] * v1[1]) + (v1[2] * v1[2] + v1[3] * v1[3])); }
                        if constexpr (MODE == EM_ROWSCALE) { v0 = v0 * rs; v1 = v1 * rs; }
                        if (MODE == EM_WIN && lyr == 0 && u.pn < 8) {
                            u32x2 w8; w8.x = pk_fp8x4(v0[0], v0[1], v0[2], v0[3]); w8.y = pk_fp8x4(v1[0], v1[1], v1[2], v1[3]);
                            *(u32x2*)((unsigned char*)OF + (size_t)row * 2048 + col0 + bj * HALF) = w8; }
                        else if constexpr (MODE == EM_ROWSCALE) { u32x4 w; w.x = cvt_pk_bf16(v0[0], v0[1]); w.y = cvt_pk_bf16(v0[2], v0[3]); w.z = cvt_pk_bf16(v1[0], v1[1]); w.w = cvt_pk_bf16(v1[2], v1[3]);
                            __builtin_nontemporal_store(w, (u32x4*)(rowp + bj * HALF)); }
                        else store8(rowp + bj * HALF, v0, v1); }
                    if constexpr (MODE == EM_RESID_ST) { s1 += __shfl_xor(s1, 16); s2 += __shfl_xor(s2, 16); s1 += __shfl_xor(s1, 32); s2 += __shfl_xor(s2, 32);
                        if (fq == 0) *(f32x2*)(OF + ((size_t)row * 32 + u.pn * 4 + wc) * 2) = (f32x2){s1, s2}; } }
        }
    }
};

template <class Epi, class Sched, bool ALIGN_EPI = false, bool SP2 = false>
__device__ __forceinline__ void gemm_phase(PG8_LAS unsigned char* lds, const Gemm g, const Sched& S, const Epi& E) {
    int tid_ = threadIdx.x; asm volatile("" : "+v"(tid_)); const int tid = tid_, wid = __builtin_amdgcn_readfirstlane(tid >> 6), lane = tid & 63, wr = wid >> 2, wc = wid & 3, fr = lane & 15, fq = lane >> 4;
    const int K = g.K, nt = K / BK, LD = g.ld;
    unsigned voffA[2], voffB[2];
#pragma unroll
    for (int i = 0; i < 2; ++i) { int R, C; stage_rc(tid * 16 + i * 8192, R, C); const int Rb = Epi::PERM ? ((R & ~31) + perm32(R & 31)) : R;
        voffA[i] = (unsigned)(R * LD + C) * 2u; voffB[i] = (unsigned)(Rb * LD + C) * 2u; }
    const size_t kstep = (size_t)(BK * 2);
    const size_t hstep = (size_t)HALF * LD * 2;
    const size_t tstep = 2 * hstep;
    const unsigned ldsw = (unsigned)wid * 1024u;
    const int aoff = lds_byte(wr * 64 + fr, fq * 8), boff = lds_byte(wc * 32 + fr, fq * 8);
#define PG8_SA(b, h) (((b) * 2 + (h)) * HTB)
#define PG8_SB(b, h) ((4 + (b) * 2 + (h)) * HTB)
#define PG8_STAGE(bufoff, gbase, voff) do { _Pragma("unroll") for (int _i = 0; _i < 2; ++_i) \
        __builtin_amdgcn_global_load_lds((const unsigned*)((const char*)(gbase) + (voff)[_i]), (PG8_LAS unsigned*)(lds + (bufoff) + ldsw + _i * 8192), 16, 0, 0); } while (0)
#define PG8_LDA(dst, b, h) do { _Pragma("unroll") for (int m = 0; m < 4; ++m) _Pragma("unroll") for (int k = 0; k < 2; ++k) dst[m][k] = *(const PG8_LAS bf16x8*)(lds + PG8_SA(b, h) + aoff + m * 2048 + k * 1024); } while (0)
#define PG8_LDB(dst, b, h) do { _Pragma("unroll") for (int n = 0; n < 2; ++n) _Pragma("unroll") for (int k = 0; k < 2; ++k) dst[n][k] = *(const PG8_LAS bf16x8*)(lds + PG8_SB(b, h) + boff + n * 2048 + k * 1024); } while (0)
#define PG8_MMA(ai, bj, At, Bt) do { __builtin_amdgcn_s_setprio(1); _Pragma("unroll") for (int m = 0; m < 4; ++m) _Pragma("unroll") for (int n = 0; n < 2; ++n) _Pragma("unroll") for (int k = 0; k < 2; ++k) \
        acc[ai][bj][m][n] = __builtin_amdgcn_mfma_f32_16x16x32_bf16(Bt[n][k], At[m][k], acc[ai][bj][m][n], 0, 0, 0); __builtin_amdgcn_s_setprio(0); } while (0)
#define PG8_WAIT_V(n) asm volatile("s_waitcnt vmcnt(" #n ")" ::: "memory")
#define PG8_WAIT_L(n) asm volatile("s_waitcnt lgkmcnt(" #n ")" ::: "memory")
#define PG8_BAR __builtin_amdgcn_s_barrier()
#define PG8_SCHED __builtin_amdgcn_sched_barrier(0)
    Unit cur, nxt; int ui = 0;
    if (!S.next(0, cur)) return;
    f32x4 acc[2][2][4][2];
#pragma unroll
    for (int a = 0; a < 2; ++a)
#pragma unroll
        for (int b = 0; b < 2; ++b)
#pragma unroll
            for (int m = 0; m < 4; ++m)
#pragma unroll
                for (int n = 0; n < 2; ++n) acc[a][b][m][n] = (f32x4){0.f, 0.f, 0.f, 0.f};
    bf16x8 At[4][2], B0[2][2], B1[2][2];
    const char* cA = (const char*)g.A + (size_t)cur.pm * tstep + (size_t)cur.ko * 2; const char* cB = (const char*)g.Bt + (size_t)cur.pb * tstep + (size_t)cur.ko * 2;
    S.a_ready(cur);
    if constexpr (SP2) {
        PG8_STAGE(PG8_SB(0, 0), cB, voffB); PG8_STAGE(PG8_SB(0, 1), cB + hstep, voffB); PG8_STAGE(PG8_SA(0, 0), cA, voffA); PG8_STAGE(PG8_SA(0, 1), cA + hstep, voffA);
        if (wr == 1) PG8_BAR;
        PG8_WAIT_V(2); PG8_BAR;
        PG8_STAGE(PG8_SB(1, 0), cB + kstep, voffB); PG8_STAGE(PG8_SA(1, 0), cA + kstep, voffA); PG8_STAGE(PG8_SB(1, 1), cB + hstep + kstep, voffB);
        PG8_WAIT_V(6); PG8_BAR;
    } else {
        PG8_STAGE(PG8_SB(0, 0), cB, voffB); PG8_STAGE(PG8_SA(0, 0), cA, voffA); PG8_STAGE(PG8_SB(0, 1), cB + hstep, voffB); PG8_STAGE(PG8_SA(0, 1), cA + hstep, voffA);
        if (wr == 1) PG8_BAR;
        PG8_WAIT_V(4); PG8_BAR;
        PG8_STAGE(PG8_SB(1, 0), cB + kstep, voffB); PG8_STAGE(PG8_SA(1, 0), cA + kstep, voffA); PG8_STAGE(PG8_SB(1, 1), cB + hstep + kstep, voffB);
        PG8_WAIT_V(6); PG8_BAR;
    }
    for (;;) {
        const bool has_next = S.next(ui + 1, nxt);
        const char* nA = has_next ? (const char*)g.A + (size_t)nxt.pm * tstep + (size_t)nxt.ko * 2 : cA; const char* nB = has_next ? (const char*)g.Bt + (size_t)nxt.pb * tstep + (size_t)nxt.ko * 2 : cB;
        for (int t = 0; t < nt; t += 2) {
            const bool last = (t == nt - 2);
            const char* a1 = cA + (size_t)(t + 1) * kstep;
            const char* a2 = last ? nA : cA + (size_t)(t + 2) * kstep; const char* b2 = last ? nB : cB + (size_t)(t + 2) * kstep;
            const char* a3 = a2 + kstep; const char* b3 = b2 + kstep;
            if (last && has_next) S.a_ready(nxt);
            if constexpr (SP2) {
            PG8_LDB(B0, 0, 0); PG8_LDB(B1, 0, 1); PG8_SCHED; PG8_LDA(At, 0, 0); PG8_STAGE(PG8_SA(1, 1), a1 + hstep, voffA);
            PG8_WAIT_V(8); PG8_WAIT_L(0); PG8_BAR; PG8_MMA(0, 0, At, B0); PG8_MMA(0, 1, At, B1); PG8_BAR; PG8_SCHED;
            PG8_LDA(At, 0, 1); PG8_STAGE(PG8_SB(0, 0), b2, voffB); PG8_STAGE(PG8_SB(0, 1), b2 + hstep, voffB); PG8_STAGE(PG8_SA(0, 0), a2, voffA);
            PG8_WAIT_V(8); PG8_WAIT_L(0); PG8_BAR; PG8_MMA(1, 0, At, B0); PG8_MMA(1, 1, At, B1); PG8_BAR; PG8_SCHED;
            PG8_LDB(B0, 1, 0); PG8_LDB(B1, 1, 1); PG8_SCHED; PG8_LDA(At, 1, 0); PG8_STAGE(PG8_SA(0, 1), a2 + hstep, voffA);
            PG8_WAIT_V(8); PG8_WAIT_L(0); PG8_BAR; PG8_MMA(0, 0, At, B0); PG8_MMA(0, 1, At, B1); PG8_BAR; PG8_SCHED;
            PG8_LDA(At, 1, 1); PG8_STAGE(PG8_SB(1, 0), b3, voffB); PG8_STAGE(PG8_SB(1, 1), b3 + hstep, voffB); PG8_STAGE(PG8_SA(1, 0), a3, voffA);
            PG8_WAIT_V(8); PG8_WAIT_L(0); PG8_BAR; PG8_MMA(1, 0, At, B0); PG8_MMA(1, 1, At, B1); PG8_BAR; PG8_SCHED;
            } else {
            PG8_LDB(B0, 0, 0); PG8_SCHED; PG8_LDA(At, 0, 0); PG8_STAGE(PG8_SA(1, 1), a1 + hstep, voffA);
            PG8_WAIT_L(8); PG8_BAR; PG8_WAIT_L(0); PG8_MMA(0, 0, At, B0); PG8_BAR; PG8_SCHED;
            PG8_LDB(B1, 0, 1); PG8_STAGE(PG8_SB(0, 0), b2, voffB);
            PG8_BAR; PG8_WAIT_L(0); PG8_MMA(0, 1, At, B1); PG8_BAR;
            PG8_LDA(At, 0, 1); PG8_STAGE(PG8_SA(0, 0), a2, voffA);
            PG8_BAR; PG8_WAIT_L(0); PG8_MMA(1, 0, At, B0); PG8_BAR; PG8_SCHED;
            PG8_STAGE(PG8_SB(0, 1), b2 + hstep, voffB);
            PG8_WAIT_V(6); PG8_BAR; PG8_MMA(1, 1, At, B1); PG8_BAR;
            PG8_LDB(B0, 1, 0); PG8_SCHED; PG8_LDA(At, 1, 0); PG8_STAGE(PG8_SA(0, 1), a2 + hstep, voffA);
            PG8_WAIT_L(8); PG8_BAR; PG8_WAIT_L(0); PG8_MMA(0, 0, At, B0); PG8_BAR; PG8_SCHED;
            PG8_LDB(B1, 1, 1); PG8_STAGE(PG8_SB(1, 0), b3, voffB);
            PG8_BAR; PG8_WAIT_L(0); PG8_MMA(0, 1, At, B1); PG8_BAR;
            PG8_LDA(At, 1, 1); PG8_STAGE(PG8_SA(1, 0), a3, voffA);
            PG8_BAR; PG8_WAIT_L(0); PG8_MMA(1, 0, At, B0); PG8_BAR; PG8_SCHED;
            PG8_STAGE(PG8_SB(1, 1), b3 + hstep, voffB);
            PG8_WAIT_V(6); PG8_BAR; PG8_MMA(1, 1, At, B1); PG8_BAR;
            }
        }
        if constexpr (ALIGN_EPI) { if (wr == 0) PG8_BAR; }
        if constexpr (!Epi::AFTER_DRAIN) { int fr_ = fr, fq_ = fq; asm volatile("" : "+v"(fr_), "+v"(fq_));
            E(acc, cur, wr, wc, fr_, fq_); S.done(cur); }
        if (!has_next) break;
#pragma unroll
        for (int a = 0; a < 2; ++a)
#pragma unroll
            for (int b = 0; b < 2; ++b)
#pragma unroll
                for (int m = 0; m < 4; ++m)
#pragma unroll
                    for (int n = 0; n < 2; ++n) acc[a][b][m][n] = (f32x4){0.f, 0.f, 0.f, 0.f};
        cur = nxt; cA = nA; cB = nB; ++ui;
        if constexpr (ALIGN_EPI) { if (wr == 1) PG8_BAR; }
    }
    PG8_WAIT_V(0);
    if constexpr (!ALIGN_EPI) { if (wr == 0) PG8_BAR; }
    PG8_BAR;
    if constexpr (Epi::AFTER_DRAIN) { E.fused(acc, cur, wr, wc, fr, fq, lds, wid, lane); S.done(cur); }
#undef PG8_SA
#undef PG8_SB
#undef PG8_STAGE
#undef PG8_LDA
#undef PG8_LDB
#undef PG8_MMA
#undef PG8_WAIT_V
#undef PG8_WAIT_L
#undef PG8_BAR
#undef PG8_SCHED
}
template <class Epi, class Sched, bool ALIGN_EPI = false, bool SP2 = true>
__device__ __forceinline__ void gemm_phase_g(PG8_LAS unsigned char* lds, const Gemm g, const Sched& S, const Epi& E) {
    int tid_ = threadIdx.x; asm volatile("" : "+v"(tid_)); const int tid = tid_, wid = __builtin_amdgcn_readfirstlane(tid >> 6), lane = tid & 63, wr = wid >> 2, wc = wid & 3, fr = lane & 15, fq = lane >> 4;
    const int K = g.K, nt = K / BK, LD = g.ld;
    unsigned voffA[2], voffB[2];
#pragma unroll
    for (int i = 0; i < 2; ++i) { int R, C; stage_rc(tid * 16 + i * 8192, R, C); const int Rb = Epi::PERM ? ((R & ~31) + perm32(R & 31)) : R;
        voffA[i] = (unsigned)(R * LD + C) * 2u; voffB[i] = (unsigned)(Rb * LD + C) * 2u; }
    static_assert(SP2, "gather variant: SP2 loop only");
    unsigned gac[2][2], gan[2][2];
#define PG8_ROWOFF(dst, ui_) do { _Pragma("unroll") for (int i_ = 0; i_ < 2; ++i_) { int R_, C_; stage_rc(tid * 16 + i_ * 8192, R_, C_); \
        _Pragma("unroll") for (int h_ = 0; h_ < 2; ++h_) dst[h_][i_] = (unsigned)S.rtab[(ui_) * 256 + h_ * 128 + R_] * (unsigned)(LD * 2) + (unsigned)C_ * 2u; } } while (0)
    const size_t kstep = (size_t)(BK * 2);
    const size_t hstep = (size_t)HALF * LD * 2;
    const size_t tstep = 2 * hstep;
    const unsigned ldsw = (unsigned)wid * 1024u;
    const int aoff = lds_byte(wr * 64 + fr, fq * 8), boff = lds_byte(wc * 32 + fr, fq * 8);
#define PG8_SA(b, h) (((b) * 2 + (h)) * HTB)
#define PG8_SB(b, h) ((4 + (b) * 2 + (h)) * HTB)
#define PG8_STAGE(bufoff, gbase, voff) do { _Pragma("unroll") for (int _i = 0; _i < 2; ++_i) \
        __builtin_amdgcn_global_load_lds((const unsigned*)((const char*)(gbase) + (voff)[_i]), (PG8_LAS unsigned*)(lds + (bufoff) + ldsw + _i * 8192), 16, 0, 0); } while (0)
#define PG8_LDA(dst, b, h) do { _Pragma("unroll") for (int m = 0; m < 4; ++m) _Pragma("unroll") for (int k = 0; k < 2; ++k) dst[m][k] = *(const PG8_LAS bf16x8*)(lds + PG8_SA(b, h) + aoff + m * 2048 + k * 1024); } while (0)
#define PG8_LDB(dst, b, h) do { _Pragma("unroll") for (int n = 0; n < 2; ++n) _Pragma("unroll") for (int k = 0; k < 2; ++k) dst[n][k] = *(const PG8_LAS bf16x8*)(lds + PG8_SB(b, h) + boff + n * 2048 + k * 1024); } while (0)
#define PG8_MMA(ai, bj, At, Bt) do { __builtin_amdgcn_s_setprio(1); _Pragma("unroll") for (int m = 0; m < 4; ++m) _Pragma("unroll") for (int n = 0; n < 2; ++n) _Pragma("unroll") for (int k = 0; k < 2; ++k) \
        acc[ai][bj][m][n] = __builtin_amdgcn_mfma_f32_16x16x32_bf16(Bt[n][k], At[m][k], acc[ai][bj][m][n], 0, 0, 0); __builtin_amdgcn_s_setprio(0); } while (0)
#define PG8_WAIT_V(n) asm volatile("s_waitcnt vmcnt(" #n ")" ::: "memory")
#define PG8_WAIT_L(n) asm volatile("s_waitcnt lgkmcnt(" #n ")" ::: "memory")
#define PG8_BAR __builtin_amdgcn_s_barrier()
#define PG8_SCHED __builtin_amdgcn_sched_barrier(0)
    Unit cur, nxt; int ui = 0;
    if (!S.next(0, cur)) return;
    f32x4 acc[2][2][4][2];
#pragma unroll
    for (int a = 0; a < 2; ++a)
#pragma unroll
        for (int b = 0; b < 2; ++b)
#pragma unroll
            for (int m = 0; m < 4; ++m)
#pragma unroll
                for (int n = 0; n < 2; ++n) acc[a][b][m][n] = (f32x4){0.f, 0.f, 0.f, 0.f};
    bf16x8 At[4][2], B0[2][2], B1[2][2];
    PG8_ROWOFF(gac, 0);
    const char* cA = (const char*)g.A + (size_t)cur.ko * 2; const char* cB = (const char*)g.Bt + (size_t)cur.pb * tstep + (size_t)cur.ko * 2;
    S.a_ready(cur);
    if constexpr (SP2) {
        PG8_STAGE(PG8_SB(0, 0), cB, voffB); PG8_STAGE(PG8_SB(0, 1), cB + hstep, voffB); PG8_STAGE(PG8_SA(0, 0), cA, gac[0]); PG8_STAGE(PG8_SA(0, 1), cA, gac[1]);
        if (wr == 1) PG8_BAR;
        PG8_WAIT_V(2); PG8_BAR;
        PG8_STAGE(PG8_SB(1, 0), cB + kstep, voffB); PG8_STAGE(PG8_SA(1, 0), cA + kstep, gac[0]); PG8_STAGE(PG8_SB(1, 1), cB + hstep + kstep, voffB);
        PG8_WAIT_V(6); PG8_BAR;
    } else {
        PG8_STAGE(PG8_SB(0, 0), cB, voffB); PG8_STAGE(PG8_SA(0, 0), cA, voffA); PG8_STAGE(PG8_SB(0, 1), cB + hstep, voffB); PG8_STAGE(PG8_SA(0, 1), cA + hstep, voffA);
        if (wr == 1) PG8_BAR;
        PG8_WAIT_V(4); PG8_BAR;
        PG8_STAGE(PG8_SB(1, 0), cB + kstep, voffB); PG8_STAGE(PG8_SA(1, 0), cA + kstep, gac[0]); PG8_STAGE(PG8_SB(1, 1), cB + hstep + kstep, voffB);
        PG8_WAIT_V(6); PG8_BAR;
    }
    for (;;) {
        const bool has_next = S.next(ui + 1, nxt);
        if (has_next) PG8_ROWOFF(gan, ui + 1); else { gan[0][0] = gac[0][0]; gan[0][1] = gac[0][1]; gan[1][0] = gac[1][0]; gan[1][1] = gac[1][1]; }
        const char* nA = has_next ? (const char*)g.A + (size_t)nxt.ko * 2 : cA; const char* nB = has_next ? (const char*)g.Bt + (size_t)nxt.pb * tstep + (size_t)nxt.ko * 2 : cB;
        for (int t = 0; t < nt; t += 2) {
            const bool last = (t == nt - 2);
            const char* a1 = cA + (size_t)(t + 1) * kstep;
            const char* a2 = last ? nA : cA + (size_t)(t + 2) * kstep; const char* b2 = last ? nB : cB + (size_t)(t + 2) * kstep;
            const char* a3 = a2 + kstep; const char* b3 = b2 + kstep;
            const unsigned g2a[2] = {last ? gan[0][0] : gac[0][0], last ? gan[0][1] : gac[0][1]}, g2b[2] = {last ? gan[1][0] : gac[1][0], last ? gan[1][1] : gac[1][1]};
            if (last && has_next) S.a_ready(nxt);
            if constexpr (SP2) {
            PG8_LDB(B0, 0, 0); PG8_LDB(B1, 0, 1); PG8_SCHED; PG8_LDA(At, 0, 0); PG8_STAGE(PG8_SA(1, 1), a1, gac[1]);
            PG8_WAIT_V(8); PG8_WAIT_L(0); PG8_BAR; PG8_MMA(0, 0, At, B0); PG8_MMA(0, 1, At, B1); PG8_BAR; PG8_SCHED;
            PG8_LDA(At, 0, 1); PG8_STAGE(PG8_SB(0, 0), b2, voffB); PG8_STAGE(PG8_SB(0, 1), b2 + hstep, voffB); PG8_STAGE(PG8_SA(0, 0), a2, g2a);
            PG8_WAIT_V(8); PG8_WAIT_L(0); PG8_BAR; PG8_MMA(1, 0, At, B0); PG8_MMA(1, 1, At, B1); PG8_BAR; PG8_SCHED;
            PG8_LDB(B0, 1, 0); PG8_LDB(B1, 1, 1); PG8_SCHED; PG8_LDA(At, 1, 0); PG8_STAGE(PG8_SA(0, 1), a2, g2b);
            PG8_WAIT_V(8); PG8_WAIT_L(0); PG8_BAR; PG8_MMA(0, 0, At, B0); PG8_MMA(0, 1, At, B1); PG8_BAR; PG8_SCHED;
            PG8_LDA(At, 1, 1); PG8_STAGE(PG8_SB(1, 0), b3, voffB); PG8_STAGE(PG8_SB(1, 1), b3 + hstep, voffB); PG8_STAGE(PG8_SA(1, 0), a3, g2a);
            PG8_WAIT_V(8); PG8_WAIT_L(0); PG8_BAR; PG8_MMA(1, 0, At, B0); PG8_MMA(1, 1, At, B1); PG8_BAR; PG8_SCHED;
            } else {
            PG8_LDB(B0, 0, 0); PG8_SCHED; PG8_LDA(At, 0, 0); PG8_STAGE(PG8_SA(1, 1), a1, gac[1]);
            PG8_WAIT_L(8); PG8_BAR; PG8_WAIT_L(0); PG8_MMA(0, 0, At, B0); PG8_BAR; PG8_SCHED;
            PG8_LDB(B1, 0, 1); PG8_STAGE(PG8_SB(0, 0), b2, voffB);
            PG8_BAR; PG8_WAIT_L(0); PG8_MMA(0, 1, At, B1); PG8_BAR;
            PG8_LDA(At, 0, 1); PG8_STAGE(PG8_SA(0, 0), a2, g2a);
            PG8_BAR; PG8_WAIT_L(0); PG8_MMA(1, 0, At, B0); PG8_BAR; PG8_SCHED;
            PG8_STAGE(PG8_SB(0, 1), b2 + hstep, voffB);
            PG8_WAIT_V(6); PG8_BAR; PG8_MMA(1, 1, At, B1); PG8_BAR;
            PG8_LDB(B0, 1, 0); PG8_SCHED; PG8_LDA(At, 1, 0); PG8_STAGE(PG8_SA(0, 1), a2, g2b);
            PG8_WAIT_L(8); PG8_BAR; PG8_WAIT_L(0); PG8_MMA(0, 0, At, B0); PG8_BAR; PG8_SCHED;
            PG8_LDB(B1, 1, 1); PG8_STAGE(PG8_SB(1, 0), b3, voffB);
            PG8_BAR; PG8_WAIT_L(0); PG8_MMA(0, 1, At, B1); PG8_BAR;
            PG8_LDA(At, 1, 1); PG8_STAGE(PG8_SA(1, 0), a3, g2a);
            PG8_BAR; PG8_WAIT_L(0); PG8_MMA(1, 0, At, B0); PG8_BAR; PG8_SCHED;
            PG8_STAGE(PG8_SB(1, 1), b3 + hstep, voffB);
            PG8_WAIT_V(6); PG8_BAR; PG8_MMA(1, 1, At, B1); PG8_BAR;
            }
        }
        if constexpr (ALIGN_EPI) { if (wr == 0) PG8_BAR; }
        if constexpr (!Epi::AFTER_DRAIN) { int fr_ = fr, fq_ = fq; asm volatile("" : "+v"(fr_), "+v"(fq_));
            E(acc, cur, wr, wc, fr_, fq_); S.done(cur); }
        if (!has_next) break;
#pragma unroll
        for (int a = 0; a < 2; ++a)
#pragma unroll
            for (int b = 0; b < 2; ++b)
#pragma unroll
                for (int m = 0; m < 4; ++m)
#pragma unroll
                    for (int n = 0; n < 2; ++n) acc[a][b][m][n] = (f32x4){0.f, 0.f, 0.f, 0.f};
        cur = nxt; cA = nA; cB = nB; ++ui; gac[0][0] = gan[0][0]; gac[0][1] = gan[0][1]; gac[1][0] = gan[1][0]; gac[1][1] = gan[1][1];
        if constexpr (ALIGN_EPI) { if (wr == 1) PG8_BAR; }
    }
    PG8_WAIT_V(0);
    if constexpr (!ALIGN_EPI) { if (wr == 0) PG8_BAR; }
    PG8_BAR;
    if constexpr (Epi::AFTER_DRAIN) { E.fused(acc, cur, wr, wc, fr, fq, lds, wid, lane); S.done(cur); }
#undef PG8_SA
#undef PG8_SB
#undef PG8_STAGE
#undef PG8_LDA
#undef PG8_LDB
#undef PG8_MMA
#undef PG8_WAIT_V
#undef PG8_WAIT_L
#undef PG8_BAR
#undef PG8_SCHED
#undef PG8_ROWOFF
}
}
namespace att {
constexpr int D = 128;
constexpr float THR = 8.f;
constexpr bool WSKIP = false;
constexpr float SCALE = 0.08838834764831845f;
constexpr int NW = 8, QBLK = 32, KVBLK = 64, QB = NW * QBLK;
constexpr int SHM_V = KVBLK * D * 2, SHM_K = KVBLK * D * 2;
constexpr int LDS_BYTES = 2 * SHM_V + 2 * SHM_K + NW * 64 * 4;

using bf16 = __hip_bfloat16;
typedef short bf16x8 __attribute__((ext_vector_type(8)));
typedef short s16x4 __attribute__((ext_vector_type(4)));
typedef float f32x16 __attribute__((ext_vector_type(16)));
typedef float f32x4 __attribute__((ext_vector_type(4)));
typedef unsigned u32x4 __attribute__((ext_vector_type(4)));
template <class A, class Bt> struct same_t { static constexpr bool v = false; };
template <class A> struct same_t<A, A> { static constexpr bool v = true; };

#define KSWZ(row, colB) ((row) * 256 + ((colB) ^ (((row) & 7) << 4)))
#define SBAR() __builtin_amdgcn_sched_barrier(0)
__device__ __forceinline__ int v_st(int k, int c) { const int kk = (k & ~0xC) | ((k & 4) << 1) | ((k & 8) >> 1); return ((kk >> 3) * 4 + (c >> 5)) * 512 + ((kk & 7) * 32 + (c & 31)) * 2; }
__device__ __forceinline__ int v_rd_base(int lane) { return ((lane & 3) << 3) | (((lane >> 2) & 3) << 6) | (((lane >> 4) & 1) << 5) | (((lane >> 5) & 1) << 8); }
constexpr int v_rd_off(int d0, int ks, int half) { return d0 * 512 + ks * 4096 + half * 2048; }
__device__ __forceinline__ int crow(int r, int hi) { return (r & 3) + 8 * (r >> 2) + 4 * hi; }
__device__ __forceinline__ unsigned cvtpk(float lo, float hi) {
    unsigned r; asm volatile("v_cvt_pk_bf16_f32 %0, %1, %2" : "=v"(r) : "v"(lo), "v"(hi)); return r;
}
__device__ __forceinline__ bf16x8 pack8(f32x4 a, f32x4 b) {
    u32x4 w = {cvtpk(a[0], a[1]), cvtpk(a[2], a[3]), cvtpk(b[0], b[1]), cvtpk(b[2], b[3])};
    return *reinterpret_cast<bf16x8*>(&w);
}
template <class T> __device__ __forceinline__ bf16x8 load8(const T* p) {
    if constexpr (same_t<T, float>::v) { return pack8(*(const f32x4*)p, *(const f32x4*)(p + 4)); }
    else { return *reinterpret_cast<const bf16x8*>(p); }
}
__device__ __forceinline__ void mask_tile(f32x16& p0, f32x16& p1, int dq, unsigned W) {
    const float NEG = -__builtin_inff();
#pragma unroll
    for (int r = 0; r < 16; ++r) {
        const int c = (r & 3) + 8 * (r >> 2);
        if ((unsigned)(dq - c) >= W) p0[r] = NEG;
        if ((unsigned)(dq - c - 32) >= W) p1[r] = NEG;
    }
}
__device__ __forceinline__ void partialSM(f32x16& p0, f32x16& p1, float& m_reg, float& mn, float& alpha) {
    float pmax = p0[0]; for (int r = 1; r < 16; ++r) pmax = fmaxf(pmax, p0[r]); for (int r = 0; r < 16; ++r) pmax = fmaxf(pmax, p1[r]);
    { auto rr = __builtin_amdgcn_permlane32_swap(__float_as_uint(pmax), __float_as_uint(pmax), false, false);
      pmax = fmaxf(__uint_as_float(rr[0]), __uint_as_float(rr[1])); }
    constexpr float C2 = 1.4426950408889634f * SCALE;
    if (__builtin_expect(__all((pmax - m_reg) * SCALE <= THR), 1)) { mn = m_reg; alpha = 1.f; }
    else { mn = fmaxf(m_reg, pmax); alpha = __builtin_amdgcn_exp2f((m_reg - mn) * C2); m_reg = mn; }
    const float mnL = -mn * C2;
    for (int r = 0; r < 16; ++r) p0[r] = fmaf(p0[r], C2, mnL); for (int r = 0; r < 16; ++r) p1[r] = fmaf(p1[r], C2, mnL);
    for (int r = 0; r < 16; ++r) p0[r] = __builtin_amdgcn_exp2f(p0[r]);
}
__device__ __forceinline__ void finishSM(f32x16& p0, f32x16& p1, float alpha, float& l_reg, bf16x8& pa0, bf16x8& pa1, bf16x8& pa2, bf16x8& pa3) {
    for (int r = 0; r < 16; ++r) p1[r] = __builtin_amdgcn_exp2f(p1[r]);
    float ps = 0; for (int r = 0; r < 16; ++r) ps += p0[r]; for (int r = 0; r < 16; ++r) ps += p1[r];
    { auto rr = __builtin_amdgcn_permlane32_swap(__float_as_uint(ps), __float_as_uint(ps), false, false);
      ps = __uint_as_float(rr[0]) + __uint_as_float(rr[1]); }
    l_reg = l_reg * alpha + ps;
#define PK4(P, B_, OUT) do { unsigned a0 = cvtpk(P[B_+0], P[B_+1]), a1 = cvtpk(P[B_+2], P[B_+3]);                          \
        unsigned b0 = cvtpk(P[B_+4], P[B_+5]), b1 = cvtpk(P[B_+6], P[B_+7]);                                             \
        auto r0 = __builtin_amdgcn_permlane32_swap(a0, b0, false, false); auto r1 = __builtin_amdgcn_permlane32_swap(a1, b1, false, false); \
        u32x4 w = {r0[0], r1[0], r0[1], r1[1]}; OUT = *reinterpret_cast<bf16x8*>(&w); } while (0)
    PK4(p0, 0, pa0); PK4(p0, 8, pa1); PK4(p1, 0, pa2); PK4(p1, 8, pa3);
#undef PK4
}
template <int KB, bool SK>
__device__ __forceinline__ void qkt(f32x16& p0, f32x16& p1, const char* K_lds, int r32, int hi, const bf16x8* qr, bool act) {
    if (SK && !act) { const float NEG = -__builtin_inff();
#pragma unroll
        for (int r = 0; r < 16; ++r) { p0[r] = NEG; p1[r] = NEG; } return; }
    p0 = f32x16{}; p1 = f32x16{};
    const char* kb[4];
#pragma unroll
    for (int dd = 0; dd < 4; ++dd) kb[dd] = K_lds + KB * SHM_K + KSWZ(r32, (dd * 16 + hi * 8) * 2);
#pragma unroll
    for (int d0 = 0; d0 < 8; ++d0) { const char* a = kb[d0 & 3] + (d0 >> 2) * 128;
        bf16x8 b0 = *reinterpret_cast<const bf16x8*>(a);
        bf16x8 b1 = *reinterpret_cast<const bf16x8*>(a + 32 * 256);
        p0 = __builtin_amdgcn_mfma_f32_32x32x16_bf16(b0, qr[d0], p0, 0, 0, 0);
        p1 = __builtin_amdgcn_mfma_f32_32x32x16_bf16(b1, qr[d0], p1, 0, 0, 0); }
}
template <int VB, bool SK>
__device__ __forceinline__ void pv_tile(f32x16* o, int vb0, bf16x8 pa0, bf16x8 pa1, bf16x8 pa2, bf16x8 pa3, bool act) {
    if (SK && !act) return;
#define TRRD(dst, off) asm volatile("ds_read_b64_tr_b16 %0, %1 offset:%2" : "=&v"(dst) : "v"(vb0), "i"(off) : "memory")
#define PV_D0(d0) do { s16x4 l0, l1, l2, l3, h0, h1, h2, h3; constexpr int b_ = VB * SHM_V + v_rd_off(d0, 0, 0);     \
        TRRD(l0, b_); TRRD(h0, b_ + 2048); TRRD(l1, b_ + 4096); TRRD(h1, b_ + 6144); TRRD(l2, b_ + 8192); TRRD(h2, b_ + 10240); TRRD(l3, b_ + 12288); TRRD(h3, b_ + 14336); \
        asm volatile("s_waitcnt lgkmcnt(0)" ::: "memory"); SBAR();                 \
        o[d0] = __builtin_amdgcn_mfma_f32_32x32x16_bf16(pa0, (bf16x8){l0[0], l0[1], l0[2], l0[3], h0[0], h0[1], h0[2], h0[3]}, o[d0], 0, 0, 0);   \
        o[d0] = __builtin_amdgcn_mfma_f32_32x32x16_bf16(pa1, (bf16x8){l1[0], l1[1], l1[2], l1[3], h1[0], h1[1], h1[2], h1[3]}, o[d0], 0, 0, 0);   \
        o[d0] = __builtin_amdgcn_mfma_f32_32x32x16_bf16(pa2, (bf16x8){l2[0], l2[1], l2[2], l2[3], h2[0], h2[1], h2[2], h2[3]}, o[d0], 0, 0, 0);   \
        o[d0] = __builtin_amdgcn_mfma_f32_32x32x16_bf16(pa3, (bf16x8){l3[0], l3[1], l3[2], l3[3], h3[0], h3[1], h3[2], h3[3]}, o[d0], 0, 0, 0); } while (0)
    PV_D0(0); PV_D0(1); PV_D0(2); PV_D0(3);
#undef PV_D0
#undef TRRD
}

template <class TIn, class TOut> struct BlockRef { const TIn* Q; const TIn* K; const TIn* V; TOut* O; int P0; };
template <class TIn> struct Seam {
    bf16x8 qr[8];
    bf16x8 st_v0, st_v1, st_k0, st_k1; f32x4 sf0, sf1, sf2, sf3;
    f32x4 tq[16];
};
__device__ __forceinline__ int swa_jlo(int P0, int W) { const int lowk = P0 - W + 1; return lowk > 0 ? lowk / KVBLK : 0; }
#define ROW(p, k0, rr) ((p) + (size_t)(k0) * KVP + (unsigned)((rr) * KVP + sc))
#define VMW() asm volatile("s_waitcnt vmcnt(0)" ::: "memory")
#define VMWN(n) asm volatile("s_waitcnt vmcnt(%0)" :: "i"(n) : "memory")
#define SLOAD_H(Kp, Vp, k0) do { S.st_v0 = load8<TIn>(ROW(Vp, k0, sr)); S.st_v1 = load8<TIn>(ROW(Vp, k0, 32 + sr));              \
                         S.st_k0 = load8<TIn>(ROW(Kp, k0, sr)); S.st_k1 = load8<TIn>(ROW(Kp, k0, 32 + sr)); } while (0)
#define SWRITE_HK(bf) do { *(bf16x8*)(K_lds + (bf) * SHM_K + kws) = S.st_k0; *(bf16x8*)(K_lds + (bf) * SHM_K + kws + 32 * 256) = S.st_k1; } while (0)
#define SWRITE_HV(bf) do { *(bf16x8*)(V_lds + (bf) * SHM_V + vst0) = S.st_v0; *(bf16x8*)(V_lds + (bf) * SHM_V + vst1) = S.st_v1; } while (0)
#define SWRITE_H(bf) do { SWRITE_HV(bf); SWRITE_HK(bf); } while (0)
#define SLOAD_F(p, k0) do { S.sf0 = *(const f32x4*)ROW(p, k0, sr); S.sf1 = *(const f32x4*)(ROW(p, k0, sr) + 4);                \
                            S.sf2 = *(const f32x4*)ROW(p, k0, 32 + sr); S.sf3 = *(const f32x4*)(ROW(p, k0, 32 + sr) + 4); } while (0)
#define SWRITE_KF(bf) do { *(bf16x8*)(K_lds + (bf) * SHM_K + kws) = pack8(S.sf0, S.sf1); *(bf16x8*)(K_lds + (bf) * SHM_K + kws + 32 * 256) = pack8(S.sf2, S.sf3); } while (0)
#define SWRITE_VF(bf) do { *(bf16x8*)(V_lds + (bf) * SHM_V + vst0) = pack8(S.sf0, S.sf1); *(bf16x8*)(V_lds + (bf) * SHM_V + vst1) = pack8(S.sf2, S.sf3); } while (0)
template <class TIn, class TOut, int QP, int KVP, int OPI>
__device__ __forceinline__ void causal_swa_prime(const BlockRef<TIn, TOut>& cur, int W, char* lds, Seam<TIn>& S) {
    constexpr bool F32 = same_t<TIn, float>::v;
    int tid_ = threadIdx.x; asm volatile("" : "+v"(tid_)); const int tid = tid_, wid = __builtin_amdgcn_readfirstlane(tid >> 6), lane = tid & 63, r32 = lane & 31, hi = lane >> 5;
    const int sr = tid >> 4, sc = (tid & 15) * 8, kws = KSWZ(sr, sc * 2); char* K_lds = lds + 2 * SHM_V;
    const int kb0 = swa_jlo(cur.P0, W) * KVBLK;
    for (int d0 = 0; d0 < 8; ++d0) S.qr[d0] = load8<TIn>(cur.Q + (unsigned)((wid * QBLK + r32) * QP + d0 * 16 + hi * 8));
    if constexpr (F32) { SLOAD_F((const float*)cur.K, kb0); VMW(); SWRITE_KF(0); SBAR(); SLOAD_F((const float*)cur.V, kb0); }
    else { SLOAD_H(cur.K, cur.V, kb0); VMW(); SWRITE_HK(0); }
    __syncthreads();
}
template <class TIn, class TOut, int QP, int KVP, int OPI>
__device__ __forceinline__ void causal_swa_block(const BlockRef<TIn, TOut>& cur, const BlockRef<TIn, TOut>& nxt, int skv, int W, char* lds, Seam<TIn>& S) {
    constexpr bool F32 = same_t<TIn, float>::v;
    int tid_ = threadIdx.x; asm volatile("" : "+v"(tid_)); const int tid = tid_, wid = __builtin_amdgcn_readfirstlane(tid >> 6), lane = tid & 63, r32 = lane & 31, hi = lane >> 5;
    const int j_lo = swa_jlo(cur.P0, W);
    int j_hi = (cur.P0 + QB - 1) / KVBLK + 1; if (j_hi > skv / KVBLK) j_hi = skv / KVBLK;
    const int NT = j_hi - j_lo;
    const int kbn = swa_jlo(nxt.P0, W) * KVBLK;
    const int qlo = cur.P0 + wid * QBLK, qm = qlo + r32 - 4 * hi;
    char* V_lds = lds; char* K_lds = lds + 2 * SHM_V;
    float* ws = (float*)(lds + 2 * SHM_V + 2 * SHM_K) + wid * 64; float* li_l = ws, * al_l = ws + 32;
    float m_reg = -1e30f, l_reg = 0; f32x16 o[4] = {};
    const int sr = tid >> 4, sc = (tid & 15) * 8, vst0 = v_st(sr, sc), vst1 = v_st(32 + sr, sc), kws = KSWZ(sr, sc * 2);
    const int vb0 = (int)(uintptr_t)V_lds + v_rd_base(lane);
    const TIn* Kh = cur.K; const TIn* Vh = cur.V;
#define RESC(a) do { if (__any((a) < 1.f)) { if (hi == 0) al_l[r32] = (a); asm volatile("s_waitcnt lgkmcnt(0)" ::: "memory");              \
                     for (int d_ = 0; d_ < 4; ++d_) for (int r = 0; r < 16; ++r) o[d_][r] *= al_l[crow(r, hi)]; } } while (0)
#define KBASE(t) ((j_lo + (t)) * KVBLK)
#define ACT(t) (KBASE(t) <= qlo + QBLK - 1 && KBASE(t) + KVBLK - 1 >= qlo - W + 1)
#define MASKT(P0_, P1_, t) do { const int kb_ = KBASE(t); if ((!SK || ACT(t)) && (kb_ + KVBLK - 1 > qlo || kb_ <= qlo + QBLK - 1 - W)) mask_tile(P0_, P1_, qm - kb_, (unsigned)W); } while (0)
    constexpr int NQL = F32 ? 16 : 8;
    constexpr bool SK = WSKIP && !F32;
#define SEAM_K0() do { VMWN(NQL); if constexpr (F32) { SWRITE_KF(0); SBAR(); SLOAD_F((const float*)nxt.V, kbn); } else { SWRITE_HK(0); } SBAR(); } while (0)
    f32x16 pA0, pA1, pB0, pB1; float mnA, mnB, alA, alB; bf16x8 pa0, pa1, pa2, pa3;
    if constexpr (F32) { VMW(); SWRITE_VF(0); SBAR(); } else { SWRITE_HV(0); SBAR(); }
    if (NT > 1) { if constexpr (F32) SLOAD_F((const float*)Kh, KBASE(1)); else SLOAD_H(Kh, Vh, KBASE(1)); }
    SBAR(); qkt<0, SK>(pA0, pA1, K_lds, r32, hi, S.qr, ACT(0));
    if constexpr (F32) { if (NT > 1) { VMW(); SWRITE_KF(1); SBAR(); SLOAD_F((const float*)Vh, KBASE(1)); } }
    MASKT(pA0, pA1, 0); partialSM(pA0, pA1, m_reg, mnA, alA);
    if (NT > 1) { VMW(); if constexpr (F32) { SWRITE_VF(1); SBAR(); if (NT > 2) SLOAD_F((const float*)Kh, KBASE(2)); } else SWRITE_H(1); }
    __syncthreads();
#define HALF_STEP(PX0, PX1, mnX, alX, PY0, PY1, alY, t, KB, VB, SB) do {                                                      \
        SBAR(); qkt<KB, SK>(PX0, PX1, K_lds, r32, hi, S.qr, ACT(t));                                             \
        finishSM(PY0, PY1, alY, l_reg, pa0, pa1, pa2, pa3); SBAR();                                                           \
        if ((t) + 1 < NT) { if constexpr (F32) { VMW(); SWRITE_KF(SB); SBAR(); SLOAD_F((const float*)Vh, KBASE((t) + 1)); }  \
                            else { SLOAD_H(Kh, Vh, KBASE((t) + 1)); } SBAR(); }                                               \
        pv_tile<VB, SK>(o, vb0, pa0, pa1, pa2, pa3, ACT((t) - 1)); MASKT(PX0, PX1, (t)); partialSM(PX0, PX1, m_reg, mnX, alX);                                        \
        __syncthreads();                                                                                                      \
        if ((t) + 1 < NT) { VMW(); if constexpr (F32) { SWRITE_VF(SB); SBAR(); if ((t) + 2 < NT) SLOAD_F((const float*)Kh, KBASE((t) + 2)); } \
                            else { SWRITE_H(SB); } }                                                                          \
        RESC(alX); __syncthreads(); } while (0)
    for (int t = 1; t + 1 < NT; t += 2) {
        HALF_STEP(pB0, pB1, mnB, alB, pA0, pA1, alA, t, 1, 0, 0);
        HALF_STEP(pA0, pA1, mnA, alA, pB0, pB1, alB, t + 1, 0, 1, 1);
    }
    const bool even = (NT & 1) == 0;
    if (even) { SBAR(); qkt<1, SK>(pB0, pB1, K_lds, r32, hi, S.qr, ACT(NT - 1)); SBAR(); }
#define QROW(e) (nxt.Q + (size_t)(wid * QBLK + r32) * QP + ((e) >> 1) * 16 + hi * 8 + ((e) & 1) * 4)
    if constexpr (F32) { SLOAD_F((const float*)nxt.K, kbn); SBAR();
#pragma unroll
        for (int e = 0; e < 8; ++e) S.tq[e] = *(const f32x4*)QROW(e); }
    else { SLOAD_H(nxt.K, nxt.V, kbn); SBAR();
#pragma unroll
        for (int d0 = 0; d0 < 8; ++d0) S.qr[d0] = load8<TIn>(nxt.Q + (unsigned)((wid * QBLK + r32) * QP + d0 * 16 + hi * 8)); }
    SBAR();
    finishSM(pA0, pA1, alA, l_reg, pa0, pa1, pa2, pa3); SBAR();
    if constexpr (F32) {
#pragma unroll
        for (int e = 8; e < 16; ++e) S.tq[e] = *(const f32x4*)QROW(e); SBAR(); }
#undef QROW
    pv_tile<0, SK>(o, vb0, pa0, pa1, pa2, pa3, ACT(even ? NT - 2 : NT - 1));
    if (even) { MASKT(pB0, pB1, NT - 1); partialSM(pB0, pB1, m_reg, mnB, alB); __syncthreads(); RESC(alB);
        finishSM(pB0, pB1, alB, l_reg, pa0, pa1, pa2, pa3); SBAR(); pv_tile<1, SK>(o, vb0, pa0, pa1, pa2, pa3, ACT(NT - 1)); }
    SBAR(); SEAM_K0();
    if (hi == 0) li_l[r32] = l_reg; asm volatile("s_waitcnt lgkmcnt(0)" ::: "memory");
    float rli[16];
#pragma unroll
    for (int r = 0; r < 16; ++r) rli[r] = __builtin_amdgcn_rcpf(li_l[crow(r, hi)]);
    TOut* Ow = cur.O + (unsigned)((wid * QBLK) * OPI);
#pragma unroll
    for (int r = 0; r < 16; ++r) { const int orow = crow(r, hi);
#pragma unroll
        for (int d0 = 0; d0 < 4; ++d0) { const float v = o[d0][r] * rli[r];
            if constexpr (same_t<TOut, float>::v) { Ow[(size_t)orow * OPI + d0 * 32 + r32] = v; }
            else { const float vn = __shfl_xor(v, 1);
                   if ((r32 & 1) == 0) *(unsigned*)(Ow + (unsigned)(orow * OPI + d0 * 32 + r32)) = cvtpk(v, vn); } } }
    if constexpr (F32) {
#pragma unroll
        for (int d0 = 0; d0 < 8; ++d0) S.qr[d0] = pack8(S.tq[2 * d0], S.tq[2 * d0 + 1]); }
    __syncthreads();
#undef RESC
#undef KBASE
#undef ACT
#undef MASKT
#undef SEAM_K0
#undef HALF_STEP
}
#undef ROW
#undef VMW
#undef VMWN
#undef SLOAD_H
#undef SWRITE_HK
#undef SWRITE_HV
#undef SWRITE_H
#undef SLOAD_F
#undef SWRITE_KF
#undef SWRITE_VF

}

#ifndef ATT_SATMODE
#define ATT_SATMODE 1
#endif
#if ATT_SATMODE
#define ATT_CL(x) (x)
#else
#define ATT_CL(x) fminf((x), 448.f)
#endif
#ifndef ATT_STATPRIO
#define ATT_STATPRIO 0
#endif
#ifndef ATT_PSH
#define ATT_PSH 1.0f
#endif
#ifndef ATT_TAU
#define ATT_TAU 3.0f
#endif
#ifndef ATT_SCHED
#define ATT_SCHED { _Pragma("unroll") for (int sg_ = 0; sg_ < 6; ++sg_) { __builtin_amdgcn_sched_group_barrier(0x008, 1, 0); __builtin_amdgcn_sched_group_barrier(0x402, ATT_VPM, 0); } }
#endif
#ifndef ATT_VPM
#define ATT_VPM 10
#endif
namespace att2 {
using att::bf16; using att::bf16x8; using att::s16x4; using att::f32x16; using att::f32x4; using att::u32x4;
constexpr float SCALE = 0.08838834764831845f;
constexpr int MX3_OFF = 132096  , AL3_OFF = MX3_OFF + 2048, LI3_OFF = AL3_OFF + 1024;
constexpr int V7_OFF = 0  , K7_OFF = 32768  , PB7_OFF = 49152  ;
template <int OPI>
__device__ __forceinline__ void diff_block7(const unsigned char* Q8, const unsigned char* K8, const unsigned char* VT8, bf16* O, int P0, char* lds) {
    typedef int v4i_ __attribute__((ext_vector_type(4))); typedef int v8i_ __attribute__((ext_vector_type(8)));
    typedef __attribute__((address_space(1))) unsigned char gcu8_; typedef __attribute__((address_space(1))) v4i_ gv4i_;
    int tid_ = threadIdx.x; asm volatile("" : "+v"(tid_));
    const int tid = tid_, wid = __builtin_amdgcn_readfirstlane(tid >> 6), lane = tid & 63, r32 = lane & 31, hi = lane >> 5;
    const int pr = wid & 3, role = wid >> 2;
    const int NT = P0 / 64 + 2;
    char* V_lds = lds + V7_OFF; char* K_lds = lds + K7_OFF; char* pb_l = lds + PB7_OFF;
    float* mx_l = (float*)(lds + MX3_OFF); float* al_l = (float*)(lds + AL3_OFF) + wid * 32; float* li_l = (float*)(lds + LI3_OFF);
    const int kkey = role * 32 + r32, ksw = (kkey >> 1) & 7;
    const char* kbase = K_lds + kkey * 128;
    const int skey = tid >> 3, sch = tid & 7, kws8 = skey * 128 + ((sch ^ ((skey >> 1) & 7)) << 4);
    const int svr = tid >> 2, sg0 = (tid & 3) * 4;
    int vws[4];
#pragma unroll
    for (int e = 0; e < 4; ++e) { const int g = sg0 + e, d = (g & 1) * 8 + 4 * (g >> 3) + ((g & 7) >> 1); vws[e] = svr * 64 + ((((d >> 2) ^ ((svr >> 2) & 3)) << 2) | (d & 3)) * 4; }
    const int vrow = role * 128 + r32, vsw = (vrow >> 2) & 3;
    const char* vbase = V_lds + vrow * 64;
    const int vc0 = ((2 * hi) ^ vsw) << 4, vc1 = ((2 * hi + 1) ^ vsw) << 4;
    const int qpos = P0 + pr * 32 + r32, qlo = P0 + pr * 32;
    constexpr float C2 = 1.4426950408889634f * SCALE;
    v8i_ qr8[2];
#pragma unroll
    for (int c = 0; c < 2; ++c) { const unsigned char* qp = Q8 + (unsigned)((pr * 32 + r32) * 2048 + 64 * c + 32 * hi);
        qr8[c] = __builtin_shufflevector(*(const v4i_*)qp, *(const v4i_*)(qp + 16), 0, 1, 2, 3, 4, 5, 6, 7); }
    typedef __attribute__((address_space(3))) unsigned las_u32_;
    const int dk_key = wid * 8 + (lane >> 3);
    unsigned dk_off = (unsigned)(dk_key * 2048 + (((lane & 7) ^ ((dk_key >> 1) & 7)) << 4));
    const int dv_r0 = wid * 32 + (lane >> 2), dv_r1 = dv_r0 + 16;
    unsigned dv_off0 = (unsigned)(dv_r0 * 16384 + (((lane & 3) ^ ((dv_r0 >> 2) & 3)) << 4)), dv_off1 = (unsigned)(dv_r1 * 16384 + (((lane & 3) ^ ((dv_r1 >> 2) & 3)) << 4));
    asm volatile("" : "+v"(dk_off), "+v"(dv_off0), "+v"(dv_off1));
#define DMAK(bf, k0) do { const gcu8_* kp_ = (const gcu8_*)K8 + (size_t)(k0) * 2048; asm volatile("" : "+s"(kp_)); \
        __builtin_amdgcn_global_load_lds((const __attribute__((address_space(1))) unsigned*)(kp_ + dk_off), (las_u32_*)(K_lds + (bf) * 8192 + wid * 1024), 16, 0, 0); } while (0)
#define DMAV(bf, k0) do { const gcu8_* vp_ = (const gcu8_*)VT8 + (k0); asm volatile("" : "+s"(vp_)); \
        __builtin_amdgcn_global_load_lds((const __attribute__((address_space(1))) unsigned*)(vp_ + dv_off0), (las_u32_*)(V_lds + (bf) * 16384 + wid * 2048), 16, 0, 0); \
        __builtin_amdgcn_global_load_lds((const __attribute__((address_space(1))) unsigned*)(vp_ + dv_off1), (las_u32_*)(V_lds + (bf) * 16384 + wid * 2048 + 1024), 16, 0, 0); } while (0)
#define VMW() asm volatile("s_waitcnt vmcnt(0)" ::: "memory")
#define QKM(dst, BUF) do { dst = (f32x16){}; \
        _Pragma("unroll") for (int c = 0; c < 2; ++c) { const char* kp2_ = kbase + (BUF) * 8192; \
            const v8i_ kf = __builtin_shufflevector(*(const v4i_*)(kp2_ + (((4 * c + 2 * hi) ^ ksw) << 4)), *(const v4i_*)(kp2_ + (((4 * c + 2 * hi + 1) ^ ksw) << 4)), 0, 1, 2, 3, 4, 5, 6, 7); \
            dst = __builtin_amdgcn_mfma_scale_f32_32x32x64_f8f6f4(kf, qr8[c], dst, 0, 0, 0, 0x7F7F7F7F, 0, 0x7F7F7F7F); } } while (0)
#define MASK(p, t) \
        { const int kb_ = (t) * 64 + role * 32; if (kb_ + 31 > qlo) { const int dq = qpos - kb_ - 4 * hi; const float NEG = -__builtin_inff(); \
            _Pragma("unroll") for (int r = 0; r < 16; ++r) { const int c = (r & 3) + 8 * (r >> 2); if (c > dq) p[r] = NEG; } } }
#define MX3(a, b, c) fmaxf(fmaxf((a), (b)), (c))
#define PMAX(p) \
        float pmax = fmaxf(MX3(MX3(p[0], p[1], p[2]), MX3(p[3], p[4], p[5]), MX3(p[6], p[7], p[8])), MX3(MX3(p[9], p[10], p[11]), MX3(p[12], p[13], p[14]), p[15])); \
        { auto rr_ = __builtin_amdgcn_permlane32_swap(__float_as_uint(pmax), __float_as_uint(pmax), false, false); pmax = MX3(__uint_as_float(rr_[0]), __uint_as_float(rr_[1]), -3.0e38f); }
#define SOFTPUB(p, SL) \
        { p = p * C2 + mnL;                                                \
          _Pragma("unroll") for (int r = 0; r < 16; ++r) p[r] = __builtin_amdgcn_exp2f(p[r]); \
          l4 += ((f32x4){p[0], p[1], p[2], p[3]} + (f32x4){p[4], p[5], p[6], p[7]}) + ((f32x4){p[8], p[9], p[10], p[11]} + (f32x4){p[12], p[13], p[14], p[15]}); }     \
        { _Pragma("unroll") for (int q4 = 0; q4 < 4; ++q4) ownw[q4] = (int)pg8::pk_fp8x4o(ATT_CL(p[4 * q4]), ATT_CL(p[4 * q4 + 1]), ATT_CL(p[4 * q4 + 2]), ATT_CL(p[4 * q4 + 3]), ownw[q4]); mx_own = pmax; \
          *(v4i_*)(pb_l + (SL) * 8192 + wid * 1024 + lane * 16) = ownw; } \
        if (hi == 0) mx_l[(SL) * 256 + wid * 32 + r32] = pmax;
#define PVLOAD(VB, SL) \
        const v4i_ h0 = *(const v4i_*)(pb_l + (SL) * 8192 + (wid & 3) * 1024 + lane * 16), h1 = *(const v4i_*)(pb_l + (SL) * 8192 + ((wid & 3) + 4) * 1024 + lane * 16); \
        v8i_ vf[4]; _Pragma("unroll") for (int d0 = 0; d0 < 4; ++d0) { const char* vp3_ = vbase + (VB) * 16384 + d0 * 2048; \
            vf[d0] = __builtin_shufflevector(*(const v4i_*)(vp3_ + vc0), *(const v4i_*)(vp3_ + vc1), 0, 1, 2, 3, 4, 5, 6, 7); }
#define PVMMA(SCA) do { const v8i_ pa = __builtin_shufflevector(h0, h1, 0, 1, 2, 3, 4, 5, 6, 7); \
        _Pragma("unroll") for (int d0 = 0; d0 < 4; ++d0) o[d0] = __builtin_amdgcn_mfma_scale_f32_32x32x64_f8f6f4(pa, vf[d0], o[d0], 0, 0, 0, (SCA), 0, 0x7F7F7F7F); } while (0)
#define PVT(VB, SL) do { PVLOAD(VB, SL) PVMMA(0x7F7F7F7F); } while (0)
    float ref = 0.f, mnL = 0.f, mx_own = 0.f;
    f32x4 l4 = {0.f, 0.f, 0.f, 0.f}; f32x16 o[4] = {};
    f32x16 pA, pB;
    v4i_ ownw = {0, 0, 0, 0};
    DMAK(0, 0); DMAK(1, 64); DMAV(0, 0);
    VMW();
    __syncthreads();
    QKM(pA, 0); QKM(pB, 1);
    MASK(pA, 0) MASK(pB, 1)
    { PMAX(pA)
      if (hi == 0) mx_l[256 + wid * 32 + r32] = pmax;
      __syncthreads();
 ref = __builtin_ceilf(fmaxf(pmax, mx_l[256 + (wid ^ 4) * 32 + r32]) * C2); mnL = ATT_PSH - ref;
      if (2 < NT) DMAK(0, 128);
      SOFTPUB(pA, 0)
      VMW();
      __syncthreads(); }
#define SEG(BUF, t, cur, nxt) do { \
        if ((t) + 2 < NT) DMAK(BUF, ((t) + 2) * 64);                        \
        DMAV(BUF, (t) * 64); \
        const float pm2 = mx_l[((BUF) ^ 1) * 256 + (wid ^ 4) * 32 + r32]; \
        PVLOAD((BUF) ^ 1, (BUF) ^ 1) \
        int sca = 0x7F7F7F7F; \
        { const float mc2 = fmaxf(mx_own, pm2) * C2;                         \
          const bool up_ = mc2 - ref > ATT_TAU;                              \
          if (__any(up_)) { const float rn = up_ ? __builtin_ceilf(mc2) : ref; const float dl = ref - rn; const float alpha = __builtin_amdgcn_exp2f(dl); ref = rn; mnL = ATT_PSH - rn; l4 = l4 * alpha; \
              sca = (127 + (int)dl) * 0x01010101; \
              if (hi == 0) al_l[r32] = alpha; asm volatile("s_waitcnt lgkmcnt(0)" ::: "memory"); \
              _Pragma("unroll") for (int d_ = 0; d_ < 4; ++d_) _Pragma("unroll") for (int r = 0; r < 16; ++r) o[d_][r] *= al_l[att::crow(r, hi)]; } } \
        QKM(nxt, (BUF) ^ 1);                                                \
        PVMMA(sca); \
        { PMAX(cur) \
          SOFTPUB(cur, BUF) } \
        ATT_SCHED \
        if ((t) + 1 < NT) MASK(nxt, (t) + 1) \
        VMW(); \
        __syncthreads(); \
    } while (0)
    SEG(1, 1, pB, pA);
    for (int t = 2; t < NT; t += 2) { SEG(0, t, pA, pB); SEG(1, t + 1, pB, pA); }
    PVT(1, 1);
    float l_reg = (l4[0] + l4[1]) + (l4[2] + l4[3]);
    { auto rr = __builtin_amdgcn_permlane32_swap(__float_as_uint(l_reg), __float_as_uint(l_reg), false, false); l_reg = __uint_as_float(rr[0]) + __uint_as_float(rr[1]); }
    if (hi == 0) li_l[wid * 32 + r32] = l_reg;
    __syncthreads();
    { const float lt = (l_reg + li_l[(wid ^ 4) * 32 + r32]) * 4.0f; if (hi == 0) al_l[r32] = lt; asm volatile("s_waitcnt lgkmcnt(0)" ::: "memory"); }
    float rli[16];
#pragma unroll
    for (int r = 0; r < 16; ++r) rli[r] = __builtin_amdgcn_rcpf(al_l[att::crow(r, hi)]);
    bf16* Ow = O + (unsigned)((pr * 32) * OPI + role * 128);
#pragma unroll
    for (int r = 0; r < 16; ++r) { const int orow = att::crow(r, hi);
#pragma unroll
        for (int d0 = 0; d0 < 4; ++d0) { const float v = o[d0][r] * rli[r]; const float vn = __shfl_xor(v, 1);
            if ((r32 & 1) == 0) *(unsigned*)(Ow + (unsigned)(orow * OPI + d0 * 32 + r32)) = att::cvtpk(v, vn); } }
    __syncthreads();
#undef SEG
#undef PVT
#undef PVMMA
#undef PVLOAD
#undef SOFTPUB
#undef QKM
#undef MASK
#undef PMAX
#undef MX3
#undef VMW
#undef DMAV
#undef DMAK
}
}

constexpr int T = 32768, DM = 2048, SEQ = 16384, INW = 5120, NMEMT = 512, RMAX = 73728;
constexpr int NWAVES = 8;
constexpr float ALPHA = 1.4142135623730951f;
constexpr float LN_EPS = 1e-5f;
constexpr size_t MiB = 1u << 20;
constexpr size_t WS_CTL = 0, CTL_ZERO_BYTES = 1 * MiB;
constexpr size_t WS_CSN = 1 * MiB, WS_LOG = 5 * MiB;
constexpr size_t WS_TOKE = 13 * MiB, WS_TOKW = WS_TOKE + 256 * 1024, WS_TOKD = WS_TOKW + 256 * 1024, WS_WGC = WS_TOKD + 256 * 1024;
constexpr size_t WS_ROWW = 14 * MiB, WS_TILE = WS_ROWW + 512 * 1024, WS_ROWT = WS_TILE + 64 * 1024;
constexpr size_t WS_RS = 15 * MiB, WS_CSQ = 15 * MiB + 512 * 1024;
constexpr size_t WS_MEMB = 16 * MiB, WS_KV = 18 * MiB, WS_VTM = 19 * MiB;
constexpr size_t WS_WIN = 20 * MiB, WS_WOUT = 60 * MiB, WS_XQ = 76 * MiB, WS_XO = 80 * MiB, WS_MEMKV = 84 * MiB, WS_ROUT = 88 * MiB, WS_W13 = 90 * MiB, WS_W2 = 346 * MiB;
constexpr size_t WS_XA = 474 * MiB, WS_XB = 602 * MiB, WS_H = 730 * MiB, WS_QK8 = 1050 * MiB, WS_VT8 = 1114 * MiB, WS_END = 1146 * MiB;
constexpr size_t DO_MIX = 0, DO_OP = 128 * MiB, DO_QC = 0, DO_OC = 32 * MiB, DO_HB = 0;
constexpr int CW_BAR = 4096, CW_HO = 16384;
constexpr int RING_BYTES = 131072;
constexpr int LDSCTL_OFF = RING_BYTES, MISC_OFF = LDSCTL_OFF + 320, SCR_OFF = LDSCTL_OFF + 1024;
constexpr int LDS_BYTES = 147456;

#define GAS __attribute__((address_space(1)))
#define LAS __attribute__((address_space(3)))
typedef unsigned short bf16;
typedef unsigned v4u __attribute__((ext_vector_type(4)));
typedef unsigned v2u __attribute__((ext_vector_type(2)));
typedef float f32x4 __attribute__((ext_vector_type(4)));
typedef float f32x2 __attribute__((ext_vector_type(2)));
typedef float f32x16 __attribute__((ext_vector_type(16)));
typedef short bf16x8 __attribute__((ext_vector_type(8)));
typedef GAS unsigned gu32;
typedef GAS unsigned long long gu64;
#define RLX_AGENT __ATOMIC_RELAXED, __HIP_MEMORY_SCOPE_AGENT
#define LDS_WAIT() asm volatile("s_waitcnt lgkmcnt(0)" ::: "memory")
#define VM_WAIT() asm volatile("s_waitcnt vmcnt(0)" ::: "memory")
__device__ __forceinline__ unsigned f2bf(float f) { unsigned u = __builtin_bit_cast(unsigned, f); return (u + 0x7fffu + ((u >> 16) & 1u)) >> 16; }
__device__ __forceinline__ unsigned pk2(float lo, float hi) { return f2bf(lo) | (f2bf(hi) << 16); }
__device__ __forceinline__ float bflo(unsigned w) { return __uint_as_float(w << 16); }
__device__ __forceinline__ float bfhi(unsigned w) { return __uint_as_float(w & 0xffff0000u); }

#define XB_TMO      128
#define XB_XCNT(j)  (256  + 64 * (j))
#define XB_XSUB(j)  (1280 + 64 * (j))
#define XB_XGEN(j)  (2304 + 64 * (j))
#define XB_TOP      3328
#define XB_TOPGEN   3392
#define XCD_BAR_WORDS 3456
#define XB_SPIN_CAP (1u << 20)

__device__ __forceinline__ unsigned xb_ld(unsigned* p)              { return __hip_atomic_load(p, __ATOMIC_RELAXED, __HIP_MEMORY_SCOPE_AGENT); }
__device__ __forceinline__ unsigned xb_add(unsigned* p, unsigned v) { return __hip_atomic_fetch_add(p, v, __ATOMIC_RELAXED, __HIP_MEMORY_SCOPE_AGENT); }
__device__ __forceinline__ unsigned xb_xcc_id() { return (unsigned)__builtin_amdgcn_s_getreg((3 << 11) | 20) & 0xFu; }
#define XB_SPIN(cond, bar) do { unsigned _sp = 0; while (cond) { __builtin_amdgcn_s_sleep(1); \
    if ((++_sp & 255u) == 0u) { if (xb_ld(&(bar)[XB_TMO])) break; if (_sp > XB_SPIN_CAP) { atomicAdd(&(bar)[XB_TMO], 1u); break; } } } } while (0)

struct XcdBarrier { unsigned* bar; unsigned x; volatile LAS unsigned* st; };
__device__ __forceinline__ XcdBarrier xcd_barrier_post(unsigned* bar, volatile LAS unsigned* st) {
    XcdBarrier b; b.bar = bar; b.x = xb_xcc_id(); b.st = st;
    if (threadIdx.x == 0) (void)xb_add(&bar[XB_XCNT(b.x)], 1u);
    return b;
}
__device__ __forceinline__ void xcd_barrier_complete(unsigned* bar, unsigned x, unsigned& nloc, unsigned& nx) {
    const unsigned G = gridDim.x * gridDim.y * gridDim.z;
    unsigned sum, cnt, mine, sp = 0u;
    for (;;) {
        sum = 0u; cnt = 0u; mine = 0u;
#pragma unroll
        for (unsigned j = 0; j < 16; ++j) { const unsigned c = xb_ld(&bar[XB_XCNT(j)]); sum += c; cnt += (c > 0u) ? 1u : 0u; mine = (j == x) ? c : mine; }
        if (sum == G) break;
        __builtin_amdgcn_s_sleep(1);
        if ((++sp & 255u) == 0u) { if (xb_ld(&bar[XB_TMO])) break; if (sp > XB_SPIN_CAP) { atomicAdd(&bar[XB_TMO], 1u); break; } }
    }
    nloc = mine > 0u ? mine : 1u; nx = cnt > 0u ? cnt : 1u;
}
__device__ __forceinline__ void xcd_barrier(const XcdBarrier& b) {
    asm volatile("s_waitcnt vmcnt(0)" ::: "memory");
    __syncthreads();
    if (threadIdx.x == 0) {
        unsigned* bar = b.bar;
        __builtin_amdgcn_s_waitcnt(0);
        unsigned nloc = b.st[0], nx = b.st[1];
        if (nloc == 0u) { xcd_barrier_complete(bar, b.x, nloc, nx); b.st[0] = nloc; b.st[1] = nx; }
        const unsigned old = xb_add(&bar[XB_XSUB(b.x)], 1u);
        const unsigned gen = old / nloc;
        if (old + 1u == (gen + 1u) * nloc) {
            __builtin_amdgcn_fence(__ATOMIC_RELEASE, "agent");
            asm volatile("s_waitcnt vmcnt(0)" ::: "memory");
            const unsigned og = xb_add(&bar[XB_TOP], 1u);
            const unsigned tg = og / nx;
            if (og + 1u == (tg + 1u) * nx) xb_add(&bar[XB_TOPGEN], 1u);
            else XB_SPIN(xb_ld(&bar[XB_TOPGEN]) == tg, bar);
            __builtin_amdgcn_fence(__ATOMIC_ACQUIRE, "agent");
            xb_add(&bar[XB_XGEN(b.x)], 1u);
            asm volatile("s_waitcnt vmcnt(0)" ::: "memory");
        } else {
            XB_SPIN(xb_ld(&bar[XB_XGEN(b.x)]) == gen, bar);
            __builtin_amdgcn_fence(__ATOMIC_ACQUIRE, "agent");
            asm volatile("s_waitcnt vmcnt(0)" ::: "memory");
        }
    }
    __syncthreads();
}

struct Args { const void* in[35]; unsigned char* out; unsigned char* ws; int ph_lo, ph_hi; };
struct Frame {
    LAS unsigned char* lds; volatile LAS unsigned* MISC;
    int tid, lane, wave, G, bx;
};
constexpr int TAB_OFF = LDSCTL_OFF + 512;
__device__ __forceinline__ unsigned char* tabp(const Frame& F, int k) {
    const volatile LAS unsigned* t = (const volatile LAS unsigned*)(F.lds + TAB_OFF) + 2 * k;
    const unsigned lo = __builtin_amdgcn_readfirstlane(t[0]), hi = __builtin_amdgcn_readfirstlane(t[1]);
    return (unsigned char*)((GAS unsigned char*)(((unsigned long long)hi << 32) | lo));
}
#define INP(k) ((const float*)tabp(F, (k)))
#define INPI(k) ((const int*)tabp(F, (k)))
#define WSP() (tabp(F, 36))
#define OUTP() (tabp(F, 35))
__device__ __forceinline__ void refresh(Frame& F) {
    int t = F.tid; asm volatile("" : "+v"(t)); F.tid = t; F.lane = t & 63; F.wave = __builtin_amdgcn_readfirstlane(t >> 6);
    int g = F.G, b = F.bx; asm volatile("" : "+s"(g), "+s"(b)); F.G = g; F.bx = b;
}
__device__ __forceinline__ float wave_sum(float v) {
#pragma unroll
    for (int o = 1; o < 64; o <<= 1) v += __shfl_xor(v, o);
    return v;
}
__constant__ double INVF_REV[16] = {0.15915494309189535, 0.0700865215877985, 0.03086376340470123, 0.013591370636193905, 0.005985185712713705, 0.002635675898667414,
    0.001160663641240061, 0.0005111175045375439, 0.00022507907903927653, 9.911730936901935e-05, 4.364795279280289e-05, 1.9221100684944863e-05,
    8.464330808241401e-06, 3.727408601915352e-06, 1.6414262627950345e-06, 7.228293068832865e-07};

struct TDesc { const float* src; bf16* dst; int N, K; const float* gs; };
__device__ __forceinline__ TDesc tr_decode(const Frame& F, unsigned char* ws, int it) {
    int r = it; const float* W; bf16* WT; int K, N, nblk, q; int mode = 0; const float* gs = nullptr;
    if (r < 5120) { const int l = r / 2560; q = r % 2560; W = INP(3) + (size_t)l * 2048 * 5120; K = 2048; N = 5120; nblk = 80; WT = (bf16*)(ws + WS_WIN) + (size_t)l * 5120 * 2048; if (l == 0) mode = 4; }
    else if ((r -= 5120) < 2048) { const int l = r / 1024; q = r % 1024; W = INP(4) + (size_t)l * 2048 * 2048; K = 2048; N = 2048; nblk = 32; WT = (bf16*)(ws + WS_WOUT) + (size_t)l * 2048 * 2048; }
    else if ((r -= 2048) < 512) { const int l = r / 256; q = r % 256; W = INP(26) + (size_t)l * 2048 * 512; K = 2048; N = 512; nblk = 8; WT = (bf16*)(ws + WS_XQ) + (size_t)l * 512 * 2048; gs = INP(5) + l * 2048; }
    else if ((r -= 512) < 512) { const int l = r / 256; q = r % 256; W = INP(27) + (size_t)l * 512 * 2048; K = 512; N = 2048; nblk = 32; WT = (bf16*)(ws + WS_XO) + (size_t)l * 2048 * 512; }
    else if ((r -= 512) < 512) { q = r; W = INP(25); K = 2048; N = 1024; nblk = 16; WT = (bf16*)(ws + WS_MEMKV); }
    else if ((r -= 512) < 16384) { const int le = r / 256; q = r % 256; W = INP(32) + (size_t)le * 2048 * 512; K = 2048; N = 512; nblk = 8; WT = (bf16*)(ws + WS_W13) + (size_t)le * 1024 * 2048; mode = 1; }
    else if ((r -= 16384) < 16384) { const int le = r / 256; q = r % 256; W = INP(33) + (size_t)le * 2048 * 512; K = 2048; N = 512; nblk = 8; WT = (bf16*)(ws + WS_W13) + (size_t)le * 1024 * 2048; mode = 2; }
    else { r -= 16384; const int le = r / 256; q = r % 256; W = INP(34) + (size_t)le * 512 * 2048; K = 512; N = 2048; nblk = 32; WT = (bf16*)(ws + WS_W2) + (size_t)le * 2048 * 512; }
    const int kb = q / nblk, nb = q % nblk, n0 = 64 * nb, k0 = 64 * kb;
    int drow = n0; if (mode == 1 || mode == 2) drow = (n0 >> 7) * 256 + (n0 & 127) + (mode == 2 ? 128 : 0);
    if (mode == 4) { mode = 0;
        if (n0 >= 4096) { const int cc = n0 - 4096; drow = 3072 + (cc >> 7) * 256 + 128 + (cc & 127); } else if (n0 >= 3072) { const int cc = n0 - 3072; drow = 3072 + (cc >> 7) * 256 + (cc & 127); } }
    TDesc d; d.src = W + (size_t)k0 * N + n0 + F.lane; d.dst = WT + (size_t)drow * K + k0; d.N = N; d.K = K; d.gs = gs ? gs + k0 : nullptr; return d;
}
#define TR_LOAD(d, wv) do { _Pragma("unroll") for (int i_ = 0; i_ < 64; ++i_) wv[i_] = __builtin_nontemporal_load((d).src + (size_t)i_ * (d).N); } while (0)
#define TR_STORE(d, wv) do { \
        if ((d).gs) { _Pragma("unroll") for (int i_ = 0; i_ < 64; ++i_) wv[i_] *= (d).gs[i_]; } \
        _Pragma("unroll") for (int i_ = 0; i_ < 32; ++i_) scr[F.lane * 33 + i_] = pk2(wv[2 * i_], wv[2 * i_ + 1]); \
        LDS_WAIT(); asm volatile("" ::: "memory"); \
        { const int c_ = F.lane & 7; \
          _Pragma("unroll") for (int j_ = 0; j_ < 8; ++j_) { const int n_ = (F.lane >> 3) + 8 * j_; const LAS unsigned* s_ = scr + n_ * 33 + 4 * c_; \
              v4u o_; o_.x = s_[0]; o_.y = s_[1]; o_.z = s_[2]; o_.w = s_[3]; \
              __builtin_nontemporal_store(o_, (v4u*)((d).dst + (size_t)n_ * (d).K + 8 * c_)); } } \
        LDS_WAIT(); asm volatile("" ::: "memory"); } while (0)
__device__ __forceinline__ void p_prologue(Frame& F, int dummy_) {
    unsigned char* ws = WSP();
    LAS unsigned* scr = (LAS unsigned*)(F.lds + F.wave * 16384);
    const int gw = F.bx * NWAVES + F.wave, NGW = F.G * NWAVES;
    constexpr int NITEMS = 5120 + 2048 + 512 + 512 + 512 + 16384 * 3;
    if (gw < NITEMS) {
        int it = gw; TDesc da = tr_decode(F, ws, it), db = da; float A[64], B[64]; TR_LOAD(da, A);
        for (;;) {
            const int itb = it + NGW; const bool hb = itb < NITEMS;
            if (hb) { db = tr_decode(F, ws, itb); TR_LOAD(db, B); }
            TR_STORE(da, A);
            if (!hb) break;
            const int ita = itb + NGW; const bool ha = ita < NITEMS;
            if (ha) { da = tr_decode(F, ws, ita); TR_LOAD(da, A); }
            TR_STORE(db, B);
            if (!ha) break;
            it = ita;
        }
    }
    const int gt = F.bx * 512 + F.tid, NT = F.G * 512;
    { bf16* RO = (bf16*)(ws + WS_ROUT); const float* rg = INP(28); const float* re = INP(30);
      for (int i = gt; i < 2 * 256 * 2048; i += NT) { const int l = i >> 19, n = (i >> 11) & 255, k = i & 2047;
          float v = 0.f; if (n < 4) v = rg[(size_t)l * 2048 * 4 + k * 4 + n]; else if (n < 36) v = re[(size_t)l * 2048 * 32 + k * 32 + (n - 4)];
          RO[i] = (bf16)f2bf(v); } }
    { const f32x4* x = (const f32x4*)INP(0); v4u* xa = (v4u*)(ws + WS_XA);
      for (int i0 = gt; i0 < T * DM / 8; i0 += 4 * NT) { f32x4 p[4], q[4];
#pragma unroll
          for (int u = 0; u < 4; ++u) { const int i = i0 + u * NT; if (i < T * DM / 8) { p[u] = __builtin_nontemporal_load(x + 2 * (size_t)i); q[u] = __builtin_nontemporal_load(x + 2 * (size_t)i + 1); } }
#pragma unroll
          for (int u = 0; u < 4; ++u) { const int i = i0 + u * NT; if (i < T * DM / 8) { v4u o; o.x = pk2(p[u][0], p[u][1]); o.y = pk2(p[u][2], p[u][3]); o.z = pk2(q[u][0], q[u][1]); o.w = pk2(q[u][2], q[u][3]); __builtin_nontemporal_store(o, xa + i); } } }
      const f32x4* m = (const f32x4*)INP(1); v4u* mb = (v4u*)(ws + WS_MEMB);
      for (int i = gt; i < NMEMT * DM / 8; i += NT) { const f32x4 p = m[2 * (size_t)i], q = m[2 * (size_t)i + 1]; v4u o; o.x = pk2(p[0], p[1]); o.y = pk2(p[2], p[3]); o.z = pk2(q[0], q[1]); o.w = pk2(q[2], q[3]); mb[i] = o; } }
    { const float* wq = INP(26); const float* g1 = INP(5); const float* b1 = INP(6); float* csq = (float*)(ws + WS_CSQ); LAS float* red = (LAS float*)(F.lds + SCR_OFF);
      for (int blk = F.bx; blk < 256; blk += F.G) { const int l = blk >> 7, n0 = (blk & 127) * 4, c = F.tid & 3, ks = F.tid >> 2;
          float s = 0.f, q = 0.f;
#pragma unroll
          for (int i = 0; i < 16; ++i) { const int k = ks * 16 + i; const float w = wq[((size_t)l * 2048 + k) * 512 + n0 + c]; s += __uint_as_float(f2bf(g1[l * 2048 + k] * w) << 16); q += b1[l * 2048 + k] * w; }
#pragma unroll
          for (int o = 4; o < 64; o <<= 1) { s += __shfl_xor(s, o); q += __shfl_xor(q, o); }
          __syncthreads();
          if (F.lane < 4) { red[F.wave * 8 + F.lane * 2] = s; red[F.wave * 8 + F.lane * 2 + 1] = q; }
          __syncthreads();
          if (F.tid < 8) { float a = 0.f;
#pragma unroll
              for (int w8 = 0; w8 < 8; ++w8) a += red[w8 * 8 + F.tid];
              csq[l * 1024 + (F.tid & 1) * 512 + n0 + (F.tid >> 1)] = a; } } }
    { const int* pos = INPI(2); float* csn = (float*)(ws + WS_CSN);
      for (int i = gt; i < T * 16; i += NT) { const int row = i >> 4, j = i & 15; double rev = (double)pos[row] * INVF_REV[j]; rev -= __builtin_rint(rev); const float f = (float)rev;
          csn[row * 32 + j] = __builtin_amdgcn_cosf(f); csn[row * 32 + 16 + j] = __builtin_amdgcn_sinf(f); } }
}

typedef att::BlockRef<att::bf16, att::bf16> ABlk;
#define DIFFBLK diff_block3
__device__ __forceinline__ void p_diff_attn2(Frame& F, char* lds, const bf16* H, bf16* OP) {
#if ATT_SATMODE
    __builtin_amdgcn_s_setreg((0 << 11) | (23 << 6) | 1, 1);
#endif
#if ATT_STATPRIO
    if (F.wave >= 4) __builtin_amdgcn_s_setprio(1);
#endif
    for (int L = F.bx; L < 1024; L += F.G) {
        const int c = L & 255, i = L >> 8, x = c & 7, k = c >> 3, combo = 2 * x + (i >> 1), b = combo >> 3, h = (combo >> 1) & 3, m = combo & 1, j = (i & 1) * 32 + k;
        const size_t row0 = (size_t)b * SEQ;
        for (int pass = 0; pass < 2; ++pass) { const int qb = pass ? 127 - j : j;
            const unsigned char* QK8 = WSP() + WS_QK8; const unsigned char* VT8 = WSP() + WS_VT8;
            att2::diff_block7<2048>(QK8 + (row0 + (size_t)qb * 128) * 2048 + (2 * h + m) * 128, QK8 + row0 * 2048 + 1024 + (2 * h + m) * 128,
                VT8 + ((size_t)b * 1024 + h * 256) * 16384, (att::bf16*)(OP + (row0 + (size_t)qb * 128) * 2048 + m * 1024 + h * 256), qb * 128, lds); }
    }
#if ATT_STATPRIO
    __builtin_amdgcn_s_setprio(0);
#endif
#if ATT_SATMODE
    __builtin_amdgcn_s_setreg((0 << 11) | (23 << 6) | 1, 0);
#endif
}
__device__ __forceinline__ ABlk cross_ref(const bf16* QC, const bf16* KV, bf16* OC, int L) {
    const int b = L >> 8, head = (L >> 6) & 3, qb = L & 63;
    ABlk r; const size_t row0 = (size_t)b * SEQ + (size_t)qb * 256;
    r.Q = (const att::bf16*)(QC + row0 * 512 + head * 128);
    r.K = (const att::bf16*)(KV + (size_t)b * 256 * 1024 + head * 128);
    r.V = (const att::bf16*)(KV + (size_t)b * 256 * 1024 + 512 + head * 128);
    r.O = (att::bf16*)(OC + row0 * 512 + head * 128);
    r.P0 = 1 << 20; return r;
}
__device__ __forceinline__ void p_cross_attn(Frame& F, char* lds, const bf16* QC, const bf16* KV, bf16* OC) {
    const int nblk = (512 - F.bx + F.G - 1) / F.G;
    if (nblk <= 0) return;
    att::Seam<att::bf16> S;
    ABlk cur = cross_ref(QC, KV, OC, F.bx);
    att::causal_swa_prime<att::bf16, att::bf16, 512, 1024, 512>(cur, 1 << 30, lds, S);
    for (int n = 0;; ++n) {
        const bool last = (n + 1 >= nblk);
        const ABlk nxt = last ? cur : cross_ref(QC, KV, OC, F.bx + (n + 1) * F.G);
        att::causal_swa_block<att::bf16, att::bf16, 512, 1024, 512>(cur, nxt, 256, 1 << 30, lds, S);
        if (last) break;
        cur = nxt;
    }
}

__device__ __forceinline__ void p_cross_attn2(Frame& F, char* lds, const bf16* QC, const bf16* KV, const bf16* VTM, bf16* OC) {
    typedef float f32x16_ __attribute__((ext_vector_type(16)));
    const int tid = F.tid, lane = F.lane, wid = F.wave, r32 = lane & 31, hi = lane >> 5;
    char* Kl = lds; char* Vl = lds + 65536;
    constexpr float C2 = 1.4426950408889634f * 0.08838834764831845f;
    for (int it = F.bx; it < 256; it += F.G) {
        const int bh = it >> 5, b = bh >> 2, head = bh & 3;
        __syncthreads();
        for (int i = tid; i < 4096; i += 512) { const int key = i >> 4, c = i & 15;
            const v4u x = *(const v4u*)(KV + ((size_t)(b * 256 + key)) * 1024 + head * 128 + c * 8);
            *(v4u*)(Kl + key * 256 + ((c ^ (key & 15)) << 4)) = x; }
        for (int i = tid; i < 2048; i += 512) { const int v = i >> 4, sg = i & 15; const bf16* src = VTM + (size_t)(head * 128 + v) * 512 + b * 256 + sg * 16;
            const v4u A = *(const v4u*)src, B = *(const v4u*)(src + 8);
            *(v4u*)(Vl + v * 512 + (((2 * sg) ^ (v & 31)) << 4)) = (v4u){A.x, A.y, B.x, B.y};
            *(v4u*)(Vl + v * 512 + (((2 * sg + 1) ^ (v & 31)) << 4)) = (v4u){A.z, A.w, B.z, B.w}; }
        __syncthreads();
        for (int qq = 0; qq < 2; ++qq) {
            const size_t row0 = (size_t)b * SEQ + (size_t)((it & 31) * 2 + qq) * 256 + wid * 32;
            bf16x8 qf[8];
#pragma unroll
            for (int ks = 0; ks < 8; ++ks) qf[ks] = *(const bf16x8*)(QC + (row0 + r32) * 512 + head * 128 + ks * 16 + hi * 8);
            f32x16_ o[4] = {}; float m = -3.0e38f, l = 0.f;
#pragma unroll
            for (int hf = 0; hf < 2; ++hf) {
                f32x16_ s[4];
#pragma unroll
                for (int kq = 0; kq < 4; ++kq) { s[kq] = (f32x16_){}; const int krow = (hf * 4 + kq) * 32 + r32;
#pragma unroll
                    for (int ks = 0; ks < 8; ++ks) { const bf16x8 kf = *(const bf16x8*)(Kl + krow * 256 + (((2 * ks + hi) ^ (krow & 15)) << 4));
                        s[kq] = __builtin_amdgcn_mfma_f32_32x32x16_bf16(kf, qf[ks], s[kq], 0, 0, 0); } }
                float mh = s[0][0];
#pragma unroll
                for (int kq = 0; kq < 4; ++kq)
#pragma unroll
                    for (int r = 0; r < 16; ++r) mh = fmaxf(mh, s[kq][r]);
                { auto rr = __builtin_amdgcn_permlane32_swap(__float_as_uint(mh), __float_as_uint(mh), false, false); mh = fmaxf(__uint_as_float(rr[0]), __uint_as_float(rr[1])); }
                const float mn = fmaxf(m, mh);
                if (hf == 1) { const float al = __builtin_amdgcn_exp2f((m - mn) * C2); l *= al;
#pragma unroll
                    for (int vb = 0; vb < 4; ++vb) o[vb] = o[vb] * al; }
                m = mn; const float mo = -m * C2; float lh = 0.f;
#pragma unroll
                for (int kq = 0; kq < 4; ++kq)
#pragma unroll
                    for (int r = 0; r < 16; ++r) { const float e = __builtin_amdgcn_exp2f(s[kq][r] * C2 + mo); s[kq][r] = e; lh += e; }
                { auto rr = __builtin_amdgcn_permlane32_swap(__float_as_uint(lh), __float_as_uint(lh), false, false); lh = __uint_as_float(rr[0]) + __uint_as_float(rr[1]); }
                l += lh;
#pragma unroll
                for (int kq = 0; kq < 4; ++kq)
#pragma unroll
                    for (int u = 0; u < 2; ++u) { v4u pw; pw.x = pg8::cvt_pk_bf16(s[kq][8 * u], s[kq][8 * u + 1]); pw.y = pg8::cvt_pk_bf16(s[kq][8 * u + 2], s[kq][8 * u + 3]);
                        pw.z = pg8::cvt_pk_bf16(s[kq][8 * u + 4], s[kq][8 * u + 5]); pw.w = pg8::cvt_pk_bf16(s[kq][8 * u + 6], s[kq][8 * u + 7]);
                        const bf16x8 pb = __builtin_bit_cast(bf16x8, pw);
#pragma unroll
                        for (int vb = 0; vb < 4; ++vb) { const int vrow = vb * 32 + r32;
                            const bf16x8 vf = *(const bf16x8*)(Vl + vrow * 512 + (((2 * (2 * (hf * 4 + kq) + u) + hi) ^ (vrow & 31)) << 4));
                            o[vb] = __builtin_amdgcn_mfma_f32_32x32x16_bf16(vf, pb, o[vb], 0, 0, 0); } }
            }
            const float rl = __builtin_amdgcn_rcpf(l);
            bf16* op = OC + (row0 + r32) * 512 + head * 128 + 4 * hi;
#pragma unroll
            for (int vb = 0; vb < 4; ++vb)
#pragma unroll
                for (int g = 0; g < 4; ++g) { v2u w; w.x = pg8::cvt_pk_bf16(o[vb][4 * g] * rl, o[vb][4 * g + 1] * rl); w.y = pg8::cvt_pk_bf16(o[vb][4 * g + 2] * rl, o[vb][4 * g + 3] * rl);
                    *(v2u*)(op + 32 * vb + 8 * g) = w; }
        }
    }
    __syncthreads();
}

__device__ __forceinline__ void p_combine(Frame& F, int dummy_, const bf16* OP, bf16* MIX) {
    const float* lq1 = INP(11); const float* lk1 = INP(12); const float* lq2 = INP(13); const float* lk2 = INP(14);
    const float* sg = INP(15);
    const int l = F.lane;
    const float d1 = wave_sum(lq1[l] * lk1[l] + lq1[l + 64] * lk1[l + 64]), d2 = wave_sum(lq2[l] * lk2[l] + lq2[l + 64] * lk2[l + 64]);
    const float lam = __expf(d1) - __expf(d2) + 0.2f;
    const int h = l >> 4, d0 = (l & 15) * 16;
    float g[16];
#pragma unroll
    for (int j = 0; j < 16; ++j) g[j] = sg[d0 + j] * 0.8f;
    const int gw = F.bx * NWAVES + F.wave, NGW = F.G * NWAVES;
    for (int row = gw; row < T; row += NGW) {
        const v4u* p1 = (const v4u*)(OP + (size_t)row * 2048 + h * 256 + d0); const v4u* p2 = (const v4u*)(OP + (size_t)row * 2048 + 1024 + h * 256 + d0);
        const v4u a0 = __builtin_nontemporal_load(p1), a1 = __builtin_nontemporal_load(p1 + 1), b0 = __builtin_nontemporal_load(p2), b1 = __builtin_nontemporal_load(p2 + 1);
        float o[16];
        o[0] = bflo(a0.x) - lam * bflo(b0.x); o[1] = bfhi(a0.x) - lam * bfhi(b0.x); o[2] = bflo(a0.y) - lam * bflo(b0.y); o[3] = bfhi(a0.y) - lam * bfhi(b0.y);
        o[4] = bflo(a0.z) - lam * bflo(b0.z); o[5] = bfhi(a0.z) - lam * bfhi(b0.z); o[6] = bflo(a0.w) - lam * bflo(b0.w); o[7] = bfhi(a0.w) - lam * bfhi(b0.w);
        o[8] = bflo(a1.x) - lam * bflo(b1.x); o[9] = bfhi(a1.x) - lam * bfhi(b1.x); o[10] = bflo(a1.y) - lam * bflo(b1.y); o[11] = bfhi(a1.y) - lam * bfhi(b1.y);
        o[12] = bflo(a1.z) - lam * bflo(b1.z); o[13] = bfhi(a1.z) - lam * bfhi(b1.z); o[14] = bflo(a1.w) - lam * bflo(b1.w); o[15] = bfhi(a1.w) - lam * bfhi(b1.w);
        float ss = 0.f;
#pragma unroll
        for (int j = 0; j < 16; ++j) ss += o[j] * o[j];
        ss += __shfl_xor(ss, 1); ss += __shfl_xor(ss, 2); ss += __shfl_xor(ss, 4); ss += __shfl_xor(ss, 8);
        const float rs = 1.0f / sqrtf(ss * (1.0f / 256.0f) + LN_EPS);
        v4u w0, w1;
        w0.x = pk2(o[0] * rs * g[0], o[1] * rs * g[1]); w0.y = pk2(o[2] * rs * g[2], o[3] * rs * g[3]); w0.z = pk2(o[4] * rs * g[4], o[5] * rs * g[5]); w0.w = pk2(o[6] * rs * g[6], o[7] * rs * g[7]);
        w1.x = pk2(o[8] * rs * g[8], o[9] * rs * g[9]); w1.y = pk2(o[10] * rs * g[10], o[11] * rs * g[11]); w1.z = pk2(o[12] * rs * g[12], o[13] * rs * g[13]); w1.w = pk2(o[14] * rs * g[14], o[15] * rs * g[15]);
        v4u* q = (v4u*)(MIX + (size_t)row * 2048 + h * 256 + d0); q[0] = w0; q[1] = w1;
    }
}

constexpr int CW_WQ = 8192;
__device__ __forceinline__ int wq_next(Frame& F, int k) {
    LAS int* slot = (LAS int*)(F.lds + SCR_OFF + 8192);
    __syncthreads();
    if (F.tid == 0) *slot = (int)__hip_atomic_fetch_add((unsigned*)(WSP() + WS_CTL) + CW_WQ + 64 * k, 1u, __ATOMIC_RELAXED, __HIP_MEMORY_SCOPE_AGENT);
    __syncthreads();
    return *slot;
}
template <int R> __device__ __forceinline__ void conv_rows(f32x2 (&acc)[32], const f32x2 (&w)[31], const LAS unsigned* ctt) {
    if constexpr (R < 62) {
        const unsigned p = ctt[R * 512]; const f32x2 val = (f32x2){bflo(p), bfhi(p)};
#pragma unroll
        for (int j = 0; j < 31; ++j) { if (R - j >= 0 && R - j < 32) acc[(R - j) & 31] = w[j] * val + acc[(R - j) & 31]; }
        conv_rows<R + 1>(acc, w, ctt);
    }
}
__device__ __forceinline__ void p_conformer(Frame& F, int dummy_, const bf16* H, bf16* MIX) {
    const float* cw = INP(16); const float* cb = INP(17); const float* cg = INP(18); const float* cbeta = INP(19);
    LAS unsigned* ct = (LAS unsigned*)F.lds;
    LAS float* red = (LAS float*)(F.lds + SCR_OFF);
    LAS float* stat = (LAS float*)(F.lds + SCR_OFF + 1024);
    const int tid = F.tid;
    f32x2 w[31];
#pragma unroll
    for (int j = 0; j < 31; ++j) w[j] = *(const f32x2*)(cw + j * 1024 + 2 * tid);
    const f32x2 bb = *(const f32x2*)(cb + 2 * tid), gg = *(const f32x2*)(cg + 2 * tid), be = *(const f32x2*)(cbeta + 2 * tid);
    for (;;) {
        const int item = wq_next(F, 0); if (item >= T / 32) break;
        const int t0 = item * 32, tl0 = t0 & (SEQ - 1);
        { const int cgp = tid & 127, rq = tid >> 7;
#pragma unroll 4
          for (int r = rq; r < 64; r += 4) { const int tl = tl0 - 30 + r; v4u o = (v4u){0u, 0u, 0u, 0u};
              if (r < 62 && tl >= 0) o = *(const v4u*)(H + (size_t)(t0 - 30 + r) * INW + 3072 + cgp * 8);
              if (r < 62) *(LAS v4u*)(ct + r * 512 + cgp * 4) = o; } }
        __syncthreads();
        f32x2 acc[32];
#pragma unroll
        for (int t = 0; t < 32; ++t) acc[t] = bb;
        conv_rows<0>(acc, w, ct + tid);
#pragma unroll
        for (int t = 0; t < 32; ++t) { const float s = wave_sum(acc[t].x + acc[t].y); if (F.lane == 0) red[F.wave * 32 + t] = s; }
        __syncthreads();
        if (tid < 32) { float s = 0.f;
#pragma unroll
            for (int k = 0; k < 8; ++k) s += red[k * 32 + tid]; stat[tid] = s * (1.0f / 1024.0f); }
        __syncthreads();
#pragma unroll
        for (int t = 0; t < 32; ++t) { const float mu = stat[t]; acc[t] = acc[t] - mu; }
        __syncthreads();
#pragma unroll
        for (int t = 0; t < 32; ++t) { const float s = wave_sum(acc[t].x * acc[t].x + acc[t].y * acc[t].y); if (F.lane == 0) red[F.wave * 32 + t] = s; }
        __syncthreads();
        if (tid < 32) { float s = 0.f;
#pragma unroll
            for (int k = 0; k < 8; ++k) s += red[k * 32 + tid]; stat[tid] = 1.0f / sqrtf(s * (1.0f / 1024.0f) + LN_EPS); }
        __syncthreads();
#pragma unroll
        for (int t = 0; t < 32; ++t) { const float rs = stat[t]; const float y0 = acc[t].x * rs * gg.x + be.x, y1 = acc[t].y * rs * gg.y + be.y;
            const float s0 = y0 * __builtin_amdgcn_rcpf(1.f + __expf(-y0)), s1 = y1 * __builtin_amdgcn_rcpf(1.f + __expf(-y1));
            *(unsigned*)(MIX + (size_t)(t0 + t) * 2048 + 1024 + 2 * tid) = pk2(s0, s1); }
    }
    __syncthreads();
}

__device__ __forceinline__ void p_sgu(Frame& F, int dummy_, const bf16* H, bf16* MIX) {
    const float* lg = INP(20); const float* lb = INP(21); const float* sw = INP(22); const float* sb = INP(23);
    constexpr int VP = 136;
    constexpr int OPP = 264;
    LAS bf16* vgt = (LAS bf16*)F.lds;
    LAS bf16* wl = (LAS bf16*)(F.lds + 256 * VP * 2);
    LAS float* st = (LAS float*)(F.lds + 256 * VP * 2 + 128 * VP * 2);
    const int tid = F.tid, lane = F.lane, wid = F.wave;
    const int wt = tid >> 2, wsq = tid & 3;
    const int s2 = tid & 63, cq = tid >> 6;
    const int c8 = (tid & 31) * 8, tq = tid >> 5;
    for (int chunk = F.bx; chunk < T / 128; chunk += F.G) {
        const size_t r0 = (size_t)chunk * 128;
        __syncthreads();
        f32x4 wp[8]; v4u za[4], zb[4];
#define SGU_LOADG(g_) do { const float* wp_ = sw + ((size_t)(g_) * 128 + wt) * 128 + wsq * 32; _Pragma("unroll") for (int k = 0; k < 8; ++k) wp[k] = *(const f32x4*)(wp_ + 4 * k); \
            const bf16* zp_ = H + (r0 + 2 * s2) * INW + 1024 + (g_) * 256 + cq * 32; _Pragma("unroll") for (int k = 0; k < 4; ++k) { za[k] = *(const v4u*)(zp_ + 8 * k); zb[k] = *(const v4u*)(zp_ + INW + 8 * k); } } while (0)
        SGU_LOADG(0);
        for (int r8 = 0; r8 < 16; r8 += 8) { v4u z0[8], z1[8];
#pragma unroll
          for (int i = 0; i < 8; ++i) { const bf16* zp = H + (r0 + wid * 16 + r8 + i) * INW + 1024 + lane * 8; z0[i] = *(const v4u*)zp; z1[i] = *(const v4u*)(zp + 512); }
#pragma unroll
          for (int i = 0; i < 8; ++i) {
              float v[16] = {bflo(z0[i].x), bfhi(z0[i].x), bflo(z0[i].y), bfhi(z0[i].y), bflo(z0[i].z), bfhi(z0[i].z), bflo(z0[i].w), bfhi(z0[i].w), bflo(z1[i].x), bfhi(z1[i].x), bflo(z1[i].y), bfhi(z1[i].y), bflo(z1[i].z), bfhi(z1[i].z), bflo(z1[i].w), bfhi(z1[i].w)};
              float sm = 0.f;
#pragma unroll
              for (int j = 0; j < 16; ++j) sm += v[j];
              const float mu = wave_sum(sm) * (1.0f / 1024.0f); float q = 0.f;
#pragma unroll
              for (int j = 0; j < 16; ++j) { const float d = v[j] - mu; q += d * d; }
              const float rs = 1.0f / sqrtf(wave_sum(q) * (1.0f / 1024.0f) + LN_EPS);
              if (lane == 0) { st[2 * (wid * 16 + r8 + i)] = mu; st[2 * (wid * 16 + r8 + i) + 1] = rs; } } }
        for (int g = 0; g < 4; ++g) {
            __syncthreads();
            {
#pragma unroll
              for (int k = 0; k < 4; ++k) { const f32x4 p = wp[2 * k], q = wp[2 * k + 1]; const int s0 = wsq * 32 + 8 * k, t = wt;
                  v4u o; o.x = pk2(s0 + 0 <= t ? p[0] : 0.f, s0 + 1 <= t ? p[1] : 0.f); o.y = pk2(s0 + 2 <= t ? p[2] : 0.f, s0 + 3 <= t ? p[3] : 0.f);
                  o.z = pk2(s0 + 4 <= t ? q[0] : 0.f, s0 + 5 <= t ? q[1] : 0.f); o.w = pk2(s0 + 6 <= t ? q[2] : 0.f, s0 + 7 <= t ? q[3] : 0.f);
                  *(LAS v4u*)(wl + t * VP + s0) = o; } }
            { const float mu0 = st[4 * s2], rs0 = st[4 * s2 + 1], mu1 = st[4 * s2 + 2], rs1 = st[4 * s2 + 3];
#pragma unroll
              for (int k = 0; k < 4; ++k) { const int c0 = cq * 32 + 8 * k; const float* gp = lg + g * 256 + c0; const float* bp = lb + g * 256 + c0;
                  const f32x4 g0 = *(const f32x4*)gp, g1 = *(const f32x4*)(gp + 4), b0 = *(const f32x4*)bp, b1 = *(const f32x4*)(bp + 4);
                  LAS unsigned* vo = (LAS unsigned*)(vgt + c0 * VP + 2 * s2);
#define NRM(zw, half, gv, bv, mu_, rs_) ((half ? bfhi(zw) : bflo(zw)) - mu_) * rs_ * gv + bv
                  vo[0 * (VP / 2)] = pk2(NRM(za[k].x, 0, g0[0], b0[0], mu0, rs0), NRM(zb[k].x, 0, g0[0], b0[0], mu1, rs1));
                  vo[1 * (VP / 2)] = pk2(NRM(za[k].x, 1, g0[1], b0[1], mu0, rs0), NRM(zb[k].x, 1, g0[1], b0[1], mu1, rs1));
                  vo[2 * (VP / 2)] = pk2(NRM(za[k].y, 0, g0[2], b0[2], mu0, rs0), NRM(zb[k].y, 0, g0[2], b0[2], mu1, rs1));
                  vo[3 * (VP / 2)] = pk2(NRM(za[k].y, 1, g0[3], b0[3], mu0, rs0), NRM(zb[k].y, 1, g0[3], b0[3], mu1, rs1));
                  vo[4 * (VP / 2)] = pk2(NRM(za[k].z, 0, g1[0], b1[0], mu0, rs0), NRM(zb[k].z, 0, g1[0], b1[0], mu1, rs1));
                  vo[5 * (VP / 2)] = pk2(NRM(za[k].z, 1, g1[1], b1[1], mu0, rs0), NRM(zb[k].z, 1, g1[1], b1[1], mu1, rs1));
                  vo[6 * (VP / 2)] = pk2(NRM(za[k].w, 0, g1[2], b1[2], mu0, rs0), NRM(zb[k].w, 0, g1[2], b1[2], mu1, rs1));
                  vo[7 * (VP / 2)] = pk2(NRM(za[k].w, 1, g1[3], b1[3], mu0, rs0), NRM(zb[k].w, 1, g1[3], b1[3], mu1, rs1));
#undef NRM
              } }
            if (g + 1 < 4) SGU_LOADG(g + 1);
            __syncthreads();
            const int wr = wid >> 1, wc = wid & 1, r32 = lane & 31, hi = lane >> 5;
            f32x16 acc[4] = {};
            for (int ks = 0; ks < 2 * wr + 2; ++ks) { const bf16x8 af = *(const LAS bf16x8*)(wl + (wr * 32 + r32) * VP + ks * 16 + hi * 8);
#pragma unroll
                for (int cb = 0; cb < 4; ++cb) { const bf16x8 bfr = *(const LAS bf16x8*)(vgt + (wc * 128 + cb * 32 + r32) * VP + ks * 16 + hi * 8);
                    acc[cb] = __builtin_amdgcn_mfma_f32_32x32x16_bf16(af, bfr, acc[cb], 0, 0, 0); } }
            __syncthreads();
            LAS bf16* ot = vgt;
#pragma unroll
            for (int r = 0; r < 16; ++r) { const int t = wr * 32 + (r & 3) + 8 * (r >> 2) + 4 * hi; const float bias = sb[g * 128 + t];
#pragma unroll
                for (int cb = 0; cb < 4; ++cb) ot[t * OPP + wc * 128 + cb * 32 + r32] = (bf16)f2bf(acc[cb][r] + bias); }
            __syncthreads();
#pragma unroll
            for (int k = 0; k < 8; ++k) { const int t = tq + 16 * k; const v4u sv = *(const LAS v4u*)(ot + t * OPP + c8); v4u o; const v4u uk = *(const v4u*)(H + (r0 + t) * INW + g * 256 + c8);
                o.x = pk2(bflo(uk.x) * bflo(sv.x), bfhi(uk.x) * bfhi(sv.x)); o.y = pk2(bflo(uk.y) * bflo(sv.y), bfhi(uk.y) * bfhi(sv.y));
                o.z = pk2(bflo(uk.z) * bflo(sv.z), bfhi(uk.z) * bfhi(sv.z)); o.w = pk2(bflo(uk.w) * bflo(sv.w), bfhi(uk.w) * bfhi(sv.w));
                *(v4u*)(MIX + (r0 + t) * 2048 + g * 256 + c8) = o; }
        }
#undef SGU_LOADG
    }
    __syncthreads();
}
__device__ __forceinline__ void p_sconv(Frame& F, int dummy_, const bf16* H, bf16* MIX) {
    const float* scw = INP(24);
    const int cgp = F.tid & 127, run = F.tid >> 7;
    float w0[8], w1[8], w2[8];
#pragma unroll
    for (int j = 0; j < 8; ++j) { w0[j] = scw[cgp * 8 + j]; w1[j] = scw[1024 + cgp * 8 + j]; w2[j] = scw[2048 + cgp * 8 + j]; }
    for (;;) {
        const int item = wq_next(F, 1); if (item >= T / 64) break;
        const int t0 = item * 64 + run * 16; const int tl0 = t0 & (SEQ - 1);
        float pm2[8], pm1[8];
#pragma unroll
        for (int j = 0; j < 8; ++j) { pm2[j] = 0.f; pm1[j] = 0.f; }
        for (int tt = -2; tt < 16; ++tt) {
            if (tl0 + tt < 0) continue;
            const bf16* hp = H + (size_t)(t0 + tt) * INW + 2048 + cgp * 8;
            const v4u gc = __builtin_nontemporal_load((const v4u*)(hp + 1024)), xi = __builtin_nontemporal_load((const v4u*)(hp + 2048));
            float p[8] = {bflo(gc.x) * bflo(xi.x), bfhi(gc.x) * bfhi(xi.x), bflo(gc.y) * bflo(xi.y), bfhi(gc.y) * bfhi(xi.y), bflo(gc.z) * bflo(xi.z), bfhi(gc.z) * bfhi(xi.z), bflo(gc.w) * bflo(xi.w), bfhi(gc.w) * bfhi(xi.w)};
            if (tt >= 0) { const v4u gb = __builtin_nontemporal_load((const v4u*)hp); const float gbf[8] = {bflo(gb.x), bfhi(gb.x), bflo(gb.y), bfhi(gb.y), bflo(gb.z), bfhi(gb.z), bflo(gb.w), bfhi(gb.w)};
                float o[8];
#pragma unroll
                for (int j = 0; j < 8; ++j) o[j] = gbf[j] * (w0[j] * pm2[j] + w1[j] * pm1[j] + w2[j] * p[j]);
                v4u w; w.x = pk2(o[0], o[1]); w.y = pk2(o[2], o[3]); w.z = pk2(o[4], o[5]); w.w = pk2(o[6], o[7]);
                *(v4u*)(MIX + (size_t)(t0 + tt) * 2048 + 1024 + cgp * 8) = w; }
#pragma unroll
            for (int j = 0; j < 8; ++j) { pm2[j] = pm1[j]; pm1[j] = p[j]; }
        }
    }
}

template <int MODE>
__device__ __forceinline__ void p_ln(Frame& F, bf16* Y, const bf16* YE, const int* tokd, float* OUTF, const float* gam, const float* bet) {
    const int l = F.lane;
    f32x4 g[8], b[8];
#pragma unroll
    for (int j = 0; j < 4; ++j) { g[2 * j] = *(const f32x4*)(gam + 8 * l + 512 * j); g[2 * j + 1] = *(const f32x4*)(gam + 8 * l + 512 * j + 4); b[2 * j] = *(const f32x4*)(bet + 8 * l + 512 * j); b[2 * j + 1] = *(const f32x4*)(bet + 8 * l + 512 * j + 4); }
    const int gw = F.bx * NWAVES + F.wave, NGW = F.G * NWAVES;
    for (int rowb = gw; rowb < T; rowb += 2 * NGW) {
        v4u w[2][4], e0[2][4], e1[2][4];
#pragma unroll
        for (int u = 0; u < 2; ++u) { const int row = rowb + u * NGW; if (row < T) { const bf16* yp = Y + (size_t)row * 2048 + 8 * l;
#pragma unroll
            for (int j = 0; j < 4; ++j) w[u][j] = __builtin_nontemporal_load((const v4u*)(yp + 512 * j));
            if constexpr (MODE == 1 || MODE == 2) { const int d0 = tokd[2 * row], d1 = tokd[2 * row + 1];
                const bf16* p0 = YE + (size_t)d0 * 2048 + 8 * l; const bf16* p1 = YE + (size_t)d1 * 2048 + 8 * l;
#pragma unroll
                for (int j = 0; j < 4; ++j) { e0[u][j] = __builtin_nontemporal_load((const v4u*)(p0 + 512 * j)); e1[u][j] = __builtin_nontemporal_load((const v4u*)(p1 + 512 * j));     } } } }
#pragma unroll
        for (int u = 0; u < 2; ++u) { const int row = rowb + u * NGW; if (row < T) {
            f32x4 v[8];
#pragma unroll
            for (int j = 0; j < 4; ++j) { v[2 * j] = (f32x4){bflo(w[u][j].x), bfhi(w[u][j].x), bflo(w[u][j].y), bfhi(w[u][j].y)}; v[2 * j + 1] = (f32x4){bflo(w[u][j].z), bfhi(w[u][j].z), bflo(w[u][j].w), bfhi(w[u][j].w)}; }
            if constexpr (MODE == 1 || MODE == 2) {
#pragma unroll
                for (int j = 0; j < 4; ++j) { const v4u w0 = e0[u][j], w1 = e1[u][j];
                    v[2 * j] = v[2 * j] * ALPHA + ((f32x4){bflo(w0.x), bfhi(w0.x), bflo(w0.y), bfhi(w0.y)} + (f32x4){bflo(w1.x), bfhi(w1.x), bflo(w1.y), bfhi(w1.y)});
                    v[2 * j + 1] = v[2 * j + 1] * ALPHA + ((f32x4){bflo(w0.z), bfhi(w0.z), bflo(w0.w), bfhi(w0.w)} + (f32x4){bflo(w1.z), bfhi(w1.z), bflo(w1.w), bfhi(w1.w)}); }
            }
            float sm = 0.f;
#pragma unroll
            for (int j = 0; j < 8; ++j) sm += (v[j][0] + v[j][1]) + (v[j][2] + v[j][3]);
            const float mu = wave_sum(sm) * (1.0f / 2048.0f); float q = 0.f;
#pragma unroll
            for (int j = 0; j < 8; ++j) { v[j] = v[j] - mu; q += (v[j][0] * v[j][0] + v[j][1] * v[j][1]) + (v[j][2] * v[j][2] + v[j][3] * v[j][3]); }
            const float rs = 1.0f / sqrtf(wave_sum(q) * (1.0f / 2048.0f) + LN_EPS);
#pragma unroll
            for (int j = 0; j < 8; ++j) v[j] = v[j] * rs * g[j] + b[j];
            if constexpr (MODE == 2) { float* op = OUTF + (size_t)row * 2048 + 8 * l;
#pragma unroll
                for (int j = 0; j < 4; ++j) { *(f32x4*)(op + 512 * j) = v[2 * j]; *(f32x4*)(op + 512 * j + 4) = v[2 * j + 1]; } }
            else { bf16* yp = (MODE == 3 ? (bf16*)OUTF : Y) + (size_t)row * 2048 + 8 * l;
#pragma unroll
                for (int j = 0; j < 4; ++j) { v4u o; o.x = pk2(v[2 * j][0], v[2 * j][1]); o.y = pk2(v[2 * j][2], v[2 * j][3]); o.z = pk2(v[2 * j + 1][0], v[2 * j + 1][1]); o.w = pk2(v[2 * j + 1][2], v[2 * j + 1][3]); *(v4u*)(yp + 512 * j) = o; } } } }
    }
}

__device__ __forceinline__ void p_router_route(Frame& F, int lyr, bf16* X, const float* gam, const float* bet) {
    typedef float f32x4_t __attribute__((ext_vector_type(4)));
    unsigned char* ws = WSP();
    const bf16* WR = (const bf16*)(ws + WS_ROUT) + (size_t)lyr * 256 * 2048;
    const float* rgb = INP(29) + lyr * 4; const float* reb = INP(31) + lyr * 32;
    int* toke = (int*)(ws + WS_TOKE); float* tokw = (float*)(ws + WS_TOKW); int* wgc = (int*)(ws + WS_WGC);
    constexpr int BP = 264;
    LAS bf16* Bs = (LAS bf16*)F.lds;
    LAS float* LGs = (LAS float*)(F.lds + 2 * 48 * BP * 2);
    LAS int* hist = (LAS int*)(F.lds + SCR_OFF);
    { int* rowt = (int*)(ws + WS_ROWT); for (int i = F.bx * 512 + F.tid; i < RMAX; i += F.G * 512) rowt[i] = 0; }
    const int tid = F.tid, lane = F.lane, wid = F.wave, r16 = lane & 15, kq = lane >> 4;
    for (int grp = F.bx; grp < T / 128; grp += F.G) {
        __syncthreads();
        if (tid < 32) hist[tid] = 0;
        { f32x4 g[8], b[8];
#pragma unroll
          for (int j = 0; j < 4; ++j) { g[2 * j] = *(const f32x4*)(gam + 8 * lane + 512 * j); g[2 * j + 1] = *(const f32x4*)(gam + 8 * lane + 512 * j + 4); b[2 * j] = *(const f32x4*)(bet + 8 * lane + 512 * j); b[2 * j + 1] = *(const f32x4*)(bet + 8 * lane + 512 * j + 4); }
          for (int it = 0; it < 8; ++it) { v4u w[2][4];
#pragma unroll
              for (int u = 0; u < 2; ++u) { const bf16* yp = X + ((size_t)grp * 128 + wid * 16 + 2 * it + u) * 2048 + 8 * lane;
#pragma unroll
                  for (int j = 0; j < 4; ++j) w[u][j] = *(const v4u*)(yp + 512 * j); }
#pragma unroll
              for (int u = 0; u < 2; ++u) { bf16* yp = X + ((size_t)grp * 128 + wid * 16 + 2 * it + u) * 2048 + 8 * lane; f32x4 v[8];
#pragma unroll
                  for (int j = 0; j < 4; ++j) { v[2 * j] = (f32x4){bflo(w[u][j].x), bfhi(w[u][j].x), bflo(w[u][j].y), bfhi(w[u][j].y)}; v[2 * j + 1] = (f32x4){bflo(w[u][j].z), bfhi(w[u][j].z), bflo(w[u][j].w), bfhi(w[u][j].w)}; }
                  float sm = 0.f;
#pragma unroll
                  for (int j = 0; j < 8; ++j) sm += (v[j][0] + v[j][1]) + (v[j][2] + v[j][3]);
                  const float mu = wave_sum(sm) * (1.0f / 2048.0f); float q = 0.f;
#pragma unroll
                  for (int j = 0; j < 8; ++j) { v[j] = v[j] - mu; q += (v[j][0] * v[j][0] + v[j][1] * v[j][1]) + (v[j][2] * v[j][2] + v[j][3] * v[j][3]); }
                  const float rs = 1.0f / sqrtf(wave_sum(q) * (1.0f / 2048.0f) + LN_EPS);
#pragma unroll
                  for (int j = 0; j < 4; ++j) { const f32x4 a0 = v[2 * j] * rs * g[2 * j] + b[2 * j], a1 = v[2 * j + 1] * rs * g[2 * j + 1] + b[2 * j + 1];
                      v4u o; o.x = pk2(a0[0], a0[1]); o.y = pk2(a0[2], a0[3]); o.z = pk2(a1[0], a1[1]); o.w = pk2(a1[2], a1[3]); *(v4u*)(yp + 512 * j) = o; } } }
          asm volatile("s_waitcnt vmcnt(0)" ::: "memory"); }
        const bf16* ap = X + ((size_t)grp * 128 + wid * 16 + r16) * 2048 + 8 * kq;
        f32x4_t acc[3] = {};
        bf16x8 a_cur[8], a_nxt[8]; v4u b_st[3];
#define RR_LOADB(ch) do { _Pragma("unroll") for (int j = 0; j < 3; ++j) { const int idx = tid + 512 * j, n = idx >> 5, c16 = idx & 31; b_st[j] = *(const v4u*)(WR + (size_t)n * 2048 + (ch) * 256 + 8 * c16); } } while (0)
#define RR_WRITEB(buf) do { _Pragma("unroll") for (int j = 0; j < 3; ++j) { const int idx = tid + 512 * j, n = idx >> 5, c16 = idx & 31; *(LAS v4u*)(Bs + (buf) * 48 * BP + n * BP + 8 * c16) = b_st[j]; } } while (0)
#define RR_LOADA(dst, ch) do { _Pragma("unroll") for (int ks = 0; ks < 8; ++ks) dst[ks] = *(const bf16x8*)(ap + (ch) * 256 + 32 * ks); } while (0)
        RR_LOADB(0); RR_LOADA(a_cur, 0);
        RR_WRITEB(0);
        __syncthreads();
#pragma unroll
        for (int ch = 0; ch < 8; ++ch) {
            if (ch + 1 < 8) { RR_LOADB(ch + 1); if (ch & 1) RR_LOADA(a_cur, ch + 1); else RR_LOADA(a_nxt, ch + 1); }
#pragma unroll
            for (int ks = 0; ks < 8; ++ks) { const bf16x8 af = (ch & 1) ? a_nxt[ks] : a_cur[ks];
#pragma unroll
                for (int cb = 0; cb < 3; ++cb) { const bf16x8 bfr = *(const LAS bf16x8*)(Bs + (ch & 1) * 48 * BP + (16 * cb + r16) * BP + 32 * ks + 8 * kq);
                    acc[cb] = __builtin_amdgcn_mfma_f32_16x16x32_bf16(af, bfr, acc[cb], 0, 0, 0); } }
            if (ch + 1 < 8) { RR_WRITEB((ch + 1) & 1); __syncthreads(); }
        }
#undef RR_LOADA
#undef RR_WRITEB
#undef RR_LOADB
#pragma unroll
        for (int cb = 0; cb < 3; ++cb)
#pragma unroll
            for (int t = 0; t < 4; ++t) LGs[(wid * 16 + 4 * kq + t) * 49 + 16 * cb + r16] = acc[cb][t];
        __syncthreads();
        if (tid < 128) { const int t = grp * 128 + tid; const LAS float* lp = LGs + tid * 49;
            float gl[4] = {lp[0] + rgb[0], lp[1] + rgb[1], lp[2] + rgb[2], lp[3] + rgb[3]};
            int gi = 0; float gm = gl[0];
#pragma unroll
            for (int j = 1; j < 4; ++j) if (gl[j] > gm) { gm = gl[j]; gi = j; }
            float den = 0.f;
#pragma unroll
            for (int j = 0; j < 4; ++j) den += __expf(gl[j] - gm);
            const float ggate = 1.0f / den;
            const LAS float* ep = lp + 4 + gi * 8; const float* rb = reb + gi * 8;
            float el[8] = {ep[0] + rb[0], ep[1] + rb[1], ep[2] + rb[2], ep[3] + rb[3], ep[4] + rb[4], ep[5] + rb[5], ep[6] + rb[6], ep[7] + rb[7]};
            int i0 = 0; float v0 = el[0];
#pragma unroll
            for (int j = 1; j < 8; ++j) if (el[j] > v0) { v0 = el[j]; i0 = j; }
            int i1 = -1; float v1 = -3.0e38f;
#pragma unroll
            for (int j = 0; j < 8; ++j) if (j != i0 && el[j] > v1) { v1 = el[j]; i1 = j; }
            const float p0 = 1.0f / (1.0f + __expf(v1 - v0)), p1 = 1.0f - p0;
            const int ea = gi * 8 + i0, eb = gi * 8 + i1;
            toke[2 * t] = ea; toke[2 * t + 1] = eb; tokw[2 * t] = p0 * ggate; tokw[2 * t + 1] = p1 * ggate;
            __hip_atomic_fetch_add(hist + ea, 1, __ATOMIC_RELAXED, __HIP_MEMORY_SCOPE_WORKGROUP); __hip_atomic_fetch_add(hist + eb, 1, __ATOMIC_RELAXED, __HIP_MEMORY_SCOPE_WORKGROUP); }
        __syncthreads();
        if (tid < 32) wgc[grp * 32 + tid] = hist[tid];
    }
    __syncthreads();
}
__device__ __forceinline__ void p_route(Frame& F, int dummy_, int lyr) {
    unsigned char* ws = WSP();
    const float* LG = (const float*)(OUTP() + DO_OP); const float* LG2 = LG + (size_t)T * 64; const float* rgb = INP(29) + lyr * 4; const float* reb = INP(31) + lyr * 32;
    int* toke = (int*)(ws + WS_TOKE); float* tokw = (float*)(ws + WS_TOKW); int* wgc = (int*)(ws + WS_WGC);
    LAS int* hist = (LAS int*)(F.lds + SCR_OFF);
    { int* rowt = (int*)(ws + WS_ROWT); for (int i = F.bx * 512 + F.tid; i < RMAX; i += F.G * 512) rowt[i] = 0; }
    for (int grp = F.bx; grp < T / 128; grp += F.G) {
        __syncthreads();
        if (F.tid < 32) hist[F.tid] = 0;
        __syncthreads();
        if (F.tid < 128) { const int t = grp * 128 + F.tid; const float* lp = LG + (size_t)t * 64;
            const float* lp2 = LG2 + (size_t)t * 64; const f32x4 gl4 = *(const f32x4*)lp + *(const f32x4*)lp2; float gl[4] = {gl4[0] + rgb[0], gl4[1] + rgb[1], gl4[2] + rgb[2], gl4[3] + rgb[3]};
            int gi = 0; float gm = gl[0];
#pragma unroll
            for (int j = 1; j < 4; ++j) if (gl[j] > gm) { gm = gl[j]; gi = j; }
            float den = 0.f;
#pragma unroll
            for (int j = 0; j < 4; ++j) den += __expf(gl[j] - gm);
            const float ggate = 1.0f / den;
            const f32x4 e0 = *(const f32x4*)(lp + 4 + gi * 8) + *(const f32x4*)(lp2 + 4 + gi * 8), e1 = *(const f32x4*)(lp + 8 + gi * 8) + *(const f32x4*)(lp2 + 8 + gi * 8); const float* rb = reb + gi * 8;
            float el[8] = {e0[0] + rb[0], e0[1] + rb[1], e0[2] + rb[2], e0[3] + rb[3], e1[0] + rb[4], e1[1] + rb[5], e1[2] + rb[6], e1[3] + rb[7]};
            int i0 = 0; float v0 = el[0];
#pragma unroll
            for (int j = 1; j < 8; ++j) if (el[j] > v0) { v0 = el[j]; i0 = j; }
            int i1 = -1; float v1 = -3.0e38f;
#pragma unroll
            for (int j = 0; j < 8; ++j) if (j != i0 && el[j] > v1) { v1 = el[j]; i1 = j; }
            const float p0 = 1.0f / (1.0f + __expf(v1 - v0)), p1 = 1.0f - p0;
            const int ea = gi * 8 + i0, eb = gi * 8 + i1;
            toke[2 * t] = ea; toke[2 * t + 1] = eb; tokw[2 * t] = p0 * ggate; tokw[2 * t + 1] = p1 * ggate;
            __hip_atomic_fetch_add(hist + ea, 1, __ATOMIC_RELAXED, __HIP_MEMORY_SCOPE_WORKGROUP); __hip_atomic_fetch_add(hist + eb, 1, __ATOMIC_RELAXED, __HIP_MEMORY_SCOPE_WORKGROUP); }
        __syncthreads();
        if (F.tid < 32) wgc[grp * 32 + F.tid] = hist[F.tid];
    }
    __syncthreads();
}
__device__ __forceinline__ void p_dispatch(Frame& F, int dummy_, const bf16* X, bf16* XG) {
    unsigned char* ws = WSP();
    const int* toke = (const int*)(ws + WS_TOKE); const float* tokw = (const float*)(ws + WS_TOKW); int* tokd = (int*)(ws + WS_TOKD); const int* wgc = (const int*)(ws + WS_WGC);
    float* roww = (float*)(ws + WS_ROWW); int* tile = (int*)(ws + WS_TILE); int* rowt = (int*)(ws + WS_ROWT);
    LAS int* part = (LAS int*)(F.lds + SCR_OFF);
    LAS int* base = part + 1024;
    LAS int* pst = base + 32;
    LAS int* earr = pst + 64;
    LAS int* darr = earr + 256;
    for (int grp = F.bx; grp < T / 128; grp += F.G) {
        __syncthreads();
        { const int e = F.tid & 31, p = F.tid >> 5; int below = 0, tot = 0;
          for (int i = p * 16; i < p * 16 + 16; ++i) { const int c = wgc[i * 32 + e]; tot += c; if (i < grp) below += c; }
          part[p * 32 + e] = below; part[512 + p * 32 + e] = tot; }
        __syncthreads();
        if (F.tid < 32) { int below = 0, tot = 0;
            for (int p = 0; p < 16; ++p) { below += part[p * 32 + F.tid]; tot += part[512 + p * 32 + F.tid]; }
            base[F.tid] = below; earr[F.tid] = tot; }
        __syncthreads();
        if (F.tid == 0) { int s = 0; for (int e = 0; e < 32; ++e) { pst[e] = s; s += (earr[e] + 255) & ~255; } pst[32] = s; }
        __syncthreads();
        if (grp == 0) {
            const int ntile = pst[32] >> 8;
            if (F.tid < 320) { int e = 0;
                for (int k = 1; k < 32; ++k) if (pst[k] <= F.tid * 256) e = k;
                tile[F.tid] = e; }
            if (F.tid == 0) tile[400] = ntile;
        }
        int mye = 0, mytok = 0;
        if (F.tid < 256) { mytok = grp * 128 + (F.tid >> 1); mye = toke[2 * mytok + (F.tid & 1)]; }
        __syncthreads();
        if (F.tid < 256) earr[F.tid] = mye;
        __syncthreads();
        if (F.tid < 256) { int rank = 0;
            for (int k = 0; k < F.tid; ++k) rank += (earr[k] == mye) ? 1 : 0;
            const int dest = pst[mye] + base[mye] + rank;
            tokd[2 * mytok + (F.tid & 1)] = dest; roww[dest] = tokw[2 * mytok + (F.tid & 1)]; rowt[dest] = mytok; }
        __syncthreads();
    }
    __syncthreads();
}

#ifndef ALIGN_SHORTK
#define ALIGN_SHORTK true
#endif
#ifndef ROUTER_GEMM
#define ROUTER_GEMM 0
#endif
#ifndef HO_BARRIER
#define HO_BARRIER false
#endif
#ifndef MIXSEL
#define MIXSEL 15
#endif
#ifndef PHMASK
#define PHMASK 0xFFFFFFFF
#endif
#define PH_ON(k) ((PHMASK >> (k)) & 1)
#ifndef DUPMASK
#define DUPMASK 0
#endif
#define REP(k) for (int rep_ = 0; rep_ < 1 + ((DUPMASK >> (k)) & 1); ++rep_)
__global__ void __launch_bounds__(NWAVES * 64, 2) fwd_kernel(Args args) {
    extern __shared__ __attribute__((aligned(16))) unsigned char lds[];
    Frame F;
    F.lds = (LAS unsigned char*)lds;
    F.MISC = (volatile LAS unsigned*)(F.lds + MISC_OFF);
    F.tid = threadIdx.x; F.lane = F.tid & 63; F.wave = __builtin_amdgcn_readfirstlane(F.tid >> 6);
    F.G = gridDim.x; F.bx = blockIdx.x;
    for (int u = F.tid; u < (LDS_BYTES - LDSCTL_OFF) / 4; u += NWAVES * 64) ((LAS unsigned*)(F.lds + LDSCTL_OFF))[u] = 0u;
    __syncthreads();
    if (F.tid < 37) { const unsigned long long p = F.tid < 35 ? (unsigned long long)args.in[F.tid] : (F.tid == 35 ? (unsigned long long)args.out : (unsigned long long)args.ws);
        LAS unsigned* t = (LAS unsigned*)(F.lds + TAB_OFF) + 2 * F.tid; t[0] = (unsigned)p; t[1] = (unsigned)(p >> 32); }
    const int lo = args.ph_lo, hi = args.ph_hi; int ph = 0;
    __syncthreads();
    XcdBarrier bar = xcd_barrier_post((unsigned*)(WSP() + WS_CTL) + CW_BAR, F.MISC + 8);
#define PHASE_BEGIN if (lo <= ph && ph < hi) { refresh(F); unsigned char* const ws = WSP(); unsigned char* const dout = OUTP(); (void)ws; (void)dout;
#define PHASE_END(sync) if ((sync) && ph + 1 < hi) xcd_barrier(bar); } ++ph;
#define XA_ ((bf16*)(ws + WS_XA))
#define XB_ ((bf16*)(ws + WS_XB))
#define HB_ ((bf16*)(ws + WS_H))
#define KV_ ((bf16*)(ws + WS_KV))
#define MIX_ ((bf16*)(dout + DO_MIX))
#define OPB_ ((bf16*)(dout + DO_OP))
#define QC_ ((bf16*)(dout + DO_QC))
#define OC_ ((bf16*)(dout + DO_OC))
#define HBM_ ((bf16*)(dout + DO_HB))

    PHASE_BEGIN
#if PH_ON(0)
        REP(0)
        p_prologue(F, 0);
#endif
#ifdef PROBE_BAR
        for (int xb_ = 0; xb_ < PROBE_BAR; ++xb_) xcd_barrier(bar);
#endif
    PHASE_END(true)
    for (int lyr = 0; lyr < 2; ++lyr) {
        PHASE_BEGIN
#if PH_ON(2)
        REP(2)
        {
            pg8::Gemm g{XA_, (const bf16*)(ws + WS_WIN) + (size_t)lyr * 5120 * 2048, T, INW, 2048, 2048}; pg8::StaticOrder S; S.init(T, lyr == 0 ? INW - 1024 : INW, F.G, F.bx);
            if (lyr == 0) { S.skip_lo = 8; S.skip_n = 4; }
            pg8::Epi<pg8::EM_WIN> E{HB_, INW, nullptr, (const float*)(ws + WS_CSN), (float*)(ws + WS_QK8), lyr, 0.f};
            pg8::gemm_phase<pg8::Epi<pg8::EM_WIN>, pg8::StaticOrder, true, true>(F.lds, g, S, E);
            if (lyr == 0) {
                pg8::Gemm g2{(const bf16*)(ws + WS_WIN) + (size_t)2048 * 2048, XA_, 1024, T, 2048, 2048}; pg8::StaticOrder S2; S2.init(1024, T, F.G, F.bx);
                pg8::Epi<pg8::EM_VT8> E2{(bf16*)(ws + WS_VT8), 0, nullptr, nullptr, nullptr, 0, 4.0f};
                pg8::gemm_phase<pg8::Epi<pg8::EM_VT8>, pg8::StaticOrder, true, true>(F.lds, g2, S2, E2);
            }
        }
#endif
        PHASE_END(true)
        PHASE_BEGIN
#if PH_ON(3)
        REP(3)
            if (lyr == 0) p_diff_attn2(F, (char*)lds, HB_, OPB_);
#endif
        PHASE_END(false)
        PHASE_BEGIN
#if PH_ON(1)
        REP(1)
        if (lyr == 0) {
            pg8::Gemm g{(const bf16*)(ws + WS_MEMB), (const bf16*)(ws + WS_MEMKV), NMEMT, 512, 2048, 2048}; pg8::StaticOrder S; S.init(NMEMT, 512, F.G, F.bx);
            pg8::Epi<pg8::EM_PLAIN> E{KV_, 1024, nullptr, nullptr, nullptr, 0, 0.f};
            pg8::gemm_phase<pg8::Epi<pg8::EM_PLAIN>, pg8::StaticOrder, true, true>(F.lds, g, S, E);
            pg8::Gemm g2{(const bf16*)(ws + WS_MEMKV) + (size_t)512 * 2048, (const bf16*)(ws + WS_MEMB), 512, NMEMT, 2048, 2048}; pg8::StaticOrder S2; S2.init(512, NMEMT, F.G, (F.bx + F.G - 4) % F.G);
            pg8::Epi<pg8::EM_PLAIN> E2{(bf16*)(ws + WS_VTM), 512, nullptr, nullptr, nullptr, 0, 0.f};
            pg8::gemm_phase<pg8::Epi<pg8::EM_PLAIN>, pg8::StaticOrder, true, true>(F.lds, g2, S2, E2);
        }
#endif
        PHASE_END(false)
        PHASE_BEGIN
#if PH_ON(4)
        REP(4)
            if (lyr == 0) p_conformer(F, 0, HB_, MIX_);
#endif
        PHASE_END(false)
        PHASE_BEGIN
#if PH_ON(5)
        REP(5)
            if (lyr == 1) p_sgu(F, 0, HB_, MIX_);
#endif
        PHASE_END(false)
        PHASE_BEGIN
#if PH_ON(6)
        REP(6)
            if (lyr == 1) p_sconv(F, 0, HB_, MIX_);
#endif
        PHASE_END(true)
        PHASE_BEGIN
#if PH_ON(7)
        REP(7)
            if (lyr == 0) p_combine(F, 0, OPB_, MIX_);
#endif
        PHASE_END(lyr == 0)
        PHASE_BEGIN
#if PH_ON(8)
        REP(8)
        {
            pg8::Gemm g{MIX_, (const bf16*)(ws + WS_WOUT) + (size_t)lyr * 2048 * 2048, T, 2048, 2048, 2048}; pg8::StaticOrder S; S.init(T, 2048, F.G, F.bx);
            pg8::Epi<pg8::EM_RESID_ST> E{XB_, 2048, XA_, nullptr, (float*)(ws + WS_LOG), 0, ALPHA};
            pg8::gemm_phase<pg8::Epi<pg8::EM_RESID_ST>, pg8::StaticOrder, true, true>(F.lds, g, S, E);
        }
#endif
        PHASE_END(true)
        PHASE_BEGIN
#if PH_ON(10)
        REP(10)
        {
            pg8::Gemm g{XB_, (const bf16*)(ws + WS_XQ) + (size_t)lyr * 512 * 2048, T, 512, 2048, 2048}; pg8::StaticOrder S; S.init(T, 512, F.G, F.bx);
            {
              const float* st = (const float*)(ws + WS_LOG); float* rs = (float*)(ws + WS_RS); pg8::Unit u;
              for (int i = 0; i < 8 && S.next(i, u); ++i) { const int row = u.pm * 256 + (F.tid >> 1), hf = F.tid & 1;
                  const f32x4* p = (const f32x4*)(st + ((size_t)row * 32 + hf * 16) * 2); float s1 = 0.f, s2 = 0.f;
#pragma unroll
                  for (int j = 0; j < 8; ++j) { const f32x4 v = p[j]; s1 += v[0] + v[2]; s2 += v[1] + v[3]; }
                  s1 += __shfl_xor(s1, 1); s2 += __shfl_xor(s2, 1);
                  const float mu = s1 * (1.0f / 2048.0f), var = fmaxf(s2 * (1.0f / 2048.0f) - mu * mu, 0.f);
                  if (hf == 0) *(f32x2*)(rs + 2 * (size_t)row) = (f32x2){mu, 1.0f / sqrtf(var + LN_EPS)}; }
              VM_WAIT(); __syncthreads(); }
            pg8::Epi<pg8::EM_XQ> E{QC_, 512, nullptr, (const float*)(ws + WS_RS), (float*)(ws + WS_CSQ) + lyr * 1024, 0, 0.f};
            pg8::gemm_phase<pg8::Epi<pg8::EM_XQ>, pg8::StaticOrder, true, true>(F.lds, g, S, E);
        }
#endif
        PHASE_END(true)
        PHASE_BEGIN
#if PH_ON(11)
        REP(11)
            p_cross_attn2(F, (char*)lds, QC_, KV_, (const bf16*)(ws + WS_VTM), OC_);
#endif
        PHASE_END(true)
        PHASE_BEGIN
#if PH_ON(12)
        REP(12)
        {
            pg8::Gemm g{OC_, (const bf16*)(ws + WS_XO) + (size_t)lyr * 2048 * 512, T, 2048, 512, 512}; pg8::StaticOrder S; S.init(T, 2048, F.G, F.bx);
            pg8::Epi<pg8::EM_RESID_LN> E{XA_, 2048, XB_, (const float*)(ws + WS_RS), nullptr, 0, ALPHA, INP(5) + lyr * 2048, INP(6) + lyr * 2048};
            pg8::gemm_phase<pg8::Epi<pg8::EM_RESID_LN>, pg8::StaticOrder, ALIGN_SHORTK, true>(F.lds, g, S, E);
        }
#endif
        PHASE_END(true)
#if ROUTER_GEMM
        PHASE_BEGIN
#if PH_ON(13)
        REP(13)
            p_ln<0>(F, XA_, nullptr, nullptr, nullptr, INP(7) + lyr * 2048, INP(8) + lyr * 2048);
#endif
        PHASE_END(true)
#endif
#if ROUTER_GEMM
        PHASE_BEGIN
#if PH_ON(14)
        REP(14)
        {
            pg8::Gemm g{XA_, (const bf16*)(ws + WS_ROUT) + (size_t)lyr * 256 * 2048, T, 256, 1024, 2048}; pg8::SplitK2Order S{T / 256, F.G, F.bx, 1024};
            pg8::Epi<pg8::EM_LOGITS> E{nullptr, 0, nullptr, nullptr, (float*)(dout + DO_OP), 0, 0.f};
            pg8::gemm_phase<pg8::Epi<pg8::EM_LOGITS>, pg8::SplitK2Order, true, true>(F.lds, g, S, E);
        }
#endif
        PHASE_END(true)
        PHASE_BEGIN
#if PH_ON(15)
        REP(15)
            p_route(F, 0, lyr);
#endif
        PHASE_END(true)
#else
        PHASE_BEGIN
#if PH_ON(14)
        REP(14)
            p_router_route(F, lyr, XA_, INP(7) + lyr * 2048, INP(8) + lyr * 2048);
#endif
        PHASE_END(true)
#endif
        PHASE_BEGIN
#if PH_ON(16)
        REP(16)
            p_dispatch(F, 0, XA_, HB_);
#endif
        PHASE_END(true)
        PHASE_BEGIN
#if PH_ON(17)
        REP(17)
        {
            const int* tile = (const int*)(ws + WS_TILE); const int ntile = tile[400];
            LAS int* rtab = (LAS int*)(F.lds + SCR_OFF);
            pg8::Gemm g{XA_, (const bf16*)(ws + WS_W13) + (size_t)lyr * 32 * 1024 * 2048, RMAX, 32 * 1024, 2048, 2048};
            pg8::MoeOrder1H S{tile, ntile, F.G, F.bx, rtab, (unsigned*)(ws + WS_CTL) + CW_HO + 64 * 288 * lyr, (unsigned*)(ws + WS_CTL) + CW_HO + 64 * (576 + 8 * lyr)};
            { const int* rowt = (const int*)(ws + WS_ROWT); pg8::Unit u;
              for (int i = 0; i < 8 && S.next(i, u); ++i) if (F.tid < 256) rtab[i * 256 + F.tid] = rowt[u.pm * 256 + F.tid];
              __syncthreads(); }
            pg8::Epi<pg8::EM_SWIGLU_WT> E{HBM_, 512, nullptr, nullptr, nullptr, 0, 0.f};
            pg8::gemm_phase_g<pg8::Epi<pg8::EM_SWIGLU_WT>, pg8::MoeOrder1H, true, true>(F.lds, g, S, E);
        }
#endif
        PHASE_END(HO_BARRIER)
        PHASE_BEGIN
#if PH_ON(18)
        REP(18)
        {
            const int* tile = (const int*)(ws + WS_TILE); const int ntile = tile[400];
            pg8::Gemm g{HBM_, (const bf16*)(ws + WS_W2) + (size_t)lyr * 32 * 2048 * 512, RMAX, 32 * 2048, 512, 512};
            pg8::MoeOrder2H S{tile, ntile, F.G, F.bx, (unsigned*)(ws + WS_CTL) + CW_HO + 64 * 288 * lyr, 32u, (unsigned*)(ws + WS_CTL) + CW_HO + 64 * (576 + 8 * lyr)};
            pg8::Epi<pg8::EM_ROWSCALE> E{HB_, 2048, nullptr, (const float*)(ws + WS_ROWW), nullptr, 0, 0.f};
            pg8::gemm_phase<pg8::Epi<pg8::EM_ROWSCALE>, pg8::MoeOrder2H, ALIGN_SHORTK, true>(F.lds, g, S, E);
        }
#endif
        PHASE_END(true)
        PHASE_BEGIN
#if PH_ON(19)
        REP(19)
            if (lyr == 0) p_ln<1>(F, XA_, HB_, (const int*)(ws + WS_TOKD), nullptr, INP(9), INP(10));
#endif
        PHASE_END(false)
        PHASE_BEGIN
#if PH_ON(20)
        REP(20)
            if (lyr == 1) p_ln<2>(F, XA_, HB_, (const int*)(ws + WS_TOKD), (float*)dout, INP(9) + 2048, INP(10) + 2048);
#endif
        PHASE_END(true)
    }
#undef PHASE_BEGIN
#undef PHASE_END
}

extern "C" void kernel_launch(void* const* d_in, const int* in_sizes, int n_in, void* d_out, int out_size, void* d_ws, size_t ws_size, hipStream_t stream) {
    static int grid = 0;
    if (grid == 0) {
        if (n_in != 35 || in_sizes[0] != T * DM || out_size != T * DM || ws_size < WS_END) { fprintf(stderr, "kernel_launch: unexpected shapes / workspace (n_in %d, ws %zu)\n", n_in, ws_size); grid = -1; return; }
        int dev = 0, cus = 0;
        if (hipGetDevice(&dev) != hipSuccess || hipDeviceGetAttribute(&cus, hipDeviceAttributeMultiprocessorCount, dev) != hipSuccess) { grid = -1; return; }
        if (hipFuncSetAttribute((const void*)fwd_kernel, hipFuncAttributeMaxDynamicSharedMemorySize, LDS_BYTES) != hipSuccess) { fprintf(stderr, "kernel_launch: hipFuncSetAttribute failed\n"); grid = -1; return; }
        int per_cu = 0;
        if (hipOccupancyMaxActiveBlocksPerMultiprocessor(&per_cu, (const void*)fwd_kernel, NWAVES * 64, LDS_BYTES) != hipSuccess || per_cu < 1) { fprintf(stderr, "kernel_launch: occupancy query says %d\n", per_cu); }
        (void)hipGetLastError();
        grid = cus > 0 ? cus : 256;
    }
    if (grid < 0) return;
    (void)hipMemsetAsync((char*)d_ws + WS_CTL, 0, CTL_ZERO_BYTES, stream);
    Args a{};
    for (int i = 0; i < 35; ++i) a.in[i] = d_in[i];
    a.out = (unsigned char*)d_out; a.ws = (unsigned char*)d_ws; a.ph_lo = 0; a.ph_hi = 1000;
    hipLaunchKernelGGL(fwd_kernel, dim3(grid), dim3(NWAVES * 64), LDS_BYTES, stream, a);
}
```

```cpp
#define DUPMASK (0)
#include <hip/hip_runtime.h>
#include <hip/hip_bf16.h>
#include <cstdio>
#include <cstdint>
#include <cmath>

namespace pg8 {
#define PG8_LAS __attribute__((address_space(3)))
typedef unsigned short bf16_t;
typedef short bf16x8 __attribute__((ext_vector_type(8)));
typedef float f32x4 __attribute__((ext_vector_type(4)));
typedef float f32x2 __attribute__((ext_vector_type(2)));
typedef unsigned u32x4 __attribute__((ext_vector_type(4)));
constexpr int BM = 256, BK = 64, HALF = 128, HTB = HALF * BK * 2  , STAGE_BYTES = 8 * HTB, NXCD = 8, WGM = 8;

__host__ __device__ __forceinline__ int lds_byte(int r, int c) { const int st = (r >> 4) * 2 + (c >> 5), rr = r & 15, cc = c & 31, ob = rr * 64 + cc * 2; return st * 1024 + (ob ^ (((ob >> 9) & 1) << 5)); }
__host__ __device__ __forceinline__ void stage_rc(int b, int& R, int& C) { const int st = b / 1024, sb = b % 1024, swz = sb ^ (((sb >> 9) & 1) << 5); R = (st >> 1) * 16 + swz / 64; C = (st & 1) * 32 + (swz % 64) / 2; }
__host__ __device__ __forceinline__ int perm32(int rho) { const int n = rho >> 4, i = rho & 15; return 8 * (i >> 2) + 4 * n + (i & 3); }

struct Unit { int pm, pn, pb, ko; };
struct Gemm { const bf16_t* A; const bf16_t* Bt; int M, N, K, ld; };

struct StaticOrder {
    int nM, nN, nwg, G, c, skip_lo = 1 << 30, skip_n = 0;
    __host__ __device__ void init(int M, int N, int G_, int c_) { nM = M / BM; nN = N / BM; nwg = nM * nN; G = G_; c = c_; }
    __host__ __device__ __forceinline__ bool next(int i, Unit& u) const {
        const long L = (long)i * G + c; if (L >= nwg) return false;
        int wgid = (int)L; { const int q = nwg / NXCD, r = nwg % NXCD, xcd = wgid % NXCD, off = wgid / NXCD; wgid = (xcd < r ? xcd * (q + 1) : r * (q + 1) + (xcd - r) * q) + off; }
        const int nig = WGM * nN, gid = wgid / nig, fm = gid * WGM, gsz = (nM - fm) < WGM ? (nM - fm) : WGM;
        u.pm = fm + ((wgid % nig) % gsz); u.pn = (wgid % nig) / gsz; if (u.pn >= skip_lo) u.pn += skip_n; u.pb = u.pn; u.ko = 0; return true;
    }
    __device__ __forceinline__ void a_ready(const Unit&) const {}
    __device__ __forceinline__ void done(const Unit&) const {}
};
struct SplitK2Order {
    int nM, G, c, khalf;
    __device__ __forceinline__ bool next(int i, Unit& u) const { const int L = i * G + c; if (L >= 2 * nM) return false; u.pm = L >> 1; u.pn = L & 1; u.pb = 0; u.ko = (L & 1) * khalf; return true; }
    __device__ __forceinline__ void a_ready(const Unit&) const {}
    __device__ __forceinline__ void done(const Unit&) const {}
};
struct MoeOrder {
    const int* tile_e; int n_units, NT, G, c; const PG8_LAS int* rtab;
    __device__ __forceinline__ bool next(int i, Unit& u) const {
        int rt, pn;
        if (G % (8 * NT) == 0) { const int x = c & 7, k = c >> 3, per_x = (G >> 3) / NT; rt = i * (G / NT) + x * per_x + k / NT; pn = k % NT; if (rt * NT >= n_units) return false; }
        else { const long L = (long)i * G + c; if (L >= n_units) return false; rt = (int)L / NT; pn = (int)L % NT; }
        u.pm = rt; u.pn = pn; u.pb = tile_e[rt] * NT + pn; u.ko = 0; return true;
    }
    __device__ __forceinline__ void a_ready(const Unit&) const {}
    __device__ __forceinline__ void done(const Unit&) const {}
};

struct MoeOrder1H {
    const int* tile_e; int ntile, G, c; const PG8_LAS int* rtab; unsigned* cnt; unsigned* full;
    __device__ __forceinline__ bool next(int i, Unit& u) const {
        int rt, pn;
        if (G == 256) { const int x = c & 7, k = c >> 3, R1 = ntile >> 6, rem = ntile & 63;
            if (i < R1) rt = i * 64 + x * 8 + (k >> 2);
            else if (i == R1) { const int j = (k >> 2) * 8 + x; if (j >= rem) return false; rt = R1 * 64 + j; }
            else return false;
            pn = k & 3; }
        else { const long L = (long)i * G + c; if (L >= (long)ntile * 4) return false; rt = (int)(L >> 2); pn = (int)(L & 3); }
        u.pm = rt; u.pn = pn; u.pb = tile_e[rt] * 4 + pn; u.ko = 0; return true; }
    __device__ __forceinline__ void a_ready(const Unit&) const {}
    __device__ __forceinline__ void done(const Unit& u) const {
        asm volatile("s_waitcnt vmcnt(0)" ::: "memory");
        if ((threadIdx.x & 63) == 0) { (void)__hip_atomic_fetch_add(cnt + 64 * u.pm, 1u, __ATOMIC_RELAXED, __HIP_MEMORY_SCOPE_AGENT);
            if (G == 256 && (u.pm >> 6) == (ntile >> 6) - 1) (void)__hip_atomic_fetch_add(full + 64 * (c & 7), 1u, __ATOMIC_RELAXED, __HIP_MEMORY_SCOPE_AGENT); } }
};
struct MoeOrder2H {
    const int* tile_e; int ntile, G, c; unsigned* cnt; unsigned need; unsigned* full; mutable bool fd = false;
    __device__ __forceinline__ bool next(int i, Unit& u) const {
        int rt, pn;
        if (G == 256) { const int x = c & 7, k = c >> 3, R1 = ntile >> 6, rem = ntile & 63;
            int ntx = rem > x ? (rem - x + 7) >> 3 : 0; if (ntx > 7) ntx = 0;
            const int U = 8 * (8 * R1 + ntx), Hc = 4 * ntx, Lc = 32 - Hc;
            int ra = (U - 2 * Lc) >> 5; if (ra < 0) ra = 0;
            int idx;
            if (i < ra) idx = i * 32 + k; else { if (k < Hc) return false; idx = ra * 32 + (i - ra) * Lc + (k - Hc); }
            if (idx >= U) return false;
            const int rp = idx >> 3; pn = idx & 7;
            rt = rp < 8 * R1 ? ((rp >> 3) * 64 + x * 8 + (rp & 7)) : (R1 * 64 + (rp - 8 * R1) * 8 + x); }
        else { const long L = (long)i * G + c; if (L >= (long)ntile * 8) return false; rt = (int)(L >> 3); pn = (int)(L & 7); }
        u.pm = rt; u.pn = pn; u.pb = tile_e[rt] * 8 + pn; u.ko = 0; return true; }
#ifdef HO_NOWAIT
    __device__ __forceinline__ void a_ready(const Unit&) const {}
#else
    __device__ __forceinline__ void a_ready(const Unit& u) const {
        const bool fr_ = (G == 256) && u.pm < ((ntile >> 6) << 6);
        if (fr_ && fd) return;
        const unsigned* w_ = fr_ ? full + 64 * (c & 7) : cnt + 64 * u.pm; const unsigned nd_ = fr_ ? 256u : need;
        if (threadIdx.x < 64) { unsigned polls = 0;
            while ((unsigned)__builtin_amdgcn_readfirstlane(__hip_atomic_load(w_, __ATOMIC_RELAXED, __HIP_MEMORY_SCOPE_AGENT)) < nd_) {
                __builtin_amdgcn_s_sleep(2); if (++polls > (1u << 22)) break; }
            __builtin_amdgcn_fence(__ATOMIC_ACQUIRE, "agent");
            asm volatile("s_waitcnt vmcnt(0)" ::: "memory"); }
        asm volatile("" ::: "memory"); __builtin_amdgcn_s_barrier(); asm volatile("" ::: "memory");
        if (fr_) fd = true; }
#endif
    __device__ __forceinline__ void done(const Unit&) const {}
};

__device__ __forceinline__ unsigned cvt_pk_bf16(float lo, float hi) { unsigned r; asm volatile("v_cvt_pk_bf16_f32 %0, %1, %2" : "=v"(r) : "v"(lo), "v"(hi)); return r; }
__device__ __forceinline__ float bf_lo(unsigned w) { return __uint_as_float(w << 16); }
__device__ __forceinline__ float bf_hi(unsigned w) { return __uint_as_float(w & 0xffff0000u); }
__device__ __forceinline__ f32x2 gelu_pk(f32x2 v) {
    const f32x2 av = __builtin_elementwise_abs(v), d = av * 0.2316418882f + 1.0f;
    f32x2 t; t.x = __builtin_amdgcn_rcpf(d.x); t.y = __builtin_amdgcn_rcpf(d.y);
    f32x2 q = t * 0.5307027145f + (-0.7265760135f); q = q * t + 0.7107068705f; q = q * t + (-0.142248368f); q = q * t + 0.127414796f; q = q * t;
    const f32x2 s = (v * v) * (-0.72134752044f);
    f32x2 e; e.x = __builtin_amdgcn_exp2f(s.x); e.y = __builtin_amdgcn_exp2f(s.y);
    const f32x2 m = v * (q * e), r = v - m;
    f32x2 o; o.x = v.x < 0.f ? m.x : r.x; o.y = v.y < 0.f ? m.y : r.y; return o;
}
__device__ __forceinline__ float silu_f(float x) { return x * __builtin_amdgcn_rcpf(1.0f + __builtin_amdgcn_exp2f(-1.4426950408889634f * x)); }

enum { EM_PLAIN = 0, EM_WIN = 1, EM_RESID = 2, EM_LOGITS = 3, EM_SWIGLU = 4, EM_ROWSCALE = 5, EM_VT8 = 7, EM_RESID_ST = 8, EM_XQ = 9, EM_RESID_LN = 10, EM_SWIGLU_WT = 11   };
typedef unsigned u32x2 __attribute__((ext_vector_type(2)));
__device__ __forceinline__ unsigned pk_fp8x4(float a, float b, float c, float d) { int w = __builtin_amdgcn_cvt_pk_fp8_f32(a, b, __builtin_bit_cast(int, a), false); w = __builtin_amdgcn_cvt_pk_fp8_f32(c, d, w, true); return (unsigned)w; }
__device__ __forceinline__ unsigned pk_fp8x4o(float a, float b, float c, float d, int old) { int w = __builtin_amdgcn_cvt_pk_fp8_f32(a, b, old, false); w = __builtin_amdgcn_cvt_pk_fp8_f32(c, d, w, true); return (unsigned)w; }
template <int MODE> struct Epi {
    static constexpr bool PERM = true, AFTER_DRAIN = false;
    bf16_t* O; int ldc;
    const bf16_t* R;
    const float* aux;
    float* OF;
    int lyr;
    float alpha;
    const float* aux2 = nullptr; const float* aux3 = nullptr;
    __device__ __forceinline__ void store8(bf16_t* p, f32x4 v0, f32x4 v1) const {
        u32x4 w; w.x = cvt_pk_bf16(v0[0], v0[1]); w.y = cvt_pk_bf16(v0[2], v0[3]); w.z = cvt_pk_bf16(v1[0], v1[1]); w.w = cvt_pk_bf16(v1[2], v1[3]); *(u32x4*)p = w; }
    __device__ __forceinline__ void store8_wt(bf16_t* p, f32x4 v0, f32x4 v1) const {
        u32x4 w; w.x = cvt_pk_bf16(v0[0], v0[1]); w.y = cvt_pk_bf16(v0[2], v0[3]); w.z = cvt_pk_bf16(v1[0], v1[1]); w.w = cvt_pk_bf16(v1[2], v1[3]);
        asm volatile("global_store_dwordx4 %0, %1, off sc1\n\ts_nop 1" :: "v"(p), "v"(w) : "memory"); }
    __device__ __forceinline__ void operator()(const f32x4 (&acc)[2][2][4][2], const Unit& u, int wr, int wc, int fr, int fq) const {
        const int row0 = u.pm * BM + wr * 64 + fr;
        if constexpr (MODE == EM_LOGITS) {
            if (wc < 2) {
#pragma unroll
                for (int ai = 0; ai < 2; ++ai)
#pragma unroll
                    for (int m = 0; m < 4; ++m) { float* p = OF + (size_t)u.pn * (32768 * 64) + (size_t)(row0 + ai * HALF + m * 16) * 64 + wc * 32 + 8 * fq;
                        *(f32x4*)p = acc[ai][0][m][0]; *(f32x4*)(p + 4) = acc[ai][0][m][1]; }
            }
        } else if constexpr (MODE == EM_VT8) {
            unsigned char* O8 = (unsigned char*)O;
#pragma unroll
            for (int ai = 0; ai < 2; ++ai)
#pragma unroll
                for (int m = 0; m < 4; ++m) { const int row = row0 + ai * HALF + m * 16;
#pragma unroll
                    for (int bj = 0; bj < 2; ++bj) { const int col0 = u.pn * BM + bj * HALF + wc * 32 + 8 * fq; const f32x4 v0 = acc[ai][bj][m][0] * alpha, v1 = acc[ai][bj][m][1] * alpha;
                        u32x2 w; w.x = pk_fp8x4(v0[0], v0[1], v0[2], v0[3]); w.y = pk_fp8x4(v1[0], v1[1], v1[2], v1[3]);
                        unsigned char* bp = O8 + ((size_t)(col0 >> 14) * 1024 + row) * 16384 + (col0 & 16383 & ~63); const int g = (col0 & 63) >> 2, d = 4 * (g >> 3) + ((g & 7) >> 1);
                        *(unsigned*)(bp + 4 * d) = w.x; *(unsigned*)(bp + 4 * d + 32) = w.y; } }
        } else if constexpr (MODE == EM_SWIGLU || MODE == EM_SWIGLU_WT) {
            const int col0 = u.pn * HALF + wc * 32 + 8 * fq;
#pragma unroll
            for (int ai = 0; ai < 2; ++ai)
#pragma unroll
                for (int m = 0; m < 4; ++m) { f32x4 v0, v1;
#pragma unroll
                    for (int j = 0; j < 4; ++j) { v0[j] = silu_f(acc[ai][0][m][0][j]) * acc[ai][1][m][0][j]; v1[j] = silu_f(acc[ai][0][m][1][j]) * acc[ai][1][m][1][j]; }
                    if constexpr (MODE == EM_SWIGLU_WT) store8_wt(O + (size_t)(row0 + ai * HALF + m * 16) * ldc + col0, v0, v1);
                    else store8(O + (size_t)(row0 + ai * HALF + m * 16) * ldc + col0, v0, v1); }
        } else {
            const int col0 = u.pn * BM + wc * 32 + 8 * fq;
            const bool rope = (MODE == EM_WIN) && lyr == 0 && u.pn < 8 && wc == 0;
            const bool gelu = (MODE == EM_WIN) && lyr == 1 && u.pn < 8;
            const bool glu = (MODE == EM_WIN) && lyr == 0 && u.pn >= 12;
            f32x4 cA[2][2], cB[2][2];
            if constexpr (MODE == EM_XQ) {
#pragma unroll
                for (int bj = 0; bj < 2; ++bj)
#pragma unroll
                    for (int n = 0; n < 2; ++n) { cA[bj][n] = *(const f32x4*)(OF + col0 + bj * HALF + 4 * n); cB[bj][n] = *(const f32x4*)(OF + 512 + col0 + bj * HALF + 4 * n); } }
            if constexpr (MODE == EM_RESID_LN) {
#pragma unroll
                for (int bj = 0; bj < 2; ++bj)
#pragma unroll
                    for (int n = 0; n < 2; ++n) { cA[bj][n] = *(const f32x4*)(aux2 + col0 + bj * HALF + 4 * n) * alpha; cB[bj][n] = *(const f32x4*)(aux3 + col0 + bj * HALF + 4 * n) * alpha; } }
#pragma unroll
            for (int ai = 0; ai < 2; ++ai)
#pragma unroll
                for (int m = 0; m < 4; ++m) { const int row = row0 + ai * HALF + m * 16; bf16_t* rowp = O + (size_t)row * ldc + col0;
                    float rs = 1.f; if constexpr (MODE == EM_ROWSCALE) rs = aux[row];
                    f32x2 mr = (f32x2){0.f, 1.f}; if constexpr (MODE == EM_XQ || MODE == EM_RESID_LN) mr = *(const f32x2*)(aux + 2 * (size_t)row);
                    float s1 = 0.f, s2 = 0.f;
                    f32x4 cs0, cs1, sn0, sn1;
                    if constexpr (MODE == EM_WIN) { if (rope) { const float* cp = aux + (size_t)row * 32 + (fq & 1) * 8; cs0 = *(const f32x4*)cp; cs1 = *(const f32x4*)(cp + 4); sn0 = *(const f32x4*)(cp + 16); sn1 = *(const f32x4*)(cp + 20); } }
                    if (MODE == EM_WIN && glu) { f32x4 c0, c1;
#pragma unroll
                        for (int j = 0; j < 4; ++j) { c0[j] = acc[ai][0][m][0][j] * __builtin_amdgcn_rcpf(1.0f + __builtin_amdgcn_exp2f(-1.4426950408889634f * acc[ai][1][m][0][j]));
                                                      c1[j] = acc[ai][0][m][1][j] * __builtin_amdgcn_rcpf(1.0f + __builtin_amdgcn_exp2f(-1.4426950408889634f * acc[ai][1][m][1][j])); }
                        store8(O + (size_t)row * ldc + 3072 + (u.pn - 12) * HALF + wc * 32 + 8 * fq, c0, c1); continue; }
#pragma unroll
                    for (int bj = 0; bj < 2; ++bj) { f32x4 v0 = acc[ai][bj][m][0], v1 = acc[ai][bj][m][1];
                        if constexpr (MODE == EM_WIN) {
                            if (rope) {
                                f32x4 p0, p1;
#pragma unroll
                                for (int j = 0; j < 4; ++j) { p0[j] = __shfl_xor(v0[j], 32); p1[j] = __shfl_xor(v1[j], 32); }
                                const float sg = (fq < 2) ? -1.f : 1.f;
#pragma unroll
                                for (int j = 0; j < 4; ++j) { v0[j] = v0[j] * cs0[j] + sg * p0[j] * sn0[j]; v1[j] = v1[j] * cs1[j] + sg * p1[j] * sn1[j]; }
                            } else if (gelu) {
                                f32x2 a = gelu_pk((f32x2){v0[0], v0[1]}), b = gelu_pk((f32x2){v0[2], v0[3]}), c = gelu_pk((f32x2){v1[0], v1[1]}), d = gelu_pk((f32x2){v1[2], v1[3]});
                                v0 = (f32x4){a.x, a.y, b.x, b.y}; v1 = (f32x4){c.x, c.y, d.x, d.y};
                            }
                        }
                        if constexpr (MODE == EM_XQ) { const float t = -mr.x * mr.y; v0 = v0 * mr.y + (cA[bj][0] * t + cB[bj][0]); v1 = v1 * mr.y + (cA[bj][1] * t + cB[bj][1]); }
                        if constexpr (MODE == EM_RESID_LN) { const u32x4 rw = __builtin_nontemporal_load((const u32x4*)(R + (size_t)row * ldc + col0 + bj * HALF));
                            const f32x4 y0 = ((f32x4){bf_lo(rw.x), bf_hi(rw.x), bf_lo(rw.y), bf_hi(rw.y)} - mr.x) * mr.y, y1 = ((f32x4){bf_lo(rw.z), bf_hi(rw.z), bf_lo(rw.w), bf_hi(rw.w)} - mr.x) * mr.y;
                            v0 = v0 + (y0 * cA[bj][0] + cB[bj][0]); v1 = v1 + (y1 * cA[bj][1] + cB[bj][1]); }
                        if constexpr (MODE == EM_RESID || MODE == EM_RESID_ST) { const u32x4 rw = __builtin_nontemporal_load((const u32x4*)(R + (size_t)row * ldc + col0 + bj * HALF));
                            v0[0] += alpha * bf_lo(rw.x); v0[1] += alpha * bf_hi(rw.x); v0[2] += alpha * bf_lo(rw.y); v0[3] += alpha * bf_hi(rw.y);
                            v1[0] += alpha * bf_lo(rw.z); v1[1] += alpha * bf_hi(rw.z); v1[2] += alpha * bf_lo(rw.w); v1[3] += alpha * bf_hi(rw.w); }
                        if constexpr (MODE == EM_RESID_ST) { s1 += ((v0[0] + v0[1]) + (v0[2] + v0[3])) + ((v1[0] + v1[1]) + (v1[2] + v1[3]));
                            s2 += ((v0[0] * v0[0] + v0[1] * v0[1]) + (v0[2] * v0[2] + v0[3] * v0[3])) + ((v1[0] * v1[0] + v1[1] * v1[1]) + (v1[2] * v1[2] + v1[3] * v1[3])); }
                        if constexpr (MODE == EM_ROWSCALE) { v0 = v0 * rs; v1 = v1 * rs; }
                        if (MODE == EM_WIN && lyr == 0 && u.pn < 8) {
                            u32x2 w8; w8.x = pk_fp8x4(v0[0], v0[1], v0[2], v0[3]); w8.y = pk_fp8x4(v1[0], v1[1], v1[2], v1[3]);
                            *(u32x2*)((unsigned char*)OF + (size_t)row * 2048 + col0 + bj * HALF) = w8; }
                        else store8(rowp + bj * HALF, v0, v1); }
                    if constexpr (MODE == EM_RESID_ST) { s1 += __shfl_xor(s1, 16); s2 += __shfl_xor(s2, 16); s1 += __shfl_xor(s1, 32); s2 += __shfl_xor(s2, 32);
                        if (fq == 0) *(f32x2*)(OF + ((size_t)row * 32 + u.pn * 4 + wc) * 2) = (f32x2){s1, s2}; } }
        }
    }
};

template <class Epi, class Sched, bool ALIGN_EPI = false, bool SP2 = false>
__device__ __forceinline__ void gemm_phase(PG8_LAS unsigned char* lds, const Gemm g, const Sched& S, const Epi& E) {
    int tid_ = threadIdx.x; asm volatile("" : "+v"(tid_)); const int tid = tid_, wid = __builtin_amdgcn_readfirstlane(tid >> 6), lane = tid & 63, wr = wid >> 2, wc = wid & 3, fr = lane & 15, fq = lane >> 4;
    const int K = g.K, nt = K / BK, LD = g.ld;
    unsigned voffA[2], voffB[2];
#pragma unroll
    for (int i = 0; i < 2; ++i) { int R, C; stage_rc(tid * 16 + i * 8192, R, C); const int Rb = Epi::PERM ? ((R & ~31) + perm32(R & 31)) : R;
        voffA[i] = (unsigned)(R * LD + C) * 2u; voffB[i] = (unsigned)(Rb * LD + C) * 2u; }
    const size_t kstep = (size_t)(BK * 2);
    const size_t hstep = (size_t)HALF * LD * 2;
    const size_t tstep = 2 * hstep;
    const unsigned ldsw = (unsigned)wid * 1024u;
    const int aoff = lds_byte(wr * 64 + fr, fq * 8), boff = lds_byte(wc * 32 + fr, fq * 8);
#define PG8_SA(b, h) (((b) * 2 + (h)) * HTB)
#define PG8_SB(b, h) ((4 + (b) * 2 + (h)) * HTB)
#define PG8_STAGE(bufoff, gbase, voff) do { _Pragma("unroll") for (int _i = 0; _i < 2; ++_i) \
        __builtin_amdgcn_global_load_lds((const unsigned*)((const char*)(gbase) + (voff)[_i]), (PG8_LAS unsigned*)(lds + (bufoff) + ldsw + _i * 8192), 16, 0, 0); } while (0)
#define PG8_LDA(dst, b, h) do { _Pragma("unroll") for (int m = 0; m < 4; ++m) _Pragma("unroll") for (int k = 0; k < 2; ++k) dst[m][k] = *(const PG8_LAS bf16x8*)(lds + PG8_SA(b, h) + aoff + m * 2048 + k * 1024); } while (0)
#define PG8_LDB(dst, b, h) do { _Pragma("unroll") for (int n = 0; n < 2; ++n) _Pragma("unroll") for (int k = 0; k < 2; ++k) dst[n][k] = *(const PG8_LAS bf16x8*)(lds + PG8_SB(b, h) + boff + n * 2048 + k * 1024); } while (0)
#define PG8_MMA(ai, bj, At, Bt) do { __builtin_amdgcn_s_setprio(1); _Pragma("unroll") for (int m = 0; m < 4; ++m) _Pragma("unroll") for (int n = 0; n < 2; ++n) _Pragma("unroll") for (int k = 0; k < 2; ++k) \
        acc[ai][bj][m][n] = __builtin_amdgcn_mfma_f32_16x16x32_bf16(Bt[n][k], At[m][k], acc[ai][bj][m][n], 0, 0, 0); __builtin_amdgcn_s_setprio(0); } while (0)
#define PG8_WAIT_V(n) asm volatile("s_waitcnt vmcnt(" #n ")" ::: "memory")
#define PG8_WAIT_L(n) asm volatile("s_waitcnt lgkmcnt(" #n ")" ::: "memory")
#define PG8_BAR __builtin_amdgcn_s_barrier()
#define PG8_SCHED __builtin_amdgcn_sched_barrier(0)
    Unit cur, nxt; int ui = 0;
    if (!S.next(0, cur)) return;
    f32x4 acc[2][2][4][2];
#pragma unroll
    for (int a = 0; a < 2; ++a)
#pragma unroll
        for (int b = 0; b < 2; ++b)
#pragma unroll
            for (int m = 0; m < 4; ++m)
#pragma unroll
                for (int n = 0; n < 2; ++n) acc[a][b][m][n] = (f32x4){0.f, 0.f, 0.f, 0.f};
    bf16x8 At[4][2], B0[2][2], B1[2][2];
    const char* cA = (const char*)g.A + (size_t)cur.pm * tstep + (size_t)cur.ko * 2; const char* cB = (const char*)g.Bt + (size_t)cur.pb * tstep + (size_t)cur.ko * 2;
    S.a_ready(cur);
    if constexpr (SP2) {
        PG8_STAGE(PG8_SB(0, 0), cB, voffB); PG8_STAGE(PG8_SB(0, 1), cB + hstep, voffB); PG8_STAGE(PG8_SA(0, 0), cA, voffA); PG8_STAGE(PG8_SA(0, 1), cA + hstep, voffA);
        if (wr == 1) PG8_BAR;
        PG8_WAIT_V(2); PG8_BAR;
        PG8_STAGE(PG8_SB(1, 0), cB + kstep, voffB); PG8_STAGE(PG8_SA(1, 0), cA + kstep, voffA); PG8_STAGE(PG8_SB(1, 1), cB + hstep + kstep, voffB);
        PG8_WAIT_V(6); PG8_BAR;
    } else {
        PG8_STAGE(PG8_SB(0, 0), cB, voffB); PG8_STAGE(PG8_SA(0, 0), cA, voffA); PG8_STAGE(PG8_SB(0, 1), cB + hstep, voffB); PG8_STAGE(PG8_SA(0, 1), cA + hstep, voffA);
        if (wr == 1) PG8_BAR;
        PG8_WAIT_V(4); PG8_BAR;
        PG8_STAGE(PG8_SB(1, 0), cB + kstep, voffB); PG8_STAGE(PG8_SA(1, 0), cA + kstep, voffA); PG8_STAGE(PG8_SB(1, 1), cB + hstep + kstep, voffB);
        PG8_WAIT_V(6); PG8_BAR;
    }
    for (;;) {
        const bool has_next = S.next(ui + 1, nxt);
        const char* nA = has_next ? (const char*)g.A + (size_t)nxt.pm * tstep + (size_t)nxt.ko * 2 : cA; const char* nB = has_next ? (const char*)g.Bt + (size_t)nxt.pb * tstep + (size_t)nxt.ko * 2 : cB;
        for (int t = 0; t < nt; t += 2) {
            const bool last = (t == nt - 2);
            const char* a1 = cA + (size_t)(t + 1) * kstep;
            const char* a2 = last ? nA : cA + (size_t)(t + 2) * kstep; const char* b2 = last ? nB : cB + (size_t)(t + 2) * kstep;
            const char* a3 = a2 + kstep; const char* b3 = b2 + kstep;
            if (last && has_next) S.a_ready(nxt);
            if constexpr (SP2) {
            PG8_LDB(B0, 0, 0); PG8_LDB(B1, 0, 1); PG8_SCHED; PG8_LDA(At, 0, 0); PG8_STAGE(PG8_SA(1, 1), a1 + hstep, voffA);
            PG8_WAIT_V(8); PG8_WAIT_L(0); PG8_BAR; PG8_MMA(0, 0, At, B0); PG8_MMA(0, 1, At, B1); PG8_BAR; PG8_SCHED;
            PG8_LDA(At, 0, 1); PG8_STAGE(PG8_SB(0, 0), b2, voffB); PG8_STAGE(PG8_SB(0, 1), b2 + hstep, voffB); PG8_STAGE(PG8_SA(0, 0), a2, voffA);
            PG8_WAIT_V(8); PG8_WAIT_L(0); PG8_BAR; PG8_MMA(1, 0, At, B0); PG8_MMA(1, 1, At, B1); PG8_BAR; PG8_SCHED;
            PG8_LDB(B0, 1, 0); PG8_LDB(B1, 1, 1); PG8_SCHED; PG8_LDA(At, 1, 0); PG8_STAGE(PG8_SA(0, 1), a2 + hstep, voffA);
            PG8_WAIT_V(8); PG8_WAIT_L(0); PG8_BAR; PG8_MMA(0, 0, At, B0); PG8_MMA(0, 1, At, B1); PG8_BAR; PG8_SCHED;
            PG8_LDA(At, 1, 1); PG8_STAGE(PG8_SB(1, 0), b3, voffB); PG8_STAGE(PG8_SB(1, 1), b3 + hstep, voffB); PG8_STAGE(PG8_SA(1, 0), a3, voffA);
            PG8_WAIT_V(8); PG8_WAIT_L(0); PG8_BAR; PG8_MMA(1, 0, At, B0); PG8_MMA(1, 1, At, B1); PG8_BAR; PG8_SCHED;
            } else {
            PG8_LDB(B0, 0, 0); PG8_SCHED; PG8_LDA(At, 0, 0); PG8_STAGE(PG8_SA(1, 1), a1 + hstep, voffA);
            PG8_WAIT_L(8); PG8_BAR; PG8_WAIT_L(0); PG8_MMA(0, 0, At, B0); PG8_BAR; PG8_SCHED;
            PG8_LDB(B1, 0, 1); PG8_STAGE(PG8_SB(0, 0), b2, voffB);
            PG8_BAR; PG8_WAIT_L(0); PG8_MMA(0, 1, At, B1); PG8_BAR;
            PG8_LDA(At, 0, 1); PG8_STAGE(PG8_SA(0, 0), a2, voffA);
            PG8_BAR; PG8_WAIT_L(0); PG8_MMA(1, 0, At, B0); PG8_BAR; PG8_SCHED;
            PG8_STAGE(PG8_SB(0, 1), b2 + hstep, voffB);
            PG8_WAIT_V(6); PG8_BAR; PG8_MMA(1, 1, At, B1); PG8_BAR;
            PG8_LDB(B0, 1, 0); PG8_SCHED; PG8_LDA(At, 1, 0); PG8_STAGE(PG8_SA(0, 1), a2 + hstep, voffA);
            PG8_WAIT_L(8); PG8_BAR; PG8_WAIT_L(0); PG8_MMA(0, 0, At, B0); PG8_BAR; PG8_SCHED;
            PG8_LDB(B1, 1, 1); PG8_STAGE(PG8_SB(1, 0), b3, voffB);
            PG8_BAR; PG8_WAIT_L(0); PG8_MMA(0, 1, At, B1); PG8_BAR;
            PG8_LDA(At, 1, 1); PG8_STAGE(PG8_SA(1, 0), a3, voffA);
            PG8_BAR; PG8_WAIT_L(0); PG8_MMA(1, 0, At, B0); PG8_BAR; PG8_SCHED;
            PG8_STAGE(PG8_SB(1, 1), b3 + hstep, voffB);
            PG8_WAIT_V(6); PG8_BAR; PG8_MMA(1, 1, At, B1); PG8_BAR;
            }
        }
        if constexpr (ALIGN_EPI) { if (wr == 0) PG8_BAR; }
        if constexpr (!Epi::AFTER_DRAIN) { int fr_ = fr, fq_ = fq; asm volatile("" : "+v"(fr_), "+v"(fq_));
            E(acc, cur, wr, wc, fr_, fq_); S.done(cur); }
        if (!has_next) break;
#pragma unroll
        for (int a = 0; a < 2; ++a)
#pragma unroll
            for (int b = 0; b < 2; ++b)
#pragma unroll
                for (int m = 0; m < 4; ++m)
#pragma unroll
                    for (int n = 0; n < 2; ++n) acc[a][b][m][n] = (f32x4){0.f, 0.f, 0.f, 0.f};
        cur = nxt; cA = nA; cB = nB; ++ui;
        if constexpr (ALIGN_EPI) { if (wr == 1) PG8_BAR; }
    }
    PG8_WAIT_V(0);
    if constexpr (!ALIGN_EPI) { if (wr == 0) PG8_BAR; }
    PG8_BAR;
    if constexpr (Epi::AFTER_DRAIN) { E.fused(acc, cur, wr, wc, fr, fq, lds, wid, lane); S.done(cur); }
#undef PG8_SA
#undef PG8_SB
#undef PG8_STAGE
#undef PG8_LDA
#undef PG8_LDB
#undef PG8_MMA
#undef PG8_WAIT_V
#undef PG8_WAIT_L
#undef PG8_BAR
#undef PG8_SCHED
}
template <class Epi, class Sched, bool ALIGN_EPI = false, bool SP2 = true>
__device__ __forceinline__ void gemm_phase_g(PG8_LAS unsigned char* lds, const Gemm g, const Sched& S, const Epi& E) {
    int tid_ = threadIdx.x; asm volatile("" : "+v"(tid_)); const int tid = tid_, wid = __builtin_amdgcn_readfirstlane(tid >> 6), lane = tid & 63, wr = wid >> 2, wc = wid & 3, fr = lane & 15, fq = lane >> 4;
    const int K = g.K, nt = K / BK, LD = g.ld;
    unsigned voffA[2], voffB[2];
#pragma unroll
    for (int i = 0; i < 2; ++i) { int R, C; stage_rc(tid * 16 + i * 8192, R, C); const int Rb = Epi::PERM ? ((R & ~31) + perm32(R & 31)) : R;
        voffA[i] = (unsigned)(R * LD + C) * 2u; voffB[i] = (unsigned)(Rb * LD + C) * 2u; }
    static_assert(SP2, "gather variant: SP2 loop only");
    unsigned gac[2][2], gan[2][2];
#define PG8_ROWOFF(dst, ui_) do { _Pragma("unroll") for (int i_ = 0; i_ < 2; ++i_) { int R_, C_; stage_rc(tid * 16 + i_ * 8192, R_, C_); \
        _Pragma("unroll") for (int h_ = 0; h_ < 2; ++h_) dst[h_][i_] = (unsigned)S.rtab[(ui_) * 256 + h_ * 128 + R_] * (unsigned)(LD * 2) + (unsigned)C_ * 2u; } } while (0)
    const size_t kstep = (size_t)(BK * 2);
    const size_t hstep = (size_t)HALF * LD * 2;
    const size_t tstep = 2 * hstep;
    const unsigned ldsw = (unsigned)wid * 1024u;
    const int aoff = lds_byte(wr * 64 + fr, fq * 8), boff = lds_byte(wc * 32 + fr, fq * 8);
#define PG8_SA(b, h) (((b) * 2 + (h)) * HTB)
#define PG8_SB(b, h) ((4 + (b) * 2 + (h)) * HTB)
#define PG8_STAGE(bufoff, gbase, voff) do { _Pragma("unroll") for (int _i = 0; _i < 2; ++_i) \
        __builtin_amdgcn_global_load_lds((const unsigned*)((const char*)(gbase) + (voff)[_i]), (PG8_LAS unsigned*)(lds + (bufoff) + ldsw + _i * 8192), 16, 0, 0); } while (0)
#define PG8_LDA(dst, b, h) do { _Pragma("unroll") for (int m = 0; m < 4; ++m) _Pragma("unroll") for (int k = 0; k < 2; ++k) dst[m][k] = *(const PG8_LAS bf16x8*)(lds + PG8_SA(b, h) + aoff + m * 2048 + k * 1024); } while (0)
#define PG8_LDB(dst, b, h) do { _Pragma("unroll") for (int n = 0; n < 2; ++n) _Pragma("unroll") for (int k = 0; k < 2; ++k) dst[n][k] = *(const PG8_LAS bf16x8*)(lds + PG8_SB(b, h) + boff + n * 2048 + k * 1024); } while (0)
#define PG8_MMA(ai, bj, At, Bt) do { __builtin_amdgcn_s_setprio(1); _Pragma("unroll") for (int m = 0; m < 4; ++m) _Pragma("unroll") for (int n = 0; n < 2; ++n) _Pragma("unroll") for (int k = 0; k < 2; ++k) \
        acc[ai][bj][m][n] = __builtin_amdgcn_mfma_f32_16x16x32_bf16(Bt[n][k], At[m][k], acc[ai][bj][m][n], 0, 0, 0); __builtin_amdgcn_s_setprio(0); } while (0)
#define PG8_WAIT_V(n) asm volatile("s_waitcnt vmcnt(" #n ")" ::: "memory")
#define PG8_WAIT_L(n) asm volatile("s_waitcnt lgkmcnt(" #n ")" ::: "memory")
#define PG8_BAR __builtin_amdgcn_s_barrier()
#define PG8_SCHED __builtin_amdgcn_sched_barrier(0)
    Unit cur, nxt; int ui = 0;
    if (!S.next(0, cur)) return;
    f32x4 acc[2][2][4][2];
#pragma unroll
    for (int a = 0; a < 2; ++a)
#pragma unroll
        for (int b = 0; b < 2; ++b)
#pragma unroll
            for (int m = 0; m < 4; ++m)
#pragma unroll
                for (int n = 0; n < 2; ++n) acc[a][b][m][n] = (f32x4){0.f, 0.f, 0.f, 0.f};
    bf16x8 At[4][2], B0[2][2], B1[2][2];
    PG8_ROWOFF(gac, 0);
    const char* cA = (const char*)g.A + (size_t)cur.ko * 2; const char* cB = (const char*)g.Bt + (size_t)cur.pb * tstep + (size_t)cur.ko * 2;
    S.a_ready(cur);
    if constexpr (SP2) {
        PG8_STAGE(PG8_SB(0, 0), cB, voffB); PG8_STAGE(PG8_SB(0, 1), cB + hstep, voffB); PG8_STAGE(PG8_SA(0, 0), cA, gac[0]); PG8_STAGE(PG8_SA(0, 1), cA, gac[1]);
        if (wr == 1) PG8_BAR;
        PG8_WAIT_V(2); PG8_BAR;
        PG8_STAGE(PG8_SB(1, 0), cB + kstep, voffB); PG8_STAGE(PG8_SA(1, 0), cA + kstep, gac[0]); PG8_STAGE(PG8_SB(1, 1), cB + hstep + kstep, voffB);
        PG8_WAIT_V(6); PG8_BAR;
    } else {
        PG8_STAGE(PG8_SB(0, 0), cB, voffB); PG8_STAGE(PG8_SA(0, 0), cA, voffA); PG8_STAGE(PG8_SB(0, 1), cB + hstep, voffB); PG8_STAGE(PG8_SA(0, 1), cA + hstep, voffA);
        if (wr == 1) PG8_BAR;
        PG8_WAIT_V(4); PG8_BAR;
        PG8_STAGE(PG8_SB(1, 0), cB + kstep, voffB); PG8_STAGE(PG8_SA(1, 0), cA + kstep, gac[0]); PG8_STAGE(PG8_SB(1, 1), cB + hstep + kstep, voffB);
        PG8_WAIT_V(6); PG8_BAR;
    }
    for (;;) {
        const bool has_next = S.next(ui + 1, nxt);
        if (has_next) PG8_ROWOFF(gan, ui + 1); else { gan[0][0] = gac[0][0]; gan[0][1] = gac[0][1]; gan[1][0] = gac[1][0]; gan[1][1] = gac[1][1]; }
        const char* nA = has_next ? (const char*)g.A + (size_t)nxt.ko * 2 : cA; const char* nB = has_next ? (const char*)g.Bt + (size_t)nxt.pb * tstep + (size_t)nxt.ko * 2 : cB;
        for (int t = 0; t < nt; t += 2) {
            const bool last = (t == nt - 2);
            const char* a1 = cA + (size_t)(t + 1) * kstep;
            const char* a2 = last ? nA : cA + (size_t)(t + 2) * kstep; const char* b2 = last ? nB : cB + (size_t)(t + 2) * kstep;
            const char* a3 = a2 + kstep; const char* b3 = b2 + kstep;
            const unsigned g2a[2] = {last ? gan[0][0] : gac[0][0], last ? gan[0][1] : gac[0][1]}, g2b[2] = {last ? gan[1][0] : gac[1][0], last ? gan[1][1] : gac[1][1]};
            if (last && has_next) S.a_ready(nxt);
            if constexpr (SP2) {
            PG8_LDB(B0, 0, 0); PG8_LDB(B1, 0, 1); PG8_SCHED; PG8_LDA(At, 0, 0); PG8_STAGE(PG8_SA(1, 1), a1, gac[1]);
            PG8_WAIT_V(8); PG8_WAIT_L(0); PG8_BAR; PG8_MMA(0, 0, At, B0); PG8_MMA(0, 1, At, B1); PG8_BAR; PG8_SCHED;
            PG8_LDA(At, 0, 1); PG8_STAGE(PG8_SB(0, 0), b2, voffB); PG8_STAGE(PG8_SB(0, 1), b2 + hstep, voffB); PG8_STAGE(PG8_SA(0, 0), a2, g2a);
            PG8_WAIT_V(8); PG8_WAIT_L(0); PG8_BAR; PG8_MMA(1, 0, At, B0); PG8_MMA(1, 1, At, B1); PG8_BAR; PG8_SCHED;
            PG8_LDB(B0, 1, 0); PG8_LDB(B1, 1, 1); PG8_SCHED; PG8_LDA(At, 1, 0); PG8_STAGE(PG8_SA(0, 1), a2, g2b);
            PG8_WAIT_V(8); PG8_WAIT_L(0); PG8_BAR; PG8_MMA(0, 0, At, B0); PG8_MMA(0, 1, At, B1); PG8_BAR; PG8_SCHED;
            PG8_LDA(At, 1, 1); PG8_STAGE(PG8_SB(1, 0), b3, voffB); PG8_STAGE(PG8_SB(1, 1), b3 + hstep, voffB); PG8_STAGE(PG8_SA(1, 0), a3, g2a);
            PG8_WAIT_V(8); PG8_WAIT_L(0); PG8_BAR; PG8_MMA(1, 0, At, B0); PG8_MMA(1, 1, At, B1); PG8_BAR; PG8_SCHED;
            } else {
            PG8_LDB(B0, 0, 0); PG8_SCHED; PG8_LDA(At, 0, 0); PG8_STAGE(PG8_SA(1, 1), a1, gac[1]);
            PG8_WAIT_L(8); PG8_BAR; PG8_WAIT_L(0); PG8_MMA(0, 0, At, B0); PG8_BAR; PG8_SCHED;
            PG8_LDB(B1, 0, 1); PG8_STAGE(PG8_SB(0, 0), b2, voffB);
            PG8_BAR; PG8_WAIT_L(0); PG8_MMA(0, 1, At, B1); PG8_BAR;
            PG8_LDA(At, 0, 1); PG8_STAGE(PG8_SA(0, 0), a2, g2a);
            PG8_BAR; PG8_WAIT_L(0); PG8_MMA(1, 0, At, B0); PG8_BAR; PG8_SCHED;
            PG8_STAGE(PG8_SB(0, 1), b2 + hstep, voffB);
            PG8_WAIT_V(6); PG8_BAR; PG8_MMA(1, 1, At, B1); PG8_BAR;
            PG8_LDB(B0, 1, 0); PG8_SCHED; PG8_LDA(At, 1, 0); PG8_STAGE(PG8_SA(0, 1), a2, g2b);
            PG8_WAIT_L(8); PG8_BAR; PG8_WAIT_L(0); PG8_MMA(0, 0, At, B0); PG8_BAR; PG8_SCHED;
            PG8_LDB(B1, 1, 1); PG8_STAGE(PG8_SB(1, 0), b3, voffB);
            PG8_BAR; PG8_WAIT_L(0); PG8_MMA(0, 1, At, B1); PG8_BAR;
            PG8_LDA(At, 1, 1); PG8_STAGE(PG8_SA(1, 0), a3, g2a);
            PG8_BAR; PG8_WAIT_L(0); PG8_MMA(1, 0, At, B0); PG8_BAR; PG8_SCHED;
            PG8_STAGE(PG8_SB(1, 1), b3 + hstep, voffB);
            PG8_WAIT_V(6); PG8_BAR; PG8_MMA(1, 1, At, B1); PG8_BAR;
            }
        }
        if constexpr (ALIGN_EPI) { if (wr == 0) PG8_BAR; }
        if constexpr (!Epi::AFTER_DRAIN) { int fr_ = fr, fq_ = fq; asm volatile("" : "+v"(fr_), "+v"(fq_));
            E(acc, cur, wr, wc, fr_, fq_); S.done(cur); }
        if (!has_next) break;
#pragma unroll
        for (int a = 0; a < 2; ++a)
#pragma unroll
            for (int b = 0; b < 2; ++b)
#pragma unroll
                for (int m = 0; m < 4; ++m)
#pragma unroll
                    for (int n = 0; n < 2; ++n) acc[a][b][m][n] = (f32x4){0.f, 0.f, 0.f, 0.f};
        cur = nxt; cA = nA; cB = nB; ++ui; gac[0][0] = gan[0][0]; gac[0][1] = gan[0][1]; gac[1][0] = gan[1][0]; gac[1][1] = gan[1][1];
        if constexpr (ALIGN_EPI) { if (wr == 1) PG8_BAR; }
    }
    PG8_WAIT_V(0);
    if constexpr (!ALIGN_EPI) { if (wr == 0) PG8_BAR; }
    PG8_BAR;
    if constexpr (Epi::AFTER_DRAIN) { E.fused(acc, cur, wr, wc, fr, fq, lds, wid, lane); S.done(cur); }
#undef PG8_SA
#undef PG8_SB
#undef PG8_STAGE
#undef PG8_LDA
#undef PG8_LDB
#undef PG8_MMA
#undef PG8_WAIT_V
#undef PG8_WAIT_L
#undef PG8_BAR
#undef PG8_SCHED
#undef PG8_ROWOFF
}
}
namespace att {
constexpr int D = 128;
constexpr float THR = 8.f;
constexpr bool WSKIP = false;
constexpr float SCALE = 0.08838834764831845f;
constexpr int NW = 8, QBLK = 32, KVBLK = 64, QB = NW * QBLK;
constexpr int SHM_V = KVBLK * D * 2, SHM_K = KVBLK * D * 2;
constexpr int LDS_BYTES = 2 * SHM_V + 2 * SHM_K + NW * 64 * 4;

using bf16 = __hip_bfloat16;
typedef short bf16x8 __attribute__((ext_vector_type(8)));
typedef short s16x4 __attribute__((ext_vector_type(4)));
typedef float f32x16 __attribute__((ext_vector_type(16)));
typedef float f32x4 __attribute__((ext_vector_type(4)));
typedef unsigned u32x4 __attribute__((ext_vector_type(4)));
template <class A, class Bt> struct same_t { static constexpr bool v = false; };
template <class A> struct same_t<A, A> { static constexpr bool v = true; };

#define KSWZ(row, colB) ((row) * 256 + ((colB) ^ (((row) & 7) << 4)))
#define SBAR() __builtin_amdgcn_sched_barrier(0)
__device__ __forceinline__ int v_st(int k, int c) { const int kk = (k & ~0xC) | ((k & 4) << 1) | ((k & 8) >> 1); return ((kk >> 3) * 4 + (c >> 5)) * 512 + ((kk & 7) * 32 + (c & 31)) * 2; }
__device__ __forceinline__ int v_rd_base(int lane) { return ((lane & 3) << 3) | (((lane >> 2) & 3) << 6) | (((lane >> 4) & 1) << 5) | (((lane >> 5) & 1) << 8); }
constexpr int v_rd_off(int d0, int ks, int half) { return d0 * 512 + ks * 4096 + half * 2048; }
__device__ __forceinline__ int crow(int r, int hi) { return (r & 3) + 8 * (r >> 2) + 4 * hi; }
__device__ __forceinline__ unsigned cvtpk(float lo, float hi) {
    unsigned r; asm volatile("v_cvt_pk_bf16_f32 %0, %1, %2" : "=v"(r) : "v"(lo), "v"(hi)); return r;
}
__device__ __forceinline__ bf16x8 pack8(f32x4 a, f32x4 b) {
    u32x4 w = {cvtpk(a[0], a[1]), cvtpk(a[2], a[3]), cvtpk(b[0], b[1]), cvtpk(b[2], b[3])};
    return *reinterpret_cast<bf16x8*>(&w);
}
template <class T> __device__ __forceinline__ bf16x8 load8(const T* p) {
    if constexpr (same_t<T, float>::v) { return pack8(*(const f32x4*)p, *(const f32x4*)(p + 4)); }
    else { return *reinterpret_cast<const bf16x8*>(p); }
}
__device__ __forceinline__ void mask_tile(f32x16& p0, f32x16& p1, int dq, unsigned W) {
    const float NEG = -__builtin_inff();
#pragma unroll
    for (int r = 0; r < 16; ++r) {
        const int c = (r & 3) + 8 * (r >> 2);
        if ((unsigned)(dq - c) >= W) p0[r] = NEG;
        if ((unsigned)(dq - c - 32) >= W) p1[r] = NEG;
    }
}
__device__ __forceinline__ void partialSM(f32x16& p0, f32x16& p1, float& m_reg, float& mn, float& alpha) {
    float pmax = p0[0]; for (int r = 1; r < 16; ++r) pmax = fmaxf(pmax, p0[r]); for (int r = 0; r < 16; ++r) pmax = fmaxf(pmax, p1[r]);
    { auto rr = __builtin_amdgcn_permlane32_swap(__float_as_uint(pmax), __float_as_uint(pmax), false, false);
      pmax = fmaxf(__uint_as_float(rr[0]), __uint_as_float(rr[1])); }
    constexpr float C2 = 1.4426950408889634f * SCALE;
    if (__builtin_expect(__all((pmax - m_reg) * SCALE <= THR), 1)) { mn = m_reg; alpha = 1.f; }
    else { mn = fmaxf(m_reg, pmax); alpha = __builtin_amdgcn_exp2f((m_reg - mn) * C2); m_reg = mn; }
    const float mnL = -mn * C2;
    for (int r = 0; r < 16; ++r) p0[r] = fmaf(p0[r], C2, mnL); for (int r = 0; r < 16; ++r) p1[r] = fmaf(p1[r], C2, mnL);
    for (int r = 0; r < 16; ++r) p0[r] = __builtin_amdgcn_exp2f(p0[r]);
}
__device__ __forceinline__ void finishSM(f32x16& p0, f32x16& p1, float alpha, float& l_reg, bf16x8& pa0, bf16x8& pa1, bf16x8& pa2, bf16x8& pa3) {
    for (int r = 0; r < 16; ++r) p1[r] = __builtin_amdgcn_exp2f(p1[r]);
    float ps = 0; for (int r = 0; r < 16; ++r) ps += p0[r]; for (int r = 0; r < 16; ++r) ps += p1[r];
    { auto rr = __builtin_amdgcn_permlane32_swap(__float_as_uint(ps), __float_as_uint(ps), false, false);
      ps = __uint_as_float(rr[0]) + __uint_as_float(rr[1]); }
    l_reg = l_reg * alpha + ps;
#define PK4(P, B_, OUT) do { unsigned a0 = cvtpk(P[B_+0], P[B_+1]), a1 = cvtpk(P[B_+2], P[B_+3]);                          \
        unsigned b0 = cvtpk(P[B_+4], P[B_+5]), b1 = cvtpk(P[B_+6], P[B_+7]);                                             \
        auto r0 = __builtin_amdgcn_permlane32_swap(a0, b0, false, false); auto r1 = __builtin_amdgcn_permlane32_swap(a1, b1, false, false); \
        u32x4 w = {r0[0], r1[0], r0[1], r1[1]}; OUT = *reinterpret_cast<bf16x8*>(&w); } while (0)
    PK4(p0, 0, pa0); PK4(p0, 8, pa1); PK4(p1, 0, pa2); PK4(p1, 8, pa3);
#undef PK4
}
template <int KB, bool SK>
__device__ __forceinline__ void qkt(f32x16& p0, f32x16& p1, const char* K_lds, int r32, int hi, const bf16x8* qr, bool act) {
    if (SK && !act) { const float NEG = -__builtin_inff();
#pragma unroll
        for (int r = 0; r < 16; ++r) { p0[r] = NEG; p1[r] = NEG; } return; }
    p0 = f32x16{}; p1 = f32x16{};
    const char* kb[4];
#pragma unroll
    for (int dd = 0; dd < 4; ++dd) kb[dd] = K_lds + KB * SHM_K + KSWZ(r32, (dd * 16 + hi * 8) * 2);
#pragma unroll
    for (int d0 = 0; d0 < 8; ++d0) { const char* a = kb[d0 & 3] + (d0 >> 2) * 128;
        bf16x8 b0 = *reinterpret_cast<const bf16x8*>(a);
        bf16x8 b1 = *reinterpret_cast<const bf16x8*>(a + 32 * 256);
        p0 = __builtin_amdgcn_mfma_f32_32x32x16_bf16(b0, qr[d0], p0, 0, 0, 0);
        p1 = __builtin_amdgcn_mfma_f32_32x32x16_bf16(b1, qr[d0], p1, 0, 0, 0); }
}
template <int VB, bool SK>
__device__ __forceinline__ void pv_tile(f32x16* o, int vb0, bf16x8 pa0, bf16x8 pa1, bf16x8 pa2, bf16x8 pa3, bool act) {
    if (SK && !act) return;
#define TRRD(dst, off) asm volatile("ds_read_b64_tr_b16 %0, %1 offset:%2" : "=&v"(dst) : "v"(vb0), "i"(off) : "memory")
#define PV_D0(d0) do { s16x4 l0, l1, l2, l3, h0, h1, h2, h3; constexpr int b_ = VB * SHM_V + v_rd_off(d0, 0, 0);     \
        TRRD(l0, b_); TRRD(h0, b_ + 2048); TRRD(l1, b_ + 4096); TRRD(h1, b_ + 6144); TRRD(l2, b_ + 8192); TRRD(h2, b_ + 10240); TRRD(l3, b_ + 12288); TRRD(h3, b_ + 14336); \
        asm volatile("s_waitcnt lgkmcnt(0)" ::: "memory"); SBAR();                 \
        o[d0] = __builtin_amdgcn_mfma_f32_32x32x16_bf16(pa0, (bf16x8){l0[0], l0[1], l0[2], l0[3], h0[0], h0[1], h0[2], h0[3]}, o[d0], 0, 0, 0);   \
        o[d0] = __builtin_amdgcn_mfma_f32_32x32x16_bf16(pa1, (bf16x8){l1[0], l1[1], l1[2], l1[3], h1[0], h1[1], h1[2], h1[3]}, o[d0], 0, 0, 0);   \
        o[d0] = __builtin_amdgcn_mfma_f32_32x32x16_bf16(pa2, (bf16x8){l2[0], l2[1], l2[2], l2[3], h2[0], h2[1], h2[2], h2[3]}, o[d0], 0, 0, 0);   \
        o[d0] = __builtin_amdgcn_mfma_f32_32x32x16_bf16(pa3, (bf16x8){l3[0], l3[1], l3[2], l3[3], h3[0], h3[1], h3[2], h3[3]}, o[d0], 0, 0, 0); } while (0)
    PV_D0(0); PV_D0(1); PV_D0(2); PV_D0(3);
#undef PV_D0
#undef TRRD
}

template <class TIn, class TOut> struct BlockRef { const TIn* Q; const TIn* K; const TIn* V; TOut* O; int P0; };
template <class TIn> struct Seam {
    bf16x8 qr[8];
    bf16x8 st_v0, st_v1, st_k0, st_k1; f32x4 sf0, sf1, sf2, sf3;
    f32x4 tq[16];
};
__device__ __forceinline__ int swa_jlo(int P0, int W) { const int lowk = P0 - W + 1; return lowk > 0 ? lowk / KVBLK : 0; }
#define ROW(p, k0, rr) ((p) + (size_t)(k0) * KVP + (unsigned)((rr) * KVP + sc))
#define VMW() asm volatile("s_waitcnt vmcnt(0)" ::: "memory")
#define VMWN(n) asm volatile("s_waitcnt vmcnt(%0)" :: "i"(n) : "memory")
#define SLOAD_H(Kp, Vp, k0) do { S.st_v0 = load8<TIn>(ROW(Vp, k0, sr)); S.st_v1 = load8<TIn>(ROW(Vp, k0, 32 + sr));              \
                         S.st_k0 = load8<TIn>(ROW(Kp, k0, sr)); S.st_k1 = load8<TIn>(ROW(Kp, k0, 32 + sr)); } while (0)
#define SWRITE_HK(bf) do { *(bf16x8*)(K_lds + (bf) * SHM_K + kws) = S.st_k0; *(bf16x8*)(K_lds + (bf) * SHM_K + kws + 32 * 256) = S.st_k1; } while (0)
#define SWRITE_HV(bf) do { *(bf16x8*)(V_lds + (bf) * SHM_V + vst0) = S.st_v0; *(bf16x8*)(V_lds + (bf) * SHM_V + vst1) = S.st_v1; } while (0)
#define SWRITE_H(bf) do { SWRITE_HV(bf); SWRITE_HK(bf); } while (0)
#define SLOAD_F(p, k0) do { S.sf0 = *(const f32x4*)ROW(p, k0, sr); S.sf1 = *(const f32x4*)(ROW(p, k0, sr) + 4);                \
                            S.sf2 = *(const f32x4*)ROW(p, k0, 32 + sr); S.sf3 = *(const f32x4*)(ROW(p, k0, 32 + sr) + 4); } while (0)
#define SWRITE_KF(bf) do { *(bf16x8*)(K_lds + (bf) * SHM_K + kws) = pack8(S.sf0, S.sf1); *(bf16x8*)(K_lds + (bf) * SHM_K + kws + 32 * 256) = pack8(S.sf2, S.sf3); } while (0)
#define SWRITE_VF(bf) do { *(bf16x8*)(V_lds + (bf) * SHM_V + vst0) = pack8(S.sf0, S.sf1); *(bf16x8*)(V_lds + (bf) * SHM_V + vst1) = pack8(S.sf2, S.sf3); } while (0)
template <class TIn, class TOut, int QP, int KVP, int OPI>
__device__ __forceinline__ void causal_swa_prime(const BlockRef<TIn, TOut>& cur, int W, char* lds, Seam<TIn>& S) {
    constexpr bool F32 = same_t<TIn, float>::v;
    int tid_ = threadIdx.x; asm volatile("" : "+v"(tid_)); const int tid = tid_, wid = __builtin_amdgcn_readfirstlane(tid >> 6), lane = tid & 63, r32 = lane & 31, hi = lane >> 5;
    const int sr = tid >> 4, sc = (tid & 15) * 8, kws = KSWZ(sr, sc * 2); char* K_lds = lds + 2 * SHM_V;
    const int kb0 = swa_jlo(cur.P0, W) * KVBLK;
    for (int d0 = 0; d0 < 8; ++d0) S.qr[d0] = load8<TIn>(cur.Q + (unsigned)((wid * QBLK + r32) * QP + d0 * 16 + hi * 8));
    if constexpr (F32) { SLOAD_F((const float*)cur.K, kb0); VMW(); SWRITE_KF(0); SBAR(); SLOAD_F((const float*)cur.V, kb0); }
    else { SLOAD_H(cur.K, cur.V, kb0); VMW(); SWRITE_HK(0); }
    __syncthreads();
}
template <class TIn, class TOut, int QP, int KVP, int OPI>
__device__ __forceinline__ void causal_swa_block(const BlockRef<TIn, TOut>& cur, const BlockRef<TIn, TOut>& nxt, int skv, int W, char* lds, Seam<TIn>& S) {
    constexpr bool F32 = same_t<TIn, float>::v;
    int tid_ = threadIdx.x; asm volatile("" : "+v"(tid_)); const int tid = tid_, wid = __builtin_amdgcn_readfirstlane(tid >> 6), lane = tid & 63, r32 = lane & 31, hi = lane >> 5;
    const int j_lo = swa_jlo(cur.P0, W);
    int j_hi = (cur.P0 + QB - 1) / KVBLK + 1; if (j_hi > skv / KVBLK) j_hi = skv / KVBLK;
    const int NT = j_hi - j_lo;
    const int kbn = swa_jlo(nxt.P0, W) * KVBLK;
    const int qlo = cur.P0 + wid * QBLK, qm = qlo + r32 - 4 * hi;
    char* V_lds = lds; char* K_lds = lds + 2 * SHM_V;
    float* ws = (float*)(lds + 2 * SHM_V + 2 * SHM_K) + wid * 64; float* li_l = ws, * al_l = ws + 32;
    float m_reg = -1e30f, l_reg = 0; f32x16 o[4] = {};
    const int sr = tid >> 4, sc = (tid & 15) * 8, vst0 = v_st(sr, sc), vst1 = v_st(32 + sr, sc), kws = KSWZ(sr, sc * 2);
    const int vb0 = (int)(uintptr_t)V_lds + v_rd_base(lane);
    const TIn* Kh = cur.K; const TIn* Vh = cur.V;
#define RESC(a) do { if (__any((a) < 1.f)) { if (hi == 0) al_l[r32] = (a); asm volatile("s_waitcnt lgkmcnt(0)" ::: "memory");              \
                     for (int d_ = 0; d_ < 4; ++d_) for (int r = 0; r < 16; ++r) o[d_][r] *= al_l[crow(r, hi)]; } } while (0)
#define KBASE(t) ((j_lo + (t)) * KVBLK)
#define ACT(t) (KBASE(t) <= qlo + QBLK - 1 && KBASE(t) + KVBLK - 1 >= qlo - W + 1)
#define MASKT(P0_, P1_, t) do { const int kb_ = KBASE(t); if ((!SK || ACT(t)) && (kb_ + KVBLK - 1 > qlo || kb_ <= qlo + QBLK - 1 - W)) mask_tile(P0_, P1_, qm - kb_, (unsigned)W); } while (0)
    constexpr int NQL = F32 ? 16 : 8;
    constexpr bool SK = WSKIP && !F32;
#define SEAM_K0() do { VMWN(NQL); if constexpr (F32) { SWRITE_KF(0); SBAR(); SLOAD_F((const float*)nxt.V, kbn); } else { SWRITE_HK(0); } SBAR(); } while (0)
    f32x16 pA0, pA1, pB0, pB1; float mnA, mnB, alA, alB; bf16x8 pa0, pa1, pa2, pa3;
    if constexpr (F32) { VMW(); SWRITE_VF(0); SBAR(); } else { SWRITE_HV(0); SBAR(); }
    if (NT > 1) { if constexpr (F32) SLOAD_F((const float*)Kh, KBASE(1)); else SLOAD_H(Kh, Vh, KBASE(1)); }
    SBAR(); qkt<0, SK>(pA0, pA1, K_lds, r32, hi, S.qr, ACT(0));
    if constexpr (F32) { if (NT > 1) { VMW(); SWRITE_KF(1); SBAR(); SLOAD_F((const float*)Vh, KBASE(1)); } }
    MASKT(pA0, pA1, 0); partialSM(pA0, pA1, m_reg, mnA, alA);
    if (NT > 1) { VMW(); if constexpr (F32) { SWRITE_VF(1); SBAR(); if (NT > 2) SLOAD_F((const float*)Kh, KBASE(2)); } else SWRITE_H(1); }
    __syncthreads();
#define HALF_STEP(PX0, PX1, mnX, alX, PY0, PY1, alY, t, KB, VB, SB) do {                                                      \
        SBAR(); qkt<KB, SK>(PX0, PX1, K_lds, r32, hi, S.qr, ACT(t));                                             \
        finishSM(PY0, PY1, alY, l_reg, pa0, pa1, pa2, pa3); SBAR();                                                           \
        if ((t) + 1 < NT) { if constexpr (F32) { VMW(); SWRITE_KF(SB); SBAR(); SLOAD_F((const float*)Vh, KBASE((t) + 1)); }  \
                            else { SLOAD_H(Kh, Vh, KBASE((t) + 1)); } SBAR(); }                                               \
        pv_tile<VB, SK>(o, vb0, pa0, pa1, pa2, pa3, ACT((t) - 1)); MASKT(PX0, PX1, (t)); partialSM(PX0, PX1, m_reg, mnX, alX);                                        \
        __syncthreads();                                                                                                      \
        if ((t) + 1 < NT) { VMW(); if constexpr (F32) { SWRITE_VF(SB); SBAR(); if ((t) + 2 < NT) SLOAD_F((const float*)Kh, KBASE((t) + 2)); } \
                            else { SWRITE_H(SB); } }                                                                          \
        RESC(alX); __syncthreads(); } while (0)
    for (int t = 1; t + 1 < NT; t += 2) {
        HALF_STEP(pB0, pB1, mnB, alB, pA0, pA1, alA, t, 1, 0, 0);
        HALF_STEP(pA0, pA1, mnA, alA, pB0, pB1, alB, t + 1, 0, 1, 1);
    }
    const bool even = (NT & 1) == 0;
    if (even) { SBAR(); qkt<1, SK>(pB0, pB1, K_lds, r32, hi, S.qr, ACT(NT - 1)); SBAR(); }
#define QROW(e) (nxt.Q + (size_t)(wid * QBLK + r32) * QP + ((e) >> 1) * 16 + hi * 8 + ((e) & 1) * 4)
    if constexpr (F32) { SLOAD_F((const float*)nxt.K, kbn); SBAR();
#pragma unroll
        for (int e = 0; e < 8; ++e) S.tq[e] = *(const f32x4*)QROW(e); }
    else { SLOAD_H(nxt.K, nxt.V, kbn); SBAR();
#pragma unroll
        for (int d0 = 0; d0 < 8; ++d0) S.qr[d0] = load8<TIn>(nxt.Q + (unsigned)((wid * QBLK + r32) * QP + d0 * 16 + hi * 8)); }
    SBAR();
    finishSM(pA0, pA1, alA, l_reg, pa0, pa1, pa2, pa3); SBAR();
    if constexpr (F32) {
#pragma unroll
        for (int e = 8; e < 16; ++e) S.tq[e] = *(const f32x4*)QROW(e); SBAR(); }
#undef QROW
    pv_tile<0, SK>(o, vb0, pa0, pa1, pa2, pa3, ACT(even ? NT - 2 : NT - 1));
    if (even) { MASKT(pB0, pB1, NT - 1); partialSM(pB0, pB1, m_reg, mnB, alB); __syncthreads(); RESC(alB);
        finishSM(pB0, pB1, alB, l_reg, pa0, pa1, pa2, pa3); SBAR(); pv_tile<1, SK>(o, vb0, pa0, pa1, pa2, pa3, ACT(NT - 1)); }
    SBAR(); SEAM_K0();
    if (hi == 0) li_l[r32] = l_reg; asm volatile("s_waitcnt lgkmcnt(0)" ::: "memory");
    float rli[16];
#pragma unroll
    for (int r = 0; r < 16; ++r) rli[r] = __builtin_amdgcn_rcpf(li_l[crow(r, hi)]);
    TOut* Ow = cur.O + (unsigned)((wid * QBLK) * OPI);
#pragma unroll
    for (int r = 0; r < 16; ++r) { const int orow = crow(r, hi);
#pragma unroll
        for (int d0 = 0; d0 < 4; ++d0) { const float v = o[d0][r] * rli[r];
            if constexpr (same_t<TOut, float>::v) { Ow[(size_t)orow * OPI + d0 * 32 + r32] = v; }
            else { const float vn = __shfl_xor(v, 1);
                   if ((r32 & 1) == 0) *(unsigned*)(Ow + (unsigned)(orow * OPI + d0 * 32 + r32)) = cvtpk(v, vn); } } }
    if constexpr (F32) {
#pragma unroll
        for (int d0 = 0; d0 < 8; ++d0) S.qr[d0] = pack8(S.tq[2 * d0], S.tq[2 * d0 + 1]); }
    __syncthreads();
#undef RESC
#undef KBASE
#undef ACT
#undef MASKT
#undef SEAM_K0
#undef HALF_STEP
}
#undef ROW
#undef VMW
#undef VMWN
#undef SLOAD_H
#undef SWRITE_HK
#undef SWRITE_HV
#undef SWRITE_H
#undef SLOAD_F
#undef SWRITE_KF
#undef SWRITE_VF

}

#ifndef ATT_SATMODE
#define ATT_SATMODE 1
#endif
#if ATT_SATMODE
#define ATT_CL(x) (x)
#else
#define ATT_CL(x) fminf((x), 448.f)
#endif
#ifndef ATT_STATPRIO
#define ATT_STATPRIO 0
#endif
#ifndef ATT_PSH
#define ATT_PSH 1.0f
#endif
#ifndef ATT_TAU
#define ATT_TAU 3.0f
#endif
#ifndef ATT_SCHED
#define ATT_SCHED { _Pragma("unroll") for (int sg_ = 0; sg_ < 6; ++sg_) { __builtin_amdgcn_sched_group_barrier(0x008, 1, 0); __builtin_amdgcn_sched_group_barrier(0x402, ATT_VPM, 0); } }
#endif
#ifndef ATT_VPM
#define ATT_VPM 10
#endif
namespace att2 {
using att::bf16; using att::bf16x8; using att::s16x4; using att::f32x16; using att::f32x4; using att::u32x4;
constexpr float SCALE = 0.08838834764831845f;
constexpr int MX3_OFF = 132096  , AL3_OFF = MX3_OFF + 2048, LI3_OFF = AL3_OFF + 1024;
constexpr int V7_OFF = 0  , K7_OFF = 32768  , PB7_OFF = 49152  ;
template <int OPI>
__device__ __forceinline__ void diff_block7(const unsigned char* Q8, const unsigned char* K8, const unsigned char* VT8, bf16* O, int P0, char* lds) {
    typedef int v4i_ __attribute__((ext_vector_type(4))); typedef int v8i_ __attribute__((ext_vector_type(8)));
    typedef __attribute__((address_space(1))) unsigned char gcu8_; typedef __attribute__((address_space(1))) v4i_ gv4i_;
    int tid_ = threadIdx.x; asm volatile("" : "+v"(tid_));
    const int tid = tid_, wid = __builtin_amdgcn_readfirstlane(tid >> 6), lane = tid & 63, r32 = lane & 31, hi = lane >> 5;
    const int pr = wid & 3, role = wid >> 2;
    const int NT = P0 / 64 + 2;
    char* V_lds = lds + V7_OFF; char* K_lds = lds + K7_OFF; char* pb_l = lds + PB7_OFF;
    float* mx_l = (float*)(lds + MX3_OFF); float* al_l = (float*)(lds + AL3_OFF) + wid * 32; float* li_l = (float*)(lds + LI3_OFF);
    const int kkey = role * 32 + r32, ksw = (kkey >> 1) & 7;
    const char* kbase = K_lds + kkey * 128;
    const int skey = tid >> 3, sch = tid & 7, kws8 = skey * 128 + ((sch ^ ((skey >> 1) & 7)) << 4);
    const int svr = tid >> 2, sg0 = (tid & 3) * 4;
    int vws[4];
#pragma unroll
    for (int e = 0; e < 4; ++e) { const int g = sg0 + e, d = (g & 1) * 8 + 4 * (g >> 3) + ((g & 7) >> 1); vws[e] = svr * 64 + ((((d >> 2) ^ ((svr >> 2) & 3)) << 2) | (d & 3)) * 4; }
    const int vrow = role * 128 + r32, vsw = (vrow >> 2) & 3;
    const char* vbase = V_lds + vrow * 64;
    const int vc0 = ((2 * hi) ^ vsw) << 4, vc1 = ((2 * hi + 1) ^ vsw) << 4;
    const int qpos = P0 + pr * 32 + r32, qlo = P0 + pr * 32;
    constexpr float C2 = 1.4426950408889634f * SCALE;
    v8i_ qr8[2];
#pragma unroll
    for (int c = 0; c < 2; ++c) { const unsigned char* qp = Q8 + (unsigned)((pr * 32 + r32) * 2048 + 64 * c + 32 * hi);
        qr8[c] = __builtin_shufflevector(*(const v4i_*)qp, *(const v4i_*)(qp + 16), 0, 1, 2, 3, 4, 5, 6, 7); }
    typedef __attribute__((address_space(3))) unsigned las_u32_;
    const int dk_key = wid * 8 + (lane >> 3);
    unsigned dk_off = (unsigned)(dk_key * 2048 + (((lane & 7) ^ ((dk_key >> 1) & 7)) << 4));
    const int dv_r0 = wid * 32 + (lane >> 2), dv_r1 = dv_r0 + 16;
    unsigned dv_off0 = (unsigned)(dv_r0 * 16384 + (((lane & 3) ^ ((dv_r0 >> 2) & 3)) << 4)), dv_off1 = (unsigned)(dv_r1 * 16384 + (((lane & 3) ^ ((dv_r1 >> 2) & 3)) << 4));
    asm volatile("" : "+v"(dk_off), "+v"(dv_off0), "+v"(dv_off1));
#define DMAK(bf, k0) do { const gcu8_* kp_ = (const gcu8_*)K8 + (size_t)(k0) * 2048; asm volatile("" : "+s"(kp_)); \
        __builtin_amdgcn_global_load_lds((const __attribute__((address_space(1))) unsigned*)(kp_ + dk_off), (las_u32_*)(K_lds + (bf) * 8192 + wid * 1024), 16, 0, 0); } while (0)
#define DMAV(bf, k0) do { const gcu8_* vp_ = (const gcu8_*)VT8 + (k0); asm volatile("" : "+s"(vp_)); \
        __builtin_amdgcn_global_load_lds((const __attribute__((address_space(1))) unsigned*)(vp_ + dv_off0), (las_u32_*)(V_lds + (bf) * 16384 + wid * 2048), 16, 0, 0); \
        __builtin_amdgcn_global_load_lds((const __attribute__((address_space(1))) unsigned*)(vp_ + dv_off1), (las_u32_*)(V_lds + (bf) * 16384 + wid * 2048 + 1024), 16, 0, 0); } while (0)
#define VMW() asm volatile("s_waitcnt vmcnt(0)" ::: "memory")
#define QKM(dst, BUF) do { dst = (f32x16){}; \
        _Pragma("unroll") for (int c = 0; c < 2; ++c) { const char* kp2_ = kbase + (BUF) * 8192; \
            const v8i_ kf = __builtin_shufflevector(*(const v4i_*)(kp2_ + (((4 * c + 2 * hi) ^ ksw) << 4)), *(const v4i_*)(kp2_ + (((4 * c + 2 * hi + 1) ^ ksw) << 4)), 0, 1, 2, 3, 4, 5, 6, 7); \
            dst = __builtin_amdgcn_mfma_scale_f32_32x32x64_f8f6f4(kf, qr8[c], dst, 0, 0, 0, 0x7F7F7F7F, 0, 0x7F7F7F7F); } } while (0)
#define MASK(p, t) \
        { const int kb_ = (t) * 64 + role * 32; if (kb_ + 31 > qlo) { const int dq = qpos - kb_ - 4 * hi; const float NEG = -__builtin_inff(); \
            _Pragma("unroll") for (int r = 0; r < 16; ++r) { const int c = (r & 3) + 8 * (r >> 2); if (c > dq) p[r] = NEG; } } }
#define MX3(a, b, c) fmaxf(fmaxf((a), (b)), (c))
#define PMAX(p) \
        float pmax = fmaxf(MX3(MX3(p[0], p[1], p[2]), MX3(p[3], p[4], p[5]), MX3(p[6], p[7], p[8])), MX3(MX3(p[9], p[10], p[11]), MX3(p[12], p[13], p[14]), p[15])); \
        { auto rr_ = __builtin_amdgcn_permlane32_swap(__float_as_uint(pmax), __float_as_uint(pmax), false, false); pmax = MX3(__uint_as_float(rr_[0]), __uint_as_float(rr_[1]), -3.0e38f); }
#define SOFTPUB(p, SL) \
        { p = p * C2 + mnL;                                                \
          _Pragma("unroll") for (int r = 0; r < 16; ++r) p[r] = __builtin_amdgcn_exp2f(p[r]); \
          l4 += ((f32x4){p[0], p[1], p[2], p[3]} + (f32x4){p[4], p[5], p[6], p[7]}) + ((f32x4){p[8], p[9], p[10], p[11]} + (f32x4){p[12], p[13], p[14], p[15]}); }     \
        { _Pragma("unroll") for (int q4 = 0; q4 < 4; ++q4) ownw[q4] = (int)pg8::pk_fp8x4o(ATT_CL(p[4 * q4]), ATT_CL(p[4 * q4 + 1]), ATT_CL(p[4 * q4 + 2]), ATT_CL(p[4 * q4 + 3]), ownw[q4]); mx_own = pmax; \
          *(v4i_*)(pb_l + (SL) * 8192 + wid * 1024 + lane * 16) = ownw; } \
        if (hi == 0) mx_l[(SL) * 256 + wid * 32 + r32] = pmax;
#define PVLOAD(VB, SL) \
        const v4i_ h0 = *(const v4i_*)(pb_l + (SL) * 8192 + (wid & 3) * 1024 + lane * 16), h1 = *(const v4i_*)(pb_l + (SL) * 8192 + ((wid & 3) + 4) * 1024 + lane * 16); \
        v8i_ vf[4]; _Pragma("unroll") for (int d0 = 0; d0 < 4; ++d0) { const char* vp3_ = vbase + (VB) * 16384 + d0 * 2048; \
            vf[d0] = __builtin_shufflevector(*(const v4i_*)(vp3_ + vc0), *(const v4i_*)(vp3_ + vc1), 0, 1, 2, 3, 4, 5, 6, 7); }
#define PVMMA(SCA) do { const v8i_ pa = __builtin_shufflevector(h0, h1, 0, 1, 2, 3, 4, 5, 6, 7); \
        _Pragma("unroll") for (int d0 = 0; d0 < 4; ++d0) o[d0] = __builtin_amdgcn_mfma_scale_f32_32x32x64_f8f6f4(pa, vf[d0], o[d0], 0, 0, 0, (SCA), 0, 0x7F7F7F7F); } while (0)
#define PVT(VB, SL) do { PVLOAD(VB, SL) PVMMA(0x7F7F7F7F); } while (0)
    float ref = 0.f, mnL = 0.f, mx_own = 0.f;
    f32x4 l4 = {0.f, 0.f, 0.f, 0.f}; f32x16 o[4] = {};
    f32x16 pA, pB;
    v4i_ ownw = {0, 0, 0, 0};
    DMAK(0, 0); DMAK(1, 64); DMAV(0, 0);
    VMW();
    __syncthreads();
    QKM(pA, 0); QKM(pB, 1);
    MASK(pA, 0) MASK(pB, 1)
    { PMAX(pA)
      if (hi == 0) mx_l[256 + wid * 32 + r32] = pmax;
      __syncthreads();
 ref = __builtin_ceilf(fmaxf(pmax, mx_l[256 + (wid ^ 4) * 32 + r32]) * C2); mnL = ATT_PSH - ref;
      if (2 < NT) DMAK(0, 128);
      SOFTPUB(pA, 0)
      VMW();
      __syncthreads(); }
#define SEG(BUF, t, cur, nxt) do { \
        if ((t) + 2 < NT) DMAK(BUF, ((t) + 2) * 64);                        \
        DMAV(BUF, (t) * 64); \
        const float pm2 = mx_l[((BUF) ^ 1) * 256 + (wid ^ 4) * 32 + r32]; \
        PVLOAD((BUF) ^ 1, (BUF) ^ 1) \
        int sca = 0x7F7F7F7F; \
        { const float mc2 = fmaxf(mx_own, pm2) * C2;                         \
          const bool up_ = mc2 - ref > ATT_TAU;                              \
          if (__any(up_)) { const float rn = up_ ? __builtin_ceilf(mc2) : ref; const float dl = ref - rn; const float alpha = __builtin_amdgcn_exp2f(dl); ref = rn; mnL = ATT_PSH - rn; l4 = l4 * alpha; \
              sca = (127 + (int)dl) * 0x01010101; \
              if (hi == 0) al_l[r32] = alpha; asm volatile("s_waitcnt lgkmcnt(0)" ::: "memory"); \
              _Pragma("unroll") for (int d_ = 0; d_ < 4; ++d_) _Pragma("unroll") for (int r = 0; r < 16; ++r) o[d_][r] *= al_l[att::crow(r, hi)]; } } \
        QKM(nxt, (BUF) ^ 1);                                                \
        PVMMA(sca); \
        { PMAX(cur) \
          SOFTPUB(cur, BUF) } \
        ATT_SCHED \
        if ((t) + 1 < NT) MASK(nxt, (t) + 1) \
        VMW(); \
        __syncthreads(); \
    } while (0)
    SEG(1, 1, pB, pA);
    for (int t = 2; t < NT; t += 2) { SEG(0, t, pA, pB); SEG(1, t + 1, pB, pA); }
    PVT(1, 1);
    float l_reg = (l4[0] + l4[1]) + (l4[2] + l4[3]);
    { auto rr = __builtin_amdgcn_permlane32_swap(__float_as_uint(l_reg), __float_as_uint(l_reg), false, false); l_reg = __uint_as_float(rr[0]) + __uint_as_float(rr[1]); }
    if (hi == 0) li_l[wid * 32 + r32] = l_reg;
    __syncthreads();
    { const float lt = (l_reg + li_l[(wid ^ 4) * 32 + r32]) * 4.0f; if (hi == 0) al_l[r32] = lt; asm volatile("s_waitcnt lgkmcnt(0)" ::: "memory"); }
    float rli[16];
#pragma unroll
    for (int r = 0; r < 16; ++r) rli[r] = __builtin_amdgcn_rcpf(al_l[att::crow(r, hi)]);
    bf16* Ow = O + (unsigned)((pr * 32) * OPI + role * 128);
#pragma unroll
    for (int r = 0; r < 16; ++r) { const int orow = att::crow(r, hi);
#pragma unroll
        for (int d0 = 0; d0 < 4; ++d0) { const float v = o[d0][r] * rli[r]; const float vn = __shfl_xor(v, 1);
            if ((r32 & 1) == 0) *(unsigned*)(Ow + (unsigned)(orow * OPI + d0 * 32 + r32)) = att::cvtpk(v, vn); } }
    __syncthreads();
#undef SEG
#undef PVT
#undef PVMMA
#undef PVLOAD
#undef SOFTPUB
#undef QKM
#undef MASK
#undef PMAX
#undef MX3
#undef VMW
#undef DMAV
#undef DMAK
}
}

constexpr int T = 32768, DM = 2048, SEQ = 16384, INW = 5120, NMEMT = 512, RMAX = 73728;
constexpr int NWAVES = 8;
constexpr float ALPHA = 1.4142135623730951f;
constexpr float LN_EPS = 1e-5f;
constexpr size_t MiB = 1u << 20;
constexpr size_t WS_CTL = 0, CTL_ZERO_BYTES = 1 * MiB;
constexpr size_t WS_CSN = 1 * MiB, WS_LOG = 5 * MiB;
constexpr size_t WS_TOKE = 13 * MiB, WS_TOKW = WS_TOKE + 256 * 1024, WS_TOKD = WS_TOKW + 256 * 1024, WS_WGC = WS_TOKD + 256 * 1024;
constexpr size_t WS_ROWW = 14 * MiB, WS_TILE = WS_ROWW + 512 * 1024, WS_ROWT = WS_TILE + 64 * 1024;
constexpr size_t WS_RS = 15 * MiB, WS_CSQ = 15 * MiB + 512 * 1024;
constexpr size_t WS_MEMB = 16 * MiB, WS_KV = 18 * MiB, WS_VTM = 19 * MiB;
constexpr size_t WS_WIN = 20 * MiB, WS_WOUT = 60 * MiB, WS_XQ = 76 * MiB, WS_XO = 80 * MiB, WS_MEMKV = 84 * MiB, WS_ROUT = 88 * MiB, WS_W13 = 90 * MiB, WS_W2 = 346 * MiB;
constexpr size_t WS_XA = 474 * MiB, WS_XB = 602 * MiB, WS_H = 730 * MiB, WS_QK8 = 1050 * MiB, WS_VT8 = 1114 * MiB, WS_END = 1146 * MiB;
constexpr size_t DO_MIX = 0, DO_OP = 128 * MiB, DO_QC = 0, DO_OC = 32 * MiB, DO_HB = 0;
constexpr int CW_BAR = 4096, CW_HO = 16384;
constexpr int RING_BYTES = 131072;
constexpr int LDSCTL_OFF = RING_BYTES, MISC_OFF = LDSCTL_OFF + 320, SCR_OFF = LDSCTL_OFF + 1024;
constexpr int LDS_BYTES = 147456;

#define GAS __attribute__((address_space(1)))
#define LAS __attribute__((address_space(3)))
typedef unsigned short bf16;
typedef unsigned v4u __attribute__((ext_vector_type(4)));
typedef unsigned v2u __attribute__((ext_vector_type(2)));
typedef float f32x4 __attribute__((ext_vector_type(4)));
typedef float f32x2 __attribute__((ext_vector_type(2)));
typedef float f32x16 __attribute__((ext_vector_type(16)));
typedef short bf16x8 __attribute__((ext_vector_type(8)));
typedef GAS unsigned gu32;
typedef GAS unsigned long long gu64;
#define RLX_AGENT __ATOMIC_RELAXED, __HIP_MEMORY_SCOPE_AGENT
#define LDS_WAIT() asm volatile("s_waitcnt lgkmcnt(0)" ::: "memory")
#define VM_WAIT() asm volatile("s_waitcnt vmcnt(0)" ::: "memory")
__device__ __forceinline__ unsigned f2bf(float f) { unsigned u = __builtin_bit_cast(unsigned, f); return (u + 0x7fffu + ((u >> 16) & 1u)) >> 16; }
__device__ __forceinline__ unsigned pk2(float lo, float hi) { return f2bf(lo) | (f2bf(hi) << 16); }
__device__ __forceinline__ float bflo(unsigned w) { return __uint_as_float(w << 16); }
__device__ __forceinline__ float bfhi(unsigned w) { return __uint_as_float(w & 0xffff0000u); }

#define XB_TMO      128
#define XB_XCNT(j)  (256  + 64 * (j))
#define XB_XSUB(j)  (1280 + 64 * (j))
#define XB_XGEN(j)  (2304 + 64 * (j))
#define XB_TOP      3328
#define XB_TOPGEN   3392
#define XCD_BAR_WORDS 3456
#define XB_SPIN_CAP (1u << 20)

__device__ __forceinline__ unsigned xb_ld(unsigned* p)              { return __hip_atomic_load(p, __ATOMIC_RELAXED, __HIP_MEMORY_SCOPE_AGENT); }
__device__ __forceinline__ unsigned xb_add(unsigned* p, unsigned v) { return __hip_atomic_fetch_add(p, v, __ATOMIC_RELAXED, __HIP_MEMORY_SCOPE_AGENT); }
__device__ __forceinline__ unsigned xb_xcc_id() { return (unsigned)__builtin_amdgcn_s_getreg((3 << 11) | 20) & 0xFu; }
#define XB_SPIN(cond, bar) do { unsigned _sp = 0; while (cond) { __builtin_amdgcn_s_sleep(1); \
    if ((++_sp & 255u) == 0u) { if (xb_ld(&(bar)[XB_TMO])) break; if (_sp > XB_SPIN_CAP) { atomicAdd(&(bar)[XB_TMO], 1u); break; } } } } while (0)

struct XcdBarrier { unsigned* bar; unsigned x; volatile LAS unsigned* st; };
__device__ __forceinline__ XcdBarrier xcd_barrier_post(unsigned* bar, volatile LAS unsigned* st) {
    XcdBarrier b; b.bar = bar; b.x = xb_xcc_id(); b.st = st;
    if (threadIdx.x == 0) (void)xb_add(&bar[XB_XCNT(b.x)], 1u);
    return b;
}
__device__ __forceinline__ void xcd_barrier_complete(unsigned* bar, unsigned x, unsigned& nloc, unsigned& nx) {
    const unsigned G = gridDim.x * gridDim.y * gridDim.z;
    unsigned sum, cnt, mine, sp = 0u;
    for (;;) {
        sum = 0u; cnt = 0u; mine = 0u;
#pragma unroll
        for (unsigned j = 0; j < 16; ++j) { const unsigned c = xb_ld(&bar[XB_XCNT(j)]); sum += c; cnt += (c > 0u) ? 1u : 0u; mine = (j == x) ? c : mine; }
        if (sum == G) break;
        __builtin_amdgcn_s_sleep(1);
        if ((++sp & 255u) == 0u) { if (xb_ld(&bar[XB_TMO])) break; if (sp > XB_SPIN_CAP) { atomicAdd(&bar[XB_TMO], 1u); break; } }
    }
    nloc = mine > 0u ? mine : 1u; nx = cnt > 0u ? cnt : 1u;
}
__device__ __forceinline__ void xcd_barrier(const XcdBarrier& b) {
    asm volatile("s_waitcnt vmcnt(0)" ::: "memory");
    __syncthreads();
    if (threadIdx.x == 0) {
        unsigned* bar = b.bar;
        __builtin_amdgcn_s_waitcnt(0);
        unsigned nloc = b.st[0], nx = b.st[1];
        if (nloc == 0u) { xcd_barrier_complete(bar, b.x, nloc, nx); b.st[0] = nloc; b.st[1] = nx; }
        const unsigned old = xb_add(&bar[XB_XSUB(b.x)], 1u);
        const unsigned gen = old / nloc;
        if (old + 1u == (gen + 1u) * nloc) {
            __builtin_amdgcn_fence(__ATOMIC_RELEASE, "agent");
            asm volatile("s_waitcnt vmcnt(0)" ::: "memory");
            const unsigned og = xb_add(&bar[XB_TOP], 1u);
            const unsigned tg = og / nx;
            if (og + 1u == (tg + 1u) * nx) xb_add(&bar[XB_TOPGEN], 1u);
            else XB_SPIN(xb_ld(&bar[XB_TOPGEN]) == tg, bar);
            __builtin_amdgcn_fence(__ATOMIC_ACQUIRE, "agent");
            xb_add(&bar[XB_XGEN(b.x)], 1u);
            asm volatile("s_waitcnt vmcnt(0)" ::: "memory");
        } else {
            XB_SPIN(xb_ld(&bar[XB_XGEN(b.x)]) == gen, bar);
            __builtin_amdgcn_fence(__ATOMIC_ACQUIRE, "agent");
            asm volatile("s_waitcnt vmcnt(0)" ::: "memory");
        }
    }
    __syncthreads();
}

struct Args { const void* in[35]; unsigned char* out; unsigned char* ws; int ph_lo, ph_hi; };
struct Frame {
    LAS unsigned char* lds; volatile LAS unsigned* MISC;
    int tid, lane, wave, G, bx;
};
constexpr int TAB_OFF = LDSCTL_OFF + 512;
__device__ __forceinline__ unsigned char* tabp(const Frame& F, int k) {
    const volatile LAS unsigned* t = (const volatile LAS unsigned*)(F.lds + TAB_OFF) + 2 * k;
    const unsigned lo = __builtin_amdgcn_readfirstlane(t[0]), hi = __builtin_amdgcn_readfirstlane(t[1]);
    return (unsigned char*)((GAS unsigned char*)(((unsigned long long)hi << 32) | lo));
}
#define INP(k) ((const float*)tabp(F, (k)))
#define INPI(k) ((const int*)tabp(F, (k)))
#define WSP() (tabp(F, 36))
#define OUTP() (tabp(F, 35))
__device__ __forceinline__ void refresh(Frame& F) {
    int t = F.tid; asm volatile("" : "+v"(t)); F.tid = t; F.lane = t & 63; F.wave = __builtin_amdgcn_readfirstlane(t >> 6);
    int g = F.G, b = F.bx; asm volatile("" : "+s"(g), "+s"(b)); F.G = g; F.bx = b;
}
__device__ __forceinline__ float wave_sum(float v) {
#pragma unroll
    for (int o = 1; o < 64; o <<= 1) v += __shfl_xor(v, o);
    return v;
}
__constant__ double INVF_REV[16] = {0.15915494309189535, 0.0700865215877985, 0.03086376340470123, 0.013591370636193905, 0.005985185712713705, 0.002635675898667414,
    0.001160663641240061, 0.0005111175045375439, 0.00022507907903927653, 9.911730936901935e-05, 4.364795279280289e-05, 1.9221100684944863e-05,
    8.464330808241401e-06, 3.727408601915352e-06, 1.6414262627950345e-06, 7.228293068832865e-07};

struct TDesc { const float* src; bf16* dst; int N, K; const float* gs; };
__device__ __forceinline__ TDesc tr_decode(const Frame& F, unsigned char* ws, int it) {
    int r = it; const float* W; bf16* WT; int K, N, nblk, q; int mode = 0; const float* gs = nullptr;
    if (r < 5120) { const int l = r / 2560; q = r % 2560; W = INP(3) + (size_t)l * 2048 * 5120; K = 2048; N = 5120; nblk = 80; WT = (bf16*)(ws + WS_WIN) + (size_t)l * 5120 * 2048; if (l == 0) mode = 4; }
    else if ((r -= 5120) < 2048) { const int l = r / 1024; q = r % 1024; W = INP(4) + (size_t)l * 2048 * 2048; K = 2048; N = 2048; nblk = 32; WT = (bf16*)(ws + WS_WOUT) + (size_t)l * 2048 * 2048; }
    else if ((r -= 2048) < 512) { const int l = r / 256; q = r % 256; W = INP(26) + (size_t)l * 2048 * 512; K = 2048; N = 512; nblk = 8; WT = (bf16*)(ws + WS_XQ) + (size_t)l * 512 * 2048; gs = INP(5) + l * 2048; }
    else if ((r -= 512) < 512) { const int l = r / 256; q = r % 256; W = INP(27) + (size_t)l * 512 * 2048; K = 512; N = 2048; nblk = 32; WT = (bf16*)(ws + WS_XO) + (size_t)l * 2048 * 512; }
    else if ((r -= 512) < 512) { q = r; W = INP(25); K = 2048; N = 1024; nblk = 16; WT = (bf16*)(ws + WS_MEMKV); }
    else if ((r -= 512) < 16384) { const int le = r / 256; q = r % 256; W = INP(32) + (size_t)le * 2048 * 512; K = 2048; N = 512; nblk = 8; WT = (bf16*)(ws + WS_W13) + (size_t)le * 1024 * 2048; mode = 1; }
    else if ((r -= 16384) < 16384) { const int le = r / 256; q = r % 256; W = INP(33) + (size_t)le * 2048 * 512; K = 2048; N = 512; nblk = 8; WT = (bf16*)(ws + WS_W13) + (size_t)le * 1024 * 2048; mode = 2; }
    else { r -= 16384; const int le = r / 256; q = r % 256; W = INP(34) + (size_t)le * 512 * 2048; K = 512; N = 2048; nblk = 32; WT = (bf16*)(ws + WS_W2) + (size_t)le * 2048 * 512; }
    const int kb = q / nblk, nb = q % nblk, n0 = 64 * nb, k0 = 64 * kb;
    int drow = n0; if (mode == 1 || mode == 2) drow = (n0 >> 7) * 256 + (n0 & 127) + (mode == 2 ? 128 : 0);
    if (mode == 4) { mode = 0;
        if (n0 >= 4096) { const int cc = n0 - 4096; drow = 3072 + (cc >> 7) * 256 + 128 + (cc & 127); } else if (n0 >= 3072) { const int cc = n0 - 3072; drow = 3072 + (cc >> 7) * 256 + (cc & 127); } }
    TDesc d; d.src = W + (size_t)k0 * N + n0 + F.lane; d.dst = WT + (size_t)drow * K + k0; d.N = N; d.K = K; d.gs = gs ? gs + k0 : nullptr; return d;
}
#define TR_LOAD(d, wv) do { _Pragma("unroll") for (int i_ = 0; i_ < 64; ++i_) wv[i_] = __builtin_nontemporal_load((d).src + (size_t)i_ * (d).N); } while (0)
#define TR_STORE(d, wv) do { \
        if ((d).gs) { _Pragma("unroll") for (int i_ = 0; i_ < 64; ++i_) wv[i_] *= (d).gs[i_]; } \
        _Pragma("unroll") for (int i_ = 0; i_ < 32; ++i_) scr[F.lane * 33 + i_] = pk2(wv[2 * i_], wv[2 * i_ + 1]); \
        LDS_WAIT(); asm volatile("" ::: "memory"); \
        { const int c_ = F.lane & 7; \
          _Pragma("unroll") for (int j_ = 0; j_ < 8; ++j_) { const int n_ = (F.lane >> 3) + 8 * j_; const LAS unsigned* s_ = scr + n_ * 33 + 4 * c_; \
              v4u o_; o_.x = s_[0]; o_.y = s_[1]; o_.z = s_[2]; o_.w = s_[3]; \
              __builtin_nontemporal_store(o_, (v4u*)((d).dst + (size_t)n_ * (d).K + 8 * c_)); } } \
        LDS_WAIT(); asm volatile("" ::: "memory"); } while (0)
__device__ __forceinline__ void p_prologue(Frame& F, int dummy_) {
    unsigned char* ws = WSP();
    LAS unsigned* scr = (LAS unsigned*)(F.lds + F.wave * 16384);
    const int gw = F.bx * NWAVES + F.wave, NGW = F.G * NWAVES;
    constexpr int NITEMS = 5120 + 2048 + 512 + 512 + 512 + 16384 * 3;
    if (gw < NITEMS) {
        int it = gw; TDesc da = tr_decode(F, ws, it), db = da; float A[64], B[64]; TR_LOAD(da, A);
        for (;;) {
            const int itb = it + NGW; const bool hb = itb < NITEMS;
            if (hb) { db = tr_decode(F, ws, itb); TR_LOAD(db, B); }
            TR_STORE(da, A);
            if (!hb) break;
            const int ita = itb + NGW; const bool ha = ita < NITEMS;
            if (ha) { da = tr_decode(F, ws, ita); TR_LOAD(da, A); }
            TR_STORE(db, B);
            if (!ha) break;
            it = ita;
        }
    }
    const int gt = F.bx * 512 + F.tid, NT = F.G * 512;
    { bf16* RO = (bf16*)(ws + WS_ROUT); const float* rg = INP(28); const float* re = INP(30);
      for (int i = gt; i < 2 * 256 * 2048; i += NT) { const int l = i >> 19, n = (i >> 11) & 255, k = i & 2047;
          float v = 0.f; if (n < 4) v = rg[(size_t)l * 2048 * 4 + k * 4 + n]; else if (n < 36) v = re[(size_t)l * 2048 * 32 + k * 32 + (n - 4)];
          RO[i] = (bf16)f2bf(v); } }
    { const f32x4* x = (const f32x4*)INP(0); v4u* xa = (v4u*)(ws + WS_XA);
      for (int i0 = gt; i0 < T * DM / 8; i0 += 4 * NT) { f32x4 p[4], q[4];
#pragma unroll
          for (int u = 0; u < 4; ++u) { const int i = i0 + u * NT; if (i < T * DM / 8) { p[u] = __builtin_nontemporal_load(x + 2 * (size_t)i); q[u] = __builtin_nontemporal_load(x + 2 * (size_t)i + 1); } }
#pragma unroll
          for (int u = 0; u < 4; ++u) { const int i = i0 + u * NT; if (i < T * DM / 8) { v4u o; o.x = pk2(p[u][0], p[u][1]); o.y = pk2(p[u][2], p[u][3]); o.z = pk2(q[u][0], q[u][1]); o.w = pk2(q[u][2], q[u][3]); __builtin_nontemporal_store(o, xa + i); } } }
      const f32x4* m = (const f32x4*)INP(1); v4u* mb = (v4u*)(ws + WS_MEMB);
      for (int i = gt; i < NMEMT * DM / 8; i += NT) { const f32x4 p = m[2 * (size_t)i], q = m[2 * (size_t)i + 1]; v4u o; o.x = pk2(p[0], p[1]); o.y = pk2(p[2], p[3]); o.z = pk2(q[0], q[1]); o.w = pk2(q[2], q[3]); mb[i] = o; } }
    { const float* wq = INP(26); const float* g1 = INP(5); const float* b1 = INP(6); float* csq = (float*)(ws + WS_CSQ); LAS float* red = (LAS float*)(F.lds + SCR_OFF);
      for (int blk = F.bx; blk < 256; blk += F.G) { const int l = blk >> 7, n0 = (blk & 127) * 4, c = F.tid & 3, ks = F.tid >> 2;
          float s = 0.f, q = 0.f;
#pragma unroll
          for (int i = 0; i < 16; ++i) { const int k = ks * 16 + i; const float w = wq[((size_t)l * 2048 + k) * 512 + n0 + c]; s += __uint_as_float(f2bf(g1[l * 2048 + k] * w) << 16); q += b1[l * 2048 + k] * w; }
#pragma unroll
          for (int o = 4; o < 64; o <<= 1) { s += __shfl_xor(s, o); q += __shfl_xor(q, o); }
          __syncthreads();
          if (F.lane < 4) { red[F.wave * 8 + F.lane * 2] = s; red[F.wave * 8 + F.lane * 2 + 1] = q; }
          __syncthreads();
          if (F.tid < 8) { float a = 0.f;
#pragma unroll
              for (int w8 = 0; w8 < 8; ++w8) a += red[w8 * 8 + F.tid];
              csq[l * 1024 + (F.tid & 1) * 512 + n0 + (F.tid >> 1)] = a; } } }
    { const int* pos = INPI(2); float* csn = (float*)(ws + WS_CSN);
      for (int i = gt; i < T * 16; i += NT) { const int row = i >> 4, j = i & 15; double rev = (double)pos[row] * INVF_REV[j]; rev -= __builtin_rint(rev); const float f = (float)rev;
          csn[row * 32 + j] = __builtin_amdgcn_cosf(f); csn[row * 32 + 16 + j] = __builtin_amdgcn_sinf(f); } }
}

typedef att::BlockRef<att::bf16, att::bf16> ABlk;
#define DIFFBLK diff_block3
__device__ __forceinline__ void p_diff_attn2(Frame& F, char* lds, const bf16* H, bf16* OP) {
#if ATT_SATMODE
    __builtin_amdgcn_s_setreg((0 << 11) | (23 << 6) | 1, 1);
#endif
#if ATT_STATPRIO
    if (F.wave >= 4) __builtin_amdgcn_s_setprio(1);
#endif
    for (int L = F.bx; L < 1024; L += F.G) {
        const int c = L & 255, i = L >> 8, x = c & 7, k = c >> 3, combo = 2 * x + (i >> 1), b = combo >> 3, h = (combo >> 1) & 3, m = combo & 1, j = (i & 1) * 32 + k;
        const size_t row0 = (size_t)b * SEQ;
        for (int pass = 0; pass < 2; ++pass) { const int qb = pass ? 127 - j : j;
            const unsigned char* QK8 = WSP() + WS_QK8; const unsigned char* VT8 = WSP() + WS_VT8;
            att2::diff_block7<2048>(QK8 + (row0 + (size_t)qb * 128) * 2048 + (2 * h + m) * 128, QK8 + row0 * 2048 + 1024 + (2 * h + m) * 128,
                VT8 + ((size_t)b * 1024 + h * 256) * 16384, (att::bf16*)(OP + (row0 + (size_t)qb * 128) * 2048 + m * 1024 + h * 256), qb * 128, lds); }
    }
#if ATT_STATPRIO
    __builtin_amdgcn_s_setprio(0);
#endif
#if ATT_SATMODE
    __builtin_amdgcn_s_setreg((0 << 11) | (23 << 6) | 1, 0);
#endif
}
__device__ __forceinline__ ABlk cross_ref(const bf16* QC, const bf16* KV, bf16* OC, int L) {
    const int b = L >> 8, head = (L >> 6) & 3, qb = L & 63;
    ABlk r; const size_t row0 = (size_t)b * SEQ + (size_t)qb * 256;
    r.Q = (const att::bf16*)(QC + row0 * 512 + head * 128);
    r.K = (const att::bf16*)(KV + (size_t)b * 256 * 1024 + head * 128);
    r.V = (const att::bf16*)(KV + (size_t)b * 256 * 1024 + 512 + head * 128);
    r.O = (att::bf16*)(OC + row0 * 512 + head * 128);
    r.P0 = 1 << 20; return r;
}
__device__ __forceinline__ void p_cross_attn(Frame& F, char* lds, const bf16* QC, const bf16* KV, bf16* OC) {
    const int nblk = (512 - F.bx + F.G - 1) / F.G;
    if (nblk <= 0) return;
    att::Seam<att::bf16> S;
    ABlk cur = cross_ref(QC, KV, OC, F.bx);
    att::causal_swa_prime<att::bf16, att::bf16, 512, 1024, 512>(cur, 1 << 30, lds, S);
    for (int n = 0;; ++n) {
        const bool last = (n + 1 >= nblk);
        const ABlk nxt = last ? cur : cross_ref(QC, KV, OC, F.bx + (n + 1) * F.G);
        att::causal_swa_block<att::bf16, att::bf16, 512, 1024, 512>(cur, nxt, 256, 1 << 30, lds, S);
        if (last) break;
        cur = nxt;
    }
}

__device__ __forceinline__ void p_cross_attn2(Frame& F, char* lds, const bf16* QC, const bf16* KV, const bf16* VTM, bf16* OC) {
    typedef float f32x16_ __attribute__((ext_vector_type(16)));
    const int tid = F.tid, lane = F.lane, wid = F.wave, r32 = lane & 31, hi = lane >> 5;
    char* Kl = lds; char* Vl = lds + 65536;
    constexpr float C2 = 1.4426950408889634f * 0.08838834764831845f;
    for (int it = F.bx; it < 256; it += F.G) {
        const int bh = it >> 5, b = bh >> 2, head = bh & 3;
        __syncthreads();
        for (int i = tid; i < 4096; i += 512) { const int key = i >> 4, c = i & 15;
            const v4u x = *(const v4u*)(KV + ((size_t)(b * 256 + key)) * 1024 + head * 128 + c * 8);
            *(v4u*)(Kl + key * 256 + ((c ^ (key & 15)) << 4)) = x; }
        for (int i = tid; i < 2048; i += 512) { const int v = i >> 4, sg = i & 15; const bf16* src = VTM + (size_t)(head * 128 + v) * 512 + b * 256 + sg * 16;
            const v4u A = *(const v4u*)src, B = *(const v4u*)(src + 8);
            *(v4u*)(Vl + v * 512 + (((2 * sg) ^ (v & 31)) << 4)) = (v4u){A.x, A.y, B.x, B.y};
            *(v4u*)(Vl + v * 512 + (((2 * sg + 1) ^ (v & 31)) << 4)) = (v4u){A.z, A.w, B.z, B.w}; }
        __syncthreads();
        for (int qq = 0; qq < 2; ++qq) {
            const size_t row0 = (size_t)b * SEQ + (size_t)((it & 31) * 2 + qq) * 256 + wid * 32;
            bf16x8 qf[8];
#pragma unroll
            for (int ks = 0; ks < 8; ++ks) qf[ks] = *(const bf16x8*)(QC + (row0 + r32) * 512 + head * 128 + ks * 16 + hi * 8);
            f32x16_ o[4] = {}; float m = -3.0e38f, l = 0.f;
#pragma unroll
            for (int hf = 0; hf < 2; ++hf) {
                f32x16_ s[4];
#pragma unroll
                for (int kq = 0; kq < 4; ++kq) { s[kq] = (f32x16_){}; const int krow = (hf * 4 + kq) * 32 + r32;
#pragma unroll
                    for (int ks = 0; ks < 8; ++ks) { const bf16x8 kf = *(const bf16x8*)(Kl + krow * 256 + (((2 * ks + hi) ^ (krow & 15)) << 4));
                        s[kq] = __builtin_amdgcn_mfma_f32_32x32x16_bf16(kf, qf[ks], s[kq], 0, 0, 0); } }
                float mh = s[0][0];
#pragma unroll
                for (int kq = 0; kq < 4; ++kq)
#pragma unroll
                    for (int r = 0; r < 16; ++r) mh = fmaxf(mh, s[kq][r]);
                { auto rr = __builtin_amdgcn_permlane32_swap(__float_as_uint(mh), __float_as_uint(mh), false, false); mh = fmaxf(__uint_as_float(rr[0]), __uint_as_float(rr[1])); }
                const float mn = fmaxf(m, mh);
                if (hf == 1) { const float al = __builtin_amdgcn_exp2f((m - mn) * C2); l *= al;
#pragma unroll
                    for (int vb = 0; vb < 4; ++vb) o[vb] = o[vb] * al; }
                m = mn; const float mo = -m * C2; float lh = 0.f;
#pragma unroll
                for (int kq = 0; kq < 4; ++kq)
#pragma unroll
                    for (int r = 0; r < 16; ++r) { const float e = __builtin_amdgcn_exp2f(s[kq][r] * C2 + mo); s[kq][r] = e; lh += e; }
                { auto rr = __builtin_amdgcn_permlane32_swap(__float_as_uint(lh), __float_as_uint(lh), false, false); lh = __uint_as_float(rr[0]) + __uint_as_float(rr[1]); }
                l += lh;
#pragma unroll
                for (int kq = 0; kq < 4; ++kq)
#pragma unroll
                    for (int u = 0; u < 2; ++u) { v4u pw; pw.x = pg8::cvt_pk_bf16(s[kq][8 * u], s[kq][8 * u + 1]); pw.y = pg8::cvt_pk_bf16(s[kq][8 * u + 2], s[kq][8 * u + 3]);
                        pw.z = pg8::cvt_pk_bf16(s[kq][8 * u + 4], s[kq][8 * u + 5]); pw.w = pg8::cvt_pk_bf16(s[kq][8 * u + 6], s[kq][8 * u + 7]);
                        const bf16x8 pb = __builtin_bit_cast(bf16x8, pw);
#pragma unroll
                        for (int vb = 0; vb < 4; ++vb) { const int vrow = vb * 32 + r32;
                            const bf16x8 vf = *(const bf16x8*)(Vl + vrow * 512 + (((2 * (2 * (hf * 4 + kq) + u) + hi) ^ (vrow & 31)) << 4));
                            o[vb] = __builtin_amdgcn_mfma_f32_32x32x16_bf16(vf, pb, o[vb], 0, 0, 0); } }
            }
            const float rl = __builtin_amdgcn_rcpf(l);
            bf16* op = OC + (row0 + r32) * 512 + head * 128 + 4 * hi;
#pragma unroll
            for (int vb = 0; vb < 4; ++vb)
#pragma unroll
                for (int g = 0; g < 4; ++g) { v2u w; w.x = pg8::cvt_pk_bf16(o[vb][4 * g] * rl, o[vb][4 * g + 1] * rl); w.y = pg8::cvt_pk_bf16(o[vb][4 * g + 2] * rl, o[vb][4 * g + 3] * rl);
                    *(v2u*)(op + 32 * vb + 8 * g) = w; }
        }
    }
    __syncthreads();
}

constexpr int CW_WQ = 8192;
__device__ __forceinline__ int wq_next(Frame& F, int k) {
    LAS int* slot = (LAS int*)(F.lds + SCR_OFF + 8192);
    __syncthreads();
    if (F.tid == 0) *slot = (int)__hip_atomic_fetch_add((unsigned*)(WSP() + WS_CTL) + CW_WQ + 64 * k, 1u, __ATOMIC_RELAXED, __HIP_MEMORY_SCOPE_AGENT);
    __syncthreads();
    return *slot;
}
__device__ __forceinline__ void p_combine(Frame& F, int dummy_, const bf16* OP, bf16* MIX) {
    const float* lq1 = INP(11); const float* lk1 = INP(12); const float* lq2 = INP(13); const float* lk2 = INP(14);
    const float* sg = INP(15);
    const int l = F.lane;
    const float d1 = wave_sum(lq1[l] * lk1[l] + lq1[l + 64] * lk1[l + 64]), d2 = wave_sum(lq2[l] * lk2[l] + lq2[l + 64] * lk2[l + 64]);
    const float lam = __expf(d1) - __expf(d2) + 0.2f;
    const int h = l >> 4, d0 = (l & 15) * 16;
    float g[16];
#pragma unroll
    for (int j = 0; j < 16; ++j) g[j] = sg[d0 + j] * 0.8f;
    for (;;) { const int item = wq_next(F, 2); if (item >= T / 64) break;
      for (int ri = 0; ri < 8; ++ri) { const int row = item * 64 + F.wave * 8 + ri;
        const v4u* p1 = (const v4u*)(OP + (size_t)row * 2048 + h * 256 + d0); const v4u* p2 = (const v4u*)(OP + (size_t)row * 2048 + 1024 + h * 256 + d0);
        const v4u a0 = __builtin_nontemporal_load(p1), a1 = __builtin_nontemporal_load(p1 + 1), b0 = __builtin_nontemporal_load(p2), b1 = __builtin_nontemporal_load(p2 + 1);
        float o[16];
        o[0] = bflo(a0.x) - lam * bflo(b0.x); o[1] = bfhi(a0.x) - lam * bfhi(b0.x); o[2] = bflo(a0.y) - lam * bflo(b0.y); o[3] = bfhi(a0.y) - lam * bfhi(b0.y);
        o[4] = bflo(a0.z) - lam * bflo(b0.z); o[5] = bfhi(a0.z) - lam * bfhi(b0.z); o[6] = bflo(a0.w) - lam * bflo(b0.w); o[7] = bfhi(a0.w) - lam * bfhi(b0.w);
        o[8] = bflo(a1.x) - lam * bflo(b1.x); o[9] = bfhi(a1.x) - lam * bfhi(b1.x); o[10] = bflo(a1.y) - lam * bflo(b1.y); o[11] = bfhi(a1.y) - lam * bfhi(b1.y);
        o[12] = bflo(a1.z) - lam * bflo(b1.z); o[13] = bfhi(a1.z) - lam * bfhi(b1.z); o[14] = bflo(a1.w) - lam * bflo(b1.w); o[15] = bfhi(a1.w) - lam * bfhi(b1.w);
        float ss = 0.f;
#pragma unroll
        for (int j = 0; j < 16; ++j) ss += o[j] * o[j];
        ss += __shfl_xor(ss, 1); ss += __shfl_xor(ss, 2); ss += __shfl_xor(ss, 4); ss += __shfl_xor(ss, 8);
        const float rs = 1.0f / sqrtf(ss * (1.0f / 256.0f) + LN_EPS);
        v4u w0, w1;
        w0.x = pk2(o[0] * rs * g[0], o[1] * rs * g[1]); w0.y = pk2(o[2] * rs * g[2], o[3] * rs * g[3]); w0.z = pk2(o[4] * rs * g[4], o[5] * rs * g[5]); w0.w = pk2(o[6] * rs * g[6], o[7] * rs * g[7]);
        w1.x = pk2(o[8] * rs * g[8], o[9] * rs * g[9]); w1.y = pk2(o[10] * rs * g[10], o[11] * rs * g[11]); w1.z = pk2(o[12] * rs * g[12], o[13] * rs * g[13]); w1.w = pk2(o[14] * rs * g[14], o[15] * rs * g[15]);
        v4u* q = (v4u*)(MIX + (size_t)row * 2048 + h * 256 + d0); q[0] = w0; q[1] = w1;
    } }
}

template <int R> __device__ __forceinline__ void conv_rows(f32x2 (&acc)[32], const f32x2 (&w)[31], const LAS unsigned* ctt) {
    if constexpr (R < 62) {
        const unsigned p = ctt[R * 512]; const f32x2 val = (f32x2){bflo(p), bfhi(p)};
#pragma unroll
        for (int j = 0; j < 31; ++j) { if (R - j >= 0 && R - j < 32) acc[(R - j) & 31] = w[j] * val + acc[(R - j) & 31]; }
        conv_rows<R + 1>(acc, w, ctt);
    }
}
__device__ __forceinline__ void p_conformer(Frame& F, int dummy_, const bf16* H, bf16* MIX) {
    const float* cw = INP(16); const float* cb = INP(17); const float* cg = INP(18); const float* cbeta = INP(19);
    LAS unsigned* ct = (LAS unsigned*)F.lds;
    LAS float* red = (LAS float*)(F.lds + SCR_OFF);
    LAS float* stat = (LAS float*)(F.lds + SCR_OFF + 1024);
    const int tid = F.tid;
    f32x2 w[31];
#pragma unroll
    for (int j = 0; j < 31; ++j) w[j] = *(const f32x2*)(cw + j * 1024 + 2 * tid);
    const f32x2 bb = *(const f32x2*)(cb + 2 * tid), gg = *(const f32x2*)(cg + 2 * tid), be = *(const f32x2*)(cbeta + 2 * tid);
    for (;;) {
        const int item = wq_next(F, 0); if (item >= T / 32) break;
        const int t0 = item * 32, tl0 = t0 & (SEQ - 1);
        { const int cgp = tid & 127, rq = tid >> 7;
#pragma unroll 4
          for (int r = rq; r < 64; r += 4) { const int tl = tl0 - 30 + r; v4u o = (v4u){0u, 0u, 0u, 0u};
              if (r < 62 && tl >= 0) o = *(const v4u*)(H + (size_t)(t0 - 30 + r) * INW + 3072 + cgp * 8);
              if (r < 62) *(LAS v4u*)(ct + r * 512 + cgp * 4) = o; } }
        __syncthreads();
        f32x2 acc[32];
#pragma unroll
        for (int t = 0; t < 32; ++t) acc[t] = bb;
        conv_rows<0>(acc, w, ct + tid);
#pragma unroll
        for (int t = 0; t < 32; ++t) { const float s = wave_sum(acc[t].x + acc[t].y); if (F.lane == 0) red[F.wave * 32 + t] = s; }
        __syncthreads();
        if (tid < 32) { float s = 0.f;
#pragma unroll
            for (int k = 0; k < 8; ++k) s += red[k * 32 + tid]; stat[tid] = s * (1.0f / 1024.0f); }
        __syncthreads();
#pragma unroll
        for (int t = 0; t < 32; ++t) { const float mu = stat[t]; acc[t] = acc[t] - mu; }
        __syncthreads();
#pragma unroll
        for (int t = 0; t < 32; ++t) { const float s = wave_sum(acc[t].x * acc[t].x + acc[t].y * acc[t].y); if (F.lane == 0) red[F.wave * 32 + t] = s; }
        __syncthreads();
        if (tid < 32) { float s = 0.f;
#pragma unroll
            for (int k = 0; k < 8; ++k) s += red[k * 32 + tid]; stat[tid] = 1.0f / sqrtf(s * (1.0f / 1024.0f) + LN_EPS); }
        __syncthreads();
#pragma unroll
        for (int t = 0; t < 32; ++t) { const float rs = stat[t]; const float y0 = acc[t].x * rs * gg.x + be.x, y1 = acc[t].y * rs * gg.y + be.y;
            const float s0 = y0 * __builtin_amdgcn_rcpf(1.f + __expf(-y0)), s1 = y1 * __builtin_amdgcn_rcpf(1.f + __expf(-y1));
            *(unsigned*)(MIX + (size_t)(t0 + t) * 2048 + 1024 + 2 * tid) = pk2(s0, s1); }
    }
    __syncthreads();
}

__device__ __forceinline__ void p_sgu(Frame& F, int dummy_, const bf16* H, bf16* MIX) {
    const float* lg = INP(20); const float* lb = INP(21); const float* sw = INP(22); const float* sb = INP(23);
    constexpr int VP = 136;
    constexpr int OPP = 264;
    LAS bf16* vgt = (LAS bf16*)F.lds;
    LAS bf16* wl = (LAS bf16*)(F.lds + 256 * VP * 2);
    LAS float* st = (LAS float*)(F.lds + 256 * VP * 2 + 128 * VP * 2);
    const int tid = F.tid, lane = F.lane, wid = F.wave;
    const int wt = tid >> 2, wsq = tid & 3;
    const int s2 = tid & 63, cq = tid >> 6;
    const int c8 = (tid & 31) * 8, tq = tid >> 5;
    for (int chunk = F.bx; chunk < T / 128; chunk += F.G) {
        const size_t r0 = (size_t)chunk * 128;
        __syncthreads();
        f32x4 wp[8]; v4u za[4], zb[4];
#define SGU_LOADG(g_) do { const float* wp_ = sw + ((size_t)(g_) * 128 + wt) * 128 + wsq * 32; _Pragma("unroll") for (int k = 0; k < 8; ++k) wp[k] = *(const f32x4*)(wp_ + 4 * k); \
            const bf16* zp_ = H + (r0 + 2 * s2) * INW + 1024 + (g_) * 256 + cq * 32; _Pragma("unroll") for (int k = 0; k < 4; ++k) { za[k] = *(const v4u*)(zp_ + 8 * k); zb[k] = *(const v4u*)(zp_ + INW + 8 * k); } } while (0)
        SGU_LOADG(0);
        for (int r8 = 0; r8 < 16; r8 += 8) { v4u z0[8], z1[8];
#pragma unroll
          for (int i = 0; i < 8; ++i) { const bf16* zp = H + (r0 + wid * 16 + r8 + i) * INW + 1024 + lane * 8; z0[i] = *(const v4u*)zp; z1[i] = *(const v4u*)(zp + 512); }
#pragma unroll
          for (int i = 0; i < 8; ++i) {
              float v[16] = {bflo(z0[i].x), bfhi(z0[i].x), bflo(z0[i].y), bfhi(z0[i].y), bflo(z0[i].z), bfhi(z0[i].z), bflo(z0[i].w), bfhi(z0[i].w), bflo(z1[i].x), bfhi(z1[i].x), bflo(z1[i].y), bfhi(z1[i].y), bflo(z1[i].z), bfhi(z1[i].z), bflo(z1[i].w), bfhi(z1[i].w)};
              float sm = 0.f;
#pragma unroll
              for (int j = 0; j < 16; ++j) sm += v[j];
              const float mu = wave_sum(sm) * (1.0f / 1024.0f); float q = 0.f;
#pragma unroll
              for (int j = 0; j < 16; ++j) { const float d = v[j] - mu; q += d * d; }
              const float rs = 1.0f / sqrtf(wave_sum(q) * (1.0f / 1024.0f) + LN_EPS);
              if (lane == 0) { st[2 * (wid * 16 + r8 + i)] = mu; st[2 * (wid * 16 + r8 + i) + 1] = rs; } } }
        for (int g = 0; g < 4; ++g) {
            __syncthreads();
            {
#pragma unroll
              for (int k = 0; k < 4; ++k) { const f32x4 p = wp[2 * k], q = wp[2 * k + 1]; const int s0 = wsq * 32 + 8 * k, t = wt;
                  v4u o; o.x = pk2(s0 + 0 <= t ? p[0] : 0.f, s0 + 1 <= t ? p[1] : 0.f); o.y = pk2(s0 + 2 <= t ? p[2] : 0.f, s0 + 3 <= t ? p[3] : 0.f);
                  o.z = pk2(s0 + 4 <= t ? q[0] : 0.f, s0 + 5 <= t ? q[1] : 0.f); o.w = pk2(s0 + 6 <= t ? q[2] : 0.f, s0 + 7 <= t ? q[3] : 0.f);
                  *(LAS v4u*)(wl + t * VP + s0) = o; } }
            { const float mu0 = st[4 * s2], rs0 = st[4 * s2 + 1], mu1 = st[4 * s2 + 2], rs1 = st[4 * s2 + 3];
#pragma unroll
              for (int k = 0; k < 4; ++k) { const int c0 = cq * 32 + 8 * k; const float* gp = lg + g * 256 + c0; const float* bp = lb + g * 256 + c0;
                  const f32x4 g0 = *(const f32x4*)gp, g1 = *(const f32x4*)(gp + 4), b0 = *(const f32x4*)bp, b1 = *(const f32x4*)(bp + 4);
                  LAS unsigned* vo = (LAS unsigned*)(vgt + c0 * VP + 2 * s2);
#define NRM(zw, half, gv, bv, mu_, rs_) ((half ? bfhi(zw) : bflo(zw)) - mu_) * rs_ * gv + bv
                  vo[0 * (VP / 2)] = pk2(NRM(za[k].x, 0, g0[0], b0[0], mu0, rs0), NRM(zb[k].x, 0, g0[0], b0[0], mu1, rs1));
                  vo[1 * (VP / 2)] = pk2(NRM(za[k].x, 1, g0[1], b0[1], mu0, rs0), NRM(zb[k].x, 1, g0[1], b0[1], mu1, rs1));
                  vo[2 * (VP / 2)] = pk2(NRM(za[k].y, 0, g0[2], b0[2], mu0, rs0), NRM(zb[k].y, 0, g0[2], b0[2], mu1, rs1));
                  vo[3 * (VP / 2)] = pk2(NRM(za[k].y, 1, g0[3], b0[3], mu0, rs0), NRM(zb[k].y, 1, g0[3], b0[3], mu1, rs1));
                  vo[4 * (VP / 2)] = pk2(NRM(za[k].z, 0, g1[0], b1[0], mu0, rs0), NRM(zb[k].z, 0, g1[0], b1[0], mu1, rs1));
                  vo[5 * (VP / 2)] = pk2(NRM(za[k].z, 1, g1[1], b1[1], mu0, rs0), NRM(zb[k].z, 1, g1[1], b1[1], mu1, rs1));
                  vo[6 * (VP / 2)] = pk2(NRM(za[k].w, 0, g1[2], b1[2], mu0, rs0), NRM(zb[k].w, 0, g1[2], b1[2], mu1, rs1));
                  vo[7 * (VP / 2)] = pk2(NRM(za[k].w, 1, g1[3], b1[3], mu0, rs0), NRM(zb[k].w, 1, g1[3], b1[3], mu1, rs1));
#undef NRM
              } }
            if (g + 1 < 4) SGU_LOADG(g + 1);
            __syncthreads();
            const int wr = wid >> 1, wc = wid & 1, r32 = lane & 31, hi = lane >> 5;
            f32x16 acc[4] = {};
            for (int ks = 0; ks < 2 * wr + 2; ++ks) { const bf16x8 af = *(const LAS bf16x8*)(wl + (wr * 32 + r32) * VP + ks * 16 + hi * 8);
#pragma unroll
                for (int cb = 0; cb < 4; ++cb) { const bf16x8 bfr = *(const LAS bf16x8*)(vgt + (wc * 128 + cb * 32 + r32) * VP + ks * 16 + hi * 8);
                    acc[cb] = __builtin_amdgcn_mfma_f32_32x32x16_bf16(af, bfr, acc[cb], 0, 0, 0); } }
            __syncthreads();
            LAS bf16* ot = vgt;
#pragma unroll
            for (int r = 0; r < 16; ++r) { const int t = wr * 32 + (r & 3) + 8 * (r >> 2) + 4 * hi; const float bias = sb[g * 128 + t];
#pragma unroll
                for (int cb = 0; cb < 4; ++cb) ot[t * OPP + wc * 128 + cb * 32 + r32] = (bf16)f2bf(acc[cb][r] + bias); }
            __syncthreads();
#pragma unroll
            for (int k = 0; k < 8; ++k) { const int t = tq + 16 * k; const v4u sv = *(const LAS v4u*)(ot + t * OPP + c8); v4u o; const v4u uk = *(const v4u*)(H + (r0 + t) * INW + g * 256 + c8);
                o.x = pk2(bflo(uk.x) * bflo(sv.x), bfhi(uk.x) * bfhi(sv.x)); o.y = pk2(bflo(uk.y) * bflo(sv.y), bfhi(uk.y) * bfhi(sv.y));
                o.z = pk2(bflo(uk.z) * bflo(sv.z), bfhi(uk.z) * bfhi(sv.z)); o.w = pk2(bflo(uk.w) * bflo(sv.w), bfhi(uk.w) * bfhi(sv.w));
                *(v4u*)(MIX + (r0 + t) * 2048 + g * 256 + c8) = o; }
        }
#undef SGU_LOADG
    }
    __syncthreads();
}
__device__ __forceinline__ void p_sconv(Frame& F, int dummy_, const bf16* H, bf16* MIX) {
    const float* scw = INP(24);
    const int cgp = F.tid & 127, run = F.tid >> 7;
    float w0[8], w1[8], w2[8];
#pragma unroll
    for (int j = 0; j < 8; ++j) { w0[j] = scw[cgp * 8 + j]; w1[j] = scw[1024 + cgp * 8 + j]; w2[j] = scw[2048 + cgp * 8 + j]; }
    for (;;) {
        const int item = wq_next(F, 1); if (item >= T / 64) break;
        const int t0 = item * 64 + run * 16; const int tl0 = t0 & (SEQ - 1);
        float pm2[8], pm1[8];
#pragma unroll
        for (int j = 0; j < 8; ++j) { pm2[j] = 0.f; pm1[j] = 0.f; }
        for (int tt = -2; tt < 16; ++tt) {
            if (tl0 + tt < 0) continue;
            const bf16* hp = H + (size_t)(t0 + tt) * INW + 2048 + cgp * 8;
            const v4u gc = __builtin_nontemporal_load((const v4u*)(hp + 1024)), xi = __builtin_nontemporal_load((const v4u*)(hp + 2048));
            float p[8] = {bflo(gc.x) * bflo(xi.x), bfhi(gc.x) * bfhi(xi.x), bflo(gc.y) * bflo(xi.y), bfhi(gc.y) * bfhi(xi.y), bflo(gc.z) * bflo(xi.z), bfhi(gc.z) * bfhi(xi.z), bflo(gc.w) * bflo(xi.w), bfhi(gc.w) * bfhi(xi.w)};
            if (tt >= 0) { const v4u gb = __builtin_nontemporal_load((const v4u*)hp); const float gbf[8] = {bflo(gb.x), bfhi(gb.x), bflo(gb.y), bfhi(gb.y), bflo(gb.z), bfhi(gb.z), bflo(gb.w), bfhi(gb.w)};
                float o[8];
#pragma unroll
                for (int j = 0; j < 8; ++j) o[j] = gbf[j] * (w0[j] * pm2[j] + w1[j] * pm1[j] + w2[j] * p[j]);
                v4u w; w.x = pk2(o[0], o[1]); w.y = pk2(o[2], o[3]); w.z = pk2(o[4], o[5]); w.w = pk2(o[6], o[7]);
                *(v4u*)(MIX + (size_t)(t0 + tt) * 2048 + 1024 + cgp * 8) = w; }
#pragma unroll
            for (int j = 0; j < 8; ++j) { pm2[j] = pm1[j]; pm1[j] = p[j]; }
        }
    }
}

template <int MODE>
__device__ __forceinline__ void p_ln(Frame& F, bf16* Y, const bf16* YE, const int* tokd, float* OUTF, const float* gam, const float* bet) {
    const int l = F.lane;
    f32x4 g[8], b[8];
#pragma unroll
    for (int j = 0; j < 4; ++j) { g[2 * j] = *(const f32x4*)(gam + 8 * l + 512 * j); g[2 * j + 1] = *(const f32x4*)(gam + 8 * l + 512 * j + 4); b[2 * j] = *(const f32x4*)(bet + 8 * l + 512 * j); b[2 * j + 1] = *(const f32x4*)(bet + 8 * l + 512 * j + 4); }
    const int gw = F.bx * NWAVES + F.wave, NGW = F.G * NWAVES;
    for (int rowb = gw; rowb < T; rowb += 2 * NGW) {
        v4u w[2][4], e0[2][4], e1[2][4];
#pragma unroll
        for (int u = 0; u < 2; ++u) { const int row = rowb + u * NGW; if (row < T) { const bf16* yp = Y + (size_t)row * 2048 + 8 * l;
#pragma unroll
            for (int j = 0; j < 4; ++j) w[u][j] = __builtin_nontemporal_load((const v4u*)(yp + 512 * j));
            if constexpr (MODE == 1 || MODE == 2) { const int d0 = tokd[2 * row], d1 = tokd[2 * row + 1];
                const bf16* p0 = YE + (size_t)d0 * 2048 + 8 * l; const bf16* p1 = YE + (size_t)d1 * 2048 + 8 * l;
#pragma unroll
                for (int j = 0; j < 4; ++j) { e0[u][j] = __builtin_nontemporal_load((const v4u*)(p0 + 512 * j)); e1[u][j] = __builtin_nontemporal_load((const v4u*)(p1 + 512 * j));     } } } }
#pragma unroll
        for (int u = 0; u < 2; ++u) { const int row = rowb + u * NGW; if (row < T) {
            f32x4 v[8];
#pragma unroll
            for (int j = 0; j < 4; ++j) { v[2 * j] = (f32x4){bflo(w[u][j].x), bfhi(w[u][j].x), bflo(w[u][j].y), bfhi(w[u][j].y)}; v[2 * j + 1] = (f32x4){bflo(w[u][j].z), bfhi(w[u][j].z), bflo(w[u][j].w), bfhi(w[u][j].w)}; }
            if constexpr (MODE == 1 || MODE == 2) {
#pragma unroll
                for (int j = 0; j < 4; ++j) { const v4u w0 = e0[u][j], w1 = e1[u][j];
                    v[2 * j] = v[2 * j] * ALPHA + ((f32x4){bflo(w0.x), bfhi(w0.x), bflo(w0.y), bfhi(w0.y)} + (f32x4){bflo(w1.x), bfhi(w1.x), bflo(w1.y), bfhi(w1.y)});
                    v[2 * j + 1] = v[2 * j + 1] * ALPHA + ((f32x4){bflo(w0.z), bfhi(w0.z), bflo(w0.w), bfhi(w0.w)} + (f32x4){bflo(w1.z), bfhi(w1.z), bflo(w1.w), bfhi(w1.w)}); }
            }
            float sm = 0.f;
#pragma unroll
            for (int j = 0; j < 8; ++j) sm += (v[j][0] + v[j][1]) + (v[j][2] + v[j][3]);
            const float mu = wave_sum(sm) * (1.0f / 2048.0f); float q = 0.f;
#pragma unroll
            for (int j = 0; j < 8; ++j) { v[j] = v[j] - mu; q += (v[j][0] * v[j][0] + v[j][1] * v[j][1]) + (v[j][2] * v[j][2] + v[j][3] * v[j][3]); }
            const float rs = 1.0f / sqrtf(wave_sum(q) * (1.0f / 2048.0f) + LN_EPS);
#pragma unroll
            for (int j = 0; j < 8; ++j) v[j] = v[j] * rs * g[j] + b[j];
            if constexpr (MODE == 2) { float* op = OUTF + (size_t)row * 2048 + 8 * l;
#pragma unroll
                for (int j = 0; j < 4; ++j) { *(f32x4*)(op + 512 * j) = v[2 * j]; *(f32x4*)(op + 512 * j + 4) = v[2 * j + 1]; } }
            else { bf16* yp = (MODE == 3 ? (bf16*)OUTF : Y) + (size_t)row * 2048 + 8 * l;
#pragma unroll
                for (int j = 0; j < 4; ++j) { v4u o; o.x = pk2(v[2 * j][0], v[2 * j][1]); o.y = pk2(v[2 * j][2], v[2 * j][3]); o.z = pk2(v[2 * j + 1][0], v[2 * j + 1][1]); o.w = pk2(v[2 * j + 1][2], v[2 * j + 1][3]); *(v4u*)(yp + 512 * j) = o; } } } }
    }
}

__device__ __forceinline__ void p_router_route(Frame& F, int lyr, bf16* X, const float* gam, const float* bet) {
    typedef float f32x4_t __attribute__((ext_vector_type(4)));
    unsigned char* ws = WSP();
    const bf16* WR = (const bf16*)(ws + WS_ROUT) + (size_t)lyr * 256 * 2048;
    const float* rgb = INP(29) + lyr * 4; const float* reb = INP(31) + lyr * 32;
    int* toke = (int*)(ws + WS_TOKE); float* tokw = (float*)(ws + WS_TOKW); int* wgc = (int*)(ws + WS_WGC);
    constexpr int BP = 264;
    LAS bf16* Bs = (LAS bf16*)F.lds;
    LAS float* LGs = (LAS float*)(F.lds + 2 * 48 * BP * 2);
    LAS int* hist = (LAS int*)(F.lds + SCR_OFF);
    { int* rowt = (int*)(ws + WS_ROWT); for (int i = F.bx * 512 + F.tid; i < RMAX; i += F.G * 512) rowt[i] = 0; }
    const int tid = F.tid, lane = F.lane, wid = F.wave, r16 = lane & 15, kq = lane >> 4;
    for (int grp = F.bx; grp < T / 128; grp += F.G) {
        __syncthreads();
        if (tid < 32) hist[tid] = 0;
        { f32x4 g[8], b[8];
#pragma unroll
          for (int j = 0; j < 4; ++j) { g[2 * j] = *(const f32x4*)(gam + 8 * lane + 512 * j); g[2 * j + 1] = *(const f32x4*)(gam + 8 * lane + 512 * j + 4); b[2 * j] = *(const f32x4*)(bet + 8 * lane + 512 * j); b[2 * j + 1] = *(const f32x4*)(bet + 8 * lane + 512 * j + 4); }
          for (int it = 0; it < 8; ++it) { v4u w[2][4];
#pragma unroll
              for (int u = 0; u < 2; ++u) { const bf16* yp = X + ((size_t)grp * 128 + wid * 16 + 2 * it + u) * 2048 + 8 * lane;
#pragma unroll
                  for (int j = 0; j < 4; ++j) w[u][j] = *(const v4u*)(yp + 512 * j); }
#pragma unroll
              for (int u = 0; u < 2; ++u) { bf16* yp = X + ((size_t)grp * 128 + wid * 16 + 2 * it + u) * 2048 + 8 * lane; f32x4 v[8];
#pragma unroll
                  for (int j = 0; j < 4; ++j) { v[2 * j] = (f32x4){bflo(w[u][j].x), bfhi(w[u][j].x), bflo(w[u][j].y), bfhi(w[u][j].y)}; v[2 * j + 1] = (f32x4){bflo(w[u][j].z), bfhi(w[u][j].z), bflo(w[u][j].w), bfhi(w[u][j].w)}; }
                  float sm = 0.f;
#pragma unroll
                  for (int j = 0; j < 8; ++j) sm += (v[j][0] + v[j][1]) + (v[j][2] + v[j][3]);
                  const float mu = wave_sum(sm) * (1.0f / 2048.0f); float q = 0.f;
#pragma unroll
                  for (int j = 0; j < 8; ++j) { v[j] = v[j] - mu; q += (v[j][0] * v[j][0] + v[j][1] * v[j][1]) + (v[j][2] * v[j][2] + v[j][3] * v[j][3]); }
                  const float rs = 1.0f / sqrtf(wave_sum(q) * (1.0f / 2048.0f) + LN_EPS);
#pragma unroll
                  for (int j = 0; j < 4; ++j) { const f32x4 a0 = v[2 * j] * rs * g[2 * j] + b[2 * j], a1 = v[2 * j + 1] * rs * g[2 * j + 1] + b[2 * j + 1];
                      v4u o; o.x = pk2(a0[0], a0[1]); o.y = pk2(a0[2], a0[3]); o.z = pk2(a1[0], a1[1]); o.w = pk2(a1[2], a1[3]); *(v4u*)(yp + 512 * j) = o; } } }
          asm volatile("s_waitcnt vmcnt(0)" ::: "memory"); }
        const bf16* ap = X + ((size_t)grp * 128 + wid * 16 + r16) * 2048 + 8 * kq;
        f32x4_t acc[3] = {};
        bf16x8 a_cur[8], a_nxt[8]; v4u b_st[3];
#define RR_LOADB(ch) do { _Pragma("unroll") for (int j = 0; j < 3; ++j) { const int idx = tid + 512 * j, n = idx >> 5, c16 = idx & 31; b_st[j] = *(const v4u*)(WR + (size_t)n * 2048 + (ch) * 256 + 8 * c16); } } while (0)
#define RR_WRITEB(buf) do { _Pragma("unroll") for (int j = 0; j < 3; ++j) { const int idx = tid + 512 * j, n = idx >> 5, c16 = idx & 31; *(LAS v4u*)(Bs + (buf) * 48 * BP + n * BP + 8 * c16) = b_st[j]; } } while (0)
#define RR_LOADA(dst, ch) do { _Pragma("unroll") for (int ks = 0; ks < 8; ++ks) dst[ks] = *(const bf16x8*)(ap + (ch) * 256 + 32 * ks); } while (0)
        RR_LOADB(0); RR_LOADA(a_cur, 0);
        RR_WRITEB(0);
        __syncthreads();
#pragma unroll
        for (int ch = 0; ch < 8; ++ch) {
            if (ch + 1 < 8) { RR_LOADB(ch + 1); if (ch & 1) RR_LOADA(a_cur, ch + 1); else RR_LOADA(a_nxt, ch + 1); }
#pragma unroll
            for (int ks = 0; ks < 8; ++ks) { const bf16x8 af = (ch & 1) ? a_nxt[ks] : a_cur[ks];
#pragma unroll
                for (int cb = 0; cb < 3; ++cb) { const bf16x8 bfr = *(const LAS bf16x8*)(Bs + (ch & 1) * 48 * BP + (16 * cb + r16) * BP + 32 * ks + 8 * kq);
                    acc[cb] = __builtin_amdgcn_mfma_f32_16x16x32_bf16(af, bfr, acc[cb], 0, 0, 0); } }
            if (ch + 1 < 8) { RR_WRITEB((ch + 1) & 1); __syncthreads(); }
        }
#undef RR_LOADA
#undef RR_WRITEB
#undef RR_LOADB
#pragma unroll
        for (int cb = 0; cb < 3; ++cb)
#pragma unroll
            for (int t = 0; t < 4; ++t) LGs[(wid * 16 + 4 * kq + t) * 49 + 16 * cb + r16] = acc[cb][t];
        __syncthreads();
        if (tid < 128) { const int t = grp * 128 + tid; const LAS float* lp = LGs + tid * 49;
            float gl[4] = {lp[0] + rgb[0], lp[1] + rgb[1], lp[2] + rgb[2], lp[3] + rgb[3]};
            int gi = 0; float gm = gl[0];
#pragma unroll
            for (int j = 1; j < 4; ++j) if (gl[j] > gm) { gm = gl[j]; gi = j; }
            float den = 0.f;
#pragma unroll
            for (int j = 0; j < 4; ++j) den += __expf(gl[j] - gm);
            const float ggate = 1.0f / den;
            const LAS float* ep = lp + 4 + gi * 8; const float* rb = reb + gi * 8;
            float el[8] = {ep[0] + rb[0], ep[1] + rb[1], ep[2] + rb[2], ep[3] + rb[3], ep[4] + rb[4], ep[5] + rb[5], ep[6] + rb[6], ep[7] + rb[7]};
            int i0 = 0; float v0 = el[0];
#pragma unroll
            for (int j = 1; j < 8; ++j) if (el[j] > v0) { v0 = el[j]; i0 = j; }
            int i1 = -1; float v1 = -3.0e38f;
#pragma unroll
            for (int j = 0; j < 8; ++j) if (j != i0 && el[j] > v1) { v1 = el[j]; i1 = j; }
            const float p0 = 1.0f / (1.0f + __expf(v1 - v0)), p1 = 1.0f - p0;
            const int ea = gi * 8 + i0, eb = gi * 8 + i1;
            toke[2 * t] = ea; toke[2 * t + 1] = eb; tokw[2 * t] = p0 * ggate; tokw[2 * t + 1] = p1 * ggate;
            __hip_atomic_fetch_add(hist + ea, 1, __ATOMIC_RELAXED, __HIP_MEMORY_SCOPE_WORKGROUP); __hip_atomic_fetch_add(hist + eb, 1, __ATOMIC_RELAXED, __HIP_MEMORY_SCOPE_WORKGROUP); }
        __syncthreads();
        if (tid < 32) wgc[grp * 32 + tid] = hist[tid];
    }
    __syncthreads();
}
__device__ __forceinline__ void p_route(Frame& F, int dummy_, int lyr) {
    unsigned char* ws = WSP();
    const float* LG = (const float*)(OUTP() + DO_OP); const float* LG2 = LG + (size_t)T * 64; const float* rgb = INP(29) + lyr * 4; const float* reb = INP(31) + lyr * 32;
    int* toke = (int*)(ws + WS_TOKE); float* tokw = (float*)(ws + WS_TOKW); int* wgc = (int*)(ws + WS_WGC);
    LAS int* hist = (LAS int*)(F.lds + SCR_OFF);
    { int* rowt = (int*)(ws + WS_ROWT); for (int i = F.bx * 512 + F.tid; i < RMAX; i += F.G * 512) rowt[i] = 0; }
    for (int grp = F.bx; grp < T / 128; grp += F.G) {
        __syncthreads();
        if (F.tid < 32) hist[F.tid] = 0;
        __syncthreads();
        if (F.tid < 128) { const int t = grp * 128 + F.tid; const float* lp = LG + (size_t)t * 64;
            const float* lp2 = LG2 + (size_t)t * 64; const f32x4 gl4 = *(const f32x4*)lp + *(const f32x4*)lp2; float gl[4] = {gl4[0] + rgb[0], gl4[1] + rgb[1], gl4[2] + rgb[2], gl4[3] + rgb[3]};
            int gi = 0; float gm = gl[0];
#pragma unroll
            for (int j = 1; j < 4; ++j) if (gl[j] > gm) { gm = gl[j]; gi = j; }
            float den = 0.f;
#pragma unroll
            for (int j = 0; j < 4; ++j) den += __expf(gl[j] - gm);
            const float ggate = 1.0f / den;
            const f32x4 e0 = *(const f32x4*)(lp + 4 + gi * 8) + *(const f32x4*)(lp2 + 4 + gi * 8), e1 = *(const f32x4*)(lp + 8 + gi * 8) + *(const f32x4*)(lp2 + 8 + gi * 8); const float* rb = reb + gi * 8;
            float el[8] = {e0[0] + rb[0], e0[1] + rb[1], e0[2] + rb[2], e0[3] + rb[3], e1[0] + rb[4], e1[1] + rb[5], e1[2] + rb[6], e1[3] + rb[7]};
            int i0 = 0; float v0 = el[0];
#pragma unroll
            for (int j = 1; j < 8; ++j) if (el[j] > v0) { v0 = el[j]; i0 = j; }
            int i1 = -1; float v1 = -3.0e38f;
#pragma unroll
            for (int j = 0; j < 8; ++j) if (j != i0 && el[j] > v1) { v1 = el[j]; i1 = j; }
            const float p0 = 1.0f / (1.0f + __expf(v1 - v0)), p1 = 1.0f - p0;
            const int ea = gi * 8 + i0, eb = gi * 8 + i1;
            toke[2 * t] = ea; toke[2 * t + 1] = eb; tokw[2 * t] = p0 * ggate; tokw[2 * t + 1] = p1 * ggate;
            __hip_atomic_fetch_add(hist + ea, 1, __ATOMIC_RELAXED, __HIP_MEMORY_SCOPE_WORKGROUP); __hip_atomic_fetch_add(hist + eb, 1, __ATOMIC_RELAXED, __HIP_MEMORY_SCOPE_WORKGROUP); }
        __syncthreads();
        if (F.tid < 32) wgc[grp * 32 + F.tid] = hist[F.tid];
    }
    __syncthreads();
}
__device__ __forceinline__ void p_dispatch(Frame& F, int dummy_, const bf16* X, bf16* XG) {
    unsigned char* ws = WSP();
    const int* toke = (const int*)(ws + WS_TOKE); const float* tokw = (const float*)(ws + WS_TOKW); int* tokd = (int*)(ws + WS_TOKD); const int* wgc = (const int*)(ws + WS_WGC);
    float* roww = (float*)(ws + WS_ROWW); int* tile = (int*)(ws + WS_TILE); int* rowt = (int*)(ws + WS_ROWT);
    LAS int* part = (LAS int*)(F.lds + SCR_OFF);
    LAS int* base = part + 1024;
    LAS int* pst = base + 32;
    LAS int* earr = pst + 64;
    LAS int* darr = earr + 256;
    for (int grp = F.bx; grp < T / 128; grp += F.G) {
        __syncthreads();
        { const int e = F.tid & 31, p = F.tid >> 5; int below = 0, tot = 0;
          for (int i = p * 16; i < p * 16 + 16; ++i) { const int c = wgc[i * 32 + e]; tot += c; if (i < grp) below += c; }
          part[p * 32 + e] = below; part[512 + p * 32 + e] = tot; }
        __syncthreads();
        if (F.tid < 32) { int below = 0, tot = 0;
            for (int p = 0; p < 16; ++p) { below += part[p * 32 + F.tid]; tot += part[512 + p * 32 + F.tid]; }
            base[F.tid] = below; earr[F.tid] = tot; }
        __syncthreads();
        if (F.tid == 0) { int s = 0; for (int e = 0; e < 32; ++e) { pst[e] = s; s += (earr[e] + 255) & ~255; } pst[32] = s; }
        __syncthreads();
        if (grp == 0) {
            const int ntile = pst[32] >> 8;
            if (F.tid < 320) { int e = 0;
                for (int k = 1; k < 32; ++k) if (pst[k] <= F.tid * 256) e = k;
                tile[F.tid] = e; }
            if (F.tid == 0) tile[400] = ntile;
        }
        int mye = 0, mytok = 0;
        if (F.tid < 256) { mytok = grp * 128 + (F.tid >> 1); mye = toke[2 * mytok + (F.tid & 1)]; }
        __syncthreads();
        if (F.tid < 256) earr[F.tid] = mye;
        __syncthreads();
        if (F.tid < 256) { int rank = 0;
            for (int k = 0; k < F.tid; ++k) rank += (earr[k] == mye) ? 1 : 0;
            const int dest = pst[mye] + base[mye] + rank;
            tokd[2 * mytok + (F.tid & 1)] = dest; roww[dest] = tokw[2 * mytok + (F.tid & 1)]; rowt[dest] = mytok; }
        __syncthreads();
    }
    __syncthreads();
}

#ifndef ALIGN_SHORTK
#define ALIGN_SHORTK true
#endif
#ifndef ROUTER_GEMM
#define ROUTER_GEMM 0
#endif
#ifndef HO_BARRIER
#define HO_BARRIER false
#endif
#ifndef MIXSEL
#define MIXSEL 15
#endif
#ifndef PHMASK
#define PHMASK 0xFFFFFFFF
#endif
#define PH_ON(k) ((PHMASK >> (k)) & 1)
#ifndef DUPMASK
#define DUPMASK 0
#endif
#define REP(k) for (int rep_ = 0; rep_ < 1 + ((DUPMASK >> (k)) & 1); ++rep_)
__global__ void __launch_bounds__(NWAVES * 64, 2) fwd_kernel(Args args) {
    extern __shared__ __attribute__((aligned(16))) unsigned char lds[];
    Frame F;
    F.lds = (LAS unsigned char*)lds;
    F.MISC = (volatile LAS unsigned*)(F.lds + MISC_OFF);
    F.tid = threadIdx.x; F.lane = F.tid & 63; F.wave = __builtin_amdgcn_readfirstlane(F.tid >> 6);
    F.G = gridDim.x; F.bx = blockIdx.x;
    for (int u = F.tid; u < (LDS_BYTES - LDSCTL_OFF) / 4; u += NWAVES * 64) ((LAS unsigned*)(F.lds + LDSCTL_OFF))[u] = 0u;
    __syncthreads();
    if (F.tid < 37) { const unsigned long long p = F.tid < 35 ? (unsigned long long)args.in[F.tid] : (F.tid == 35 ? (unsigned long long)args.out : (unsigned long long)args.ws);
        LAS unsigned* t = (LAS unsigned*)(F.lds + TAB_OFF) + 2 * F.tid; t[0] = (unsigned)p; t[1] = (unsigned)(p >> 32); }
    const int lo = args.ph_lo, hi = args.ph_hi; int ph = 0;
    __syncthreads();
    XcdBarrier bar = xcd_barrier_post((unsigned*)(WSP() + WS_CTL) + CW_BAR, F.MISC + 8);
#define PHASE_BEGIN if (lo <= ph && ph < hi) { refresh(F); unsigned char* const ws = WSP(); unsigned char* const dout = OUTP(); (void)ws; (void)dout;
#define PHASE_END(sync) if ((sync) && ph + 1 < hi) xcd_barrier(bar); } ++ph;
#define XA_ ((bf16*)(ws + WS_XA))
#define XB_ ((bf16*)(ws + WS_XB))
#define HB_ ((bf16*)(ws + WS_H))
#define KV_ ((bf16*)(ws + WS_KV))
#define MIX_ ((bf16*)(dout + DO_MIX))
#define OPB_ ((bf16*)(dout + DO_OP))
#define QC_ ((bf16*)(dout + DO_QC))
#define OC_ ((bf16*)(dout + DO_OC))
#define HBM_ ((bf16*)(dout + DO_HB))

    PHASE_BEGIN
#if PH_ON(0)
        REP(0)
        p_prologue(F, 0);
#endif
#ifdef PROBE_BAR
        for (int xb_ = 0; xb_ < PROBE_BAR; ++xb_) xcd_barrier(bar);
#endif
    PHASE_END(true)
    for (int lyr = 0; lyr < 2; ++lyr) {
        PHASE_BEGIN
#if PH_ON(2)
        REP(2)
        {
            pg8::Gemm g{XA_, (const bf16*)(ws + WS_WIN) + (size_t)lyr * 5120 * 2048, T, INW, 2048, 2048}; pg8::StaticOrder S; S.init(T, lyr == 0 ? INW - 1024 : INW, F.G, F.bx);
            if (lyr == 0) { S.skip_lo = 8; S.skip_n = 4; }
            pg8::Epi<pg8::EM_WIN> E{HB_, INW, nullptr, (const float*)(ws + WS_CSN), (float*)(ws + WS_QK8), lyr, 0.f};
            pg8::gemm_phase<pg8::Epi<pg8::EM_WIN>, pg8::StaticOrder, true, true>(F.lds, g, S, E);
            if (lyr == 0) {
                pg8::Gemm g2{(const bf16*)(ws + WS_WIN) + (size_t)2048 * 2048, XA_, 1024, T, 2048, 2048}; pg8::StaticOrder S2; S2.init(1024, T, F.G, F.bx);
                pg8::Epi<pg8::EM_VT8> E2{(bf16*)(ws + WS_VT8), 0, nullptr, nullptr, nullptr, 0, 4.0f};
                pg8::gemm_phase<pg8::Epi<pg8::EM_VT8>, pg8::StaticOrder, true, true>(F.lds, g2, S2, E2);
            }
        }
#endif
        PHASE_END(true)
        PHASE_BEGIN
#if PH_ON(3)
        REP(3)
            if (lyr == 0) p_diff_attn2(F, (char*)lds, HB_, OPB_);
#endif
        PHASE_END(lyr == 0)
        PHASE_BEGIN
#if PH_ON(1)
        REP(1)
        if (lyr == 0) {
            pg8::Gemm g{(const bf16*)(ws + WS_MEMB), (const bf16*)(ws + WS_MEMKV), NMEMT, 512, 2048, 2048}; pg8::StaticOrder S; S.init(NMEMT, 512, F.G, F.bx);
            pg8::Epi<pg8::EM_PLAIN> E{KV_, 1024, nullptr, nullptr, nullptr, 0, 0.f};
            pg8::gemm_phase<pg8::Epi<pg8::EM_PLAIN>, pg8::StaticOrder, true, true>(F.lds, g, S, E);
            pg8::Gemm g2{(const bf16*)(ws + WS_MEMKV) + (size_t)512 * 2048, (const bf16*)(ws + WS_MEMB), 512, NMEMT, 2048, 2048}; pg8::StaticOrder S2; S2.init(512, NMEMT, F.G, (F.bx + F.G - 4) % F.G);
            pg8::Epi<pg8::EM_PLAIN> E2{(bf16*)(ws + WS_VTM), 512, nullptr, nullptr, nullptr, 0, 0.f};
            pg8::gemm_phase<pg8::Epi<pg8::EM_PLAIN>, pg8::StaticOrder, true, true>(F.lds, g2, S2, E2);
        }
#endif
        PHASE_END(false)
        PHASE_BEGIN
#if PH_ON(4)
        REP(4)
            if (lyr == 0) p_conformer(F, 0, HB_, MIX_);
#endif
        PHASE_END(false)
        PHASE_BEGIN
#if PH_ON(5)
        REP(5)
            if (lyr == 1) p_sgu(F, 0, HB_, MIX_);
#endif
        PHASE_END(false)
        PHASE_BEGIN
#if PH_ON(6)
        REP(6)
            if (lyr == 1) p_sconv(F, 0, HB_, MIX_);
#endif
        PHASE_END(lyr == 1)
        PHASE_BEGIN
#if PH_ON(7)
        REP(7)
            if (lyr == 0) p_combine(F, 0, OPB_, MIX_);
#endif
        PHASE_END(lyr == 0)
        PHASE_BEGIN
#if PH_ON(8)
        REP(8)
        {
            pg8::Gemm g{MIX_, (const bf16*)(ws + WS_WOUT) + (size_t)lyr * 2048 * 2048, T, 2048, 2048, 2048}; pg8::StaticOrder S; S.init(T, 2048, F.G, F.bx);
            pg8::Epi<pg8::EM_RESID_ST> E{XB_, 2048, XA_, nullptr, (float*)(ws + WS_LOG), 0, ALPHA};
            pg8::gemm_phase<pg8::Epi<pg8::EM_RESID_ST>, pg8::StaticOrder, true, true>(F.lds, g, S, E);
        }
#endif
        PHASE_END(true)
        PHASE_BEGIN
#if PH_ON(10)
        REP(10)
        {
            pg8::Gemm g{XB_, (const bf16*)(ws + WS_XQ) + (size_t)lyr * 512 * 2048, T, 512, 2048, 2048}; pg8::StaticOrder S; S.init(T, 512, F.G, F.bx);
            {
              const float* st = (const float*)(ws + WS_LOG); float* rs = (float*)(ws + WS_RS); pg8::Unit u;
              for (int i = 0; i < 8 && S.next(i, u); ++i) { const int row = u.pm * 256 + (F.tid >> 1), hf = F.tid & 1;
                  const f32x4* p = (const f32x4*)(st + ((size_t)row * 32 + hf * 16) * 2); float s1 = 0.f, s2 = 0.f;
#pragma unroll
                  for (int j = 0; j < 8; ++j) { const f32x4 v = p[j]; s1 += v[0] + v[2]; s2 += v[1] + v[3]; }
                  s1 += __shfl_xor(s1, 1); s2 += __shfl_xor(s2, 1);
                  const float mu = s1 * (1.0f / 2048.0f), var = fmaxf(s2 * (1.0f / 2048.0f) - mu * mu, 0.f);
                  if (hf == 0) *(f32x2*)(rs + 2 * (size_t)row) = (f32x2){mu, 1.0f / sqrtf(var + LN_EPS)}; }
              VM_WAIT(); __syncthreads(); }
            pg8::Epi<pg8::EM_XQ> E{QC_, 512, nullptr, (const float*)(ws + WS_RS), (float*)(ws + WS_CSQ) + lyr * 1024, 0, 0.f};
            pg8::gemm_phase<pg8::Epi<pg8::EM_XQ>, pg8::StaticOrder, true, true>(F.lds, g, S, E);
        }
#endif
        PHASE_END(true)
        PHASE_BEGIN
#if PH_ON(11)
        REP(11)
            p_cross_attn2(F, (char*)lds, QC_, KV_, (const bf16*)(ws + WS_VTM), OC_);
#endif
        PHASE_END(true)
        PHASE_BEGIN
#if PH_ON(12)
        REP(12)
        {
            pg8::Gemm g{OC_, (const bf16*)(ws + WS_XO) + (size_t)lyr * 2048 * 512, T, 2048, 512, 512}; pg8::StaticOrder S; S.init(T, 2048, F.G, F.bx);
            pg8::Epi<pg8::EM_RESID_LN> E{XA_, 2048, XB_, (const float*)(ws + WS_RS), nullptr, 0, ALPHA, INP(5) + lyr * 2048, INP(6) + lyr * 2048};
            pg8::gemm_phase<pg8::Epi<pg8::EM_RESID_LN>, pg8::StaticOrder, ALIGN_SHORTK, true>(F.lds, g, S, E);
        }
#endif
        PHASE_END(true)
#if ROUTER_GEMM
        PHASE_BEGIN
#if PH_ON(13)
        REP(13)
            p_ln<0>(F, XA_, nullptr, nullptr, nullptr, INP(7) + lyr * 2048, INP(8) + lyr * 2048);
#endif
        PHASE_END(true)
#endif
#if ROUTER_GEMM
        PHASE_BEGIN
#if PH_ON(14)
        REP(14)
        {
            pg8::Gemm g{XA_, (const bf16*)(ws + WS_ROUT) + (size_t)lyr * 256 * 2048, T, 256, 1024, 2048}; pg8::SplitK2Order S{T / 256, F.G, F.bx, 1024};
            pg8::Epi<pg8::EM_LOGITS> E{nullptr, 0, nullptr, nullptr, (float*)(dout + DO_OP), 0, 0.f};
            pg8::gemm_phase<pg8::Epi<pg8::EM_LOGITS>, pg8::SplitK2Order, true, true>(F.lds, g, S, E);
        }
#endif
        PHASE_END(true)
        PHASE_BEGIN
#if PH_ON(15)
        REP(15)
            p_route(F, 0, lyr);
#endif
        PHASE_END(true)
#else
        PHASE_BEGIN
#if PH_ON(14)
        REP(14)
            p_router_route(F, lyr, XA_, INP(7) + lyr * 2048, INP(8) + lyr * 2048);
#endif
        PHASE_END(true)
#endif
        PHASE_BEGIN
#if PH_ON(16)
        REP(16)
            p_dispatch(F, 0, XA_, HB_);
#endif
        PHASE_END(true)
        PHASE_BEGIN
#if PH_ON(17)
        REP(17)
        {
            const int* tile = (const int*)(ws + WS_TILE); const int ntile = tile[400];
            LAS int* rtab = (LAS int*)(F.lds + SCR_OFF);
            pg8::Gemm g{XA_, (const bf16*)(ws + WS_W13) + (size_t)lyr * 32 * 1024 * 2048, RMAX, 32 * 1024, 2048, 2048};
            pg8::MoeOrder1H S{tile, ntile, F.G, F.bx, rtab, (unsigned*)(ws + WS_CTL) + CW_HO + 64 * 288 * lyr, (unsigned*)(ws + WS_CTL) + CW_HO + 64 * (576 + 8 * lyr)};
            { const int* rowt = (const int*)(ws + WS_ROWT); pg8::Unit u;
              for (int i = 0; i < 8 && S.next(i, u); ++i) if (F.tid < 256) rtab[i * 256 + F.tid] = rowt[u.pm * 256 + F.tid];
              __syncthreads(); }
            pg8::Epi<pg8::EM_SWIGLU_WT> E{HBM_, 512, nullptr, nullptr, nullptr, 0, 0.f};
            pg8::gemm_phase_g<pg8::Epi<pg8::EM_SWIGLU_WT>, pg8::MoeOrder1H, true, true>(F.lds, g, S, E);
        }
#endif
        PHASE_END(HO_BARRIER)
        PHASE_BEGIN
#if PH_ON(18)
        REP(18)
        {
            const int* tile = (const int*)(ws + WS_TILE); const int ntile = tile[400];
            pg8::Gemm g{HBM_, (const bf16*)(ws + WS_W2) + (size_t)lyr * 32 * 2048 * 512, RMAX, 32 * 2048, 512, 512};
            pg8::MoeOrder2H S{tile, ntile, F.G, F.bx, (unsigned*)(ws + WS_CTL) + CW_HO + 64 * 288 * lyr, 32u, (unsigned*)(ws + WS_CTL) + CW_HO + 64 * (576 + 8 * lyr)};
            pg8::Epi<pg8::EM_ROWSCALE> E{HB_, 2048, nullptr, (const float*)(ws + WS_ROWW), nullptr, 0, 0.f};
            pg8::gemm_phase<pg8::Epi<pg8::EM_ROWSCALE>, pg8::MoeOrder2H, ALIGN_SHORTK, true>(F.lds, g, S, E);
        }
#endif
        PHASE_END(true)
        PHASE_BEGIN
#if PH_ON(19)
        REP(19)
            if (lyr == 0) p_ln<1>(F, XA_, HB_, (const int*)(ws + WS_TOKD), nullptr, INP(9), INP(10));
#endif
        PHASE_END(false)
        PHASE_BEGIN
#if PH_ON(20)
        REP(20)
            if (lyr == 1) p_ln<2>(F, XA_, HB_, (const int*)(ws + WS_TOKD), (float*)dout, INP(9) + 2048, INP(10) + 2048);
#endif
        PHASE_END(true)
    }
#undef PHASE_BEGIN
#undef PHASE_END
}

extern "C" void kernel_launch(void* const* d_in, const int* in_sizes, int n_in, void* d_out, int out_size, void* d_ws, size_t ws_size, hipStream_t stream) {
    static int grid = 0;
    if (grid == 0) {
        if (n_in != 35 || in_sizes[0] != T * DM || out_size != T * DM || ws_size < WS_END) { fprintf(stderr, "kernel_launch: unexpected shapes / workspace (n_in %d, ws %zu)\n", n_in, ws_size); grid = -1; return; }
        int dev = 0, cus = 0;
        if (hipGetDevice(&dev) != hipSuccess || hipDeviceGetAttribute(&cus, hipDeviceAttributeMultiprocessorCount, dev) != hipSuccess) { grid = -1; return; }
        if (hipFuncSetAttribute((const void*)fwd_kernel, hipFuncAttributeMaxDynamicSharedMemorySize, LDS_BYTES) != hipSuccess) { fprintf(stderr, "kernel_launch: hipFuncSetAttribute failed\n"); grid = -1; return; }
        int per_cu = 0;
        if (hipOccupancyMaxActiveBlocksPerMultiprocessor(&per_cu, (const void*)fwd_kernel, NWAVES * 64, LDS_BYTES) != hipSuccess || per_cu < 1) { fprintf(stderr, "kernel_launch: occupancy query says %d\n", per_cu); }
        (void)hipGetLastError();
        grid = cus > 0 ? cus : 256;
    }
    if (grid < 0) return;
    (void)hipMemsetAsync((char*)d_ws + WS_CTL, 0, CTL_ZERO_BYTES, stream);
    Args a{};
    for (int i = 0; i < 35; ++i) a.in[i] = d_in[i];
    a.out = (unsigned char*)d_out; a.ws = (unsigned char*)d_ws; a.ph_lo = 0; a.ph_hi = 1000;
    hipLaunchKernelGGL(fwd_kernel, dim3(grid), dim3(NWAVES * 64), LDS_BYTES, stream, a);
}
```

```cpp
#define DUPMASK (0)
#include <hip/hip_runtime.h>
#include <hip/hip_bf16.h>
#include <cstdio>
#include <cstdint>
#include <cmath>

namespace pg8 {
#define PG8_LAS __attribute__((address_space(3)))
typedef unsigned short bf16_t;
typedef short bf16x8 __attribute__((ext_vector_type(8)));
typedef float f32x4 __attribute__((ext_vector_type(4)));
typedef float f32x2 __attribute__((ext_vector_type(2)));
typedef unsigned u32x4 __attribute__((ext_vector_type(4)));
constexpr int BM = 256, BK = 64, HALF = 128, HTB = HALF * BK * 2  , STAGE_BYTES = 8 * HTB, NXCD = 8, WGM = 8;

__host__ __device__ __forceinline__ int lds_byte(int r, int c) { const int st = (r >> 4) * 2 + (c >> 5), rr = r & 15, cc = c & 31, ob = rr * 64 + cc * 2; return st * 1024 + (ob ^ (((ob >> 9) & 1) << 5)); }
__host__ __device__ __forceinline__ void stage_rc(int b, int& R, int& C) { const int st = b / 1024, sb = b % 1024, swz = sb ^ (((sb >> 9) & 1) << 5); R = (st >> 1) * 16 + swz / 64; C = (st & 1) * 32 + (swz % 64) / 2; }
__host__ __device__ __forceinline__ int perm32(int rho) { const int n = rho >> 4, i = rho & 15; return 8 * (i >> 2) + 4 * n + (i & 3); }

struct Unit { int pm, pn, pb, ko; };
struct Gemm { const bf16_t* A; const bf16_t* Bt; int M, N, K, ld; };

struct StaticOrder {
    int nM, nN, nwg, G, c, skip_lo = 1 << 30, skip_n = 0;
    __host__ __device__ void init(int M, int N, int G_, int c_) { nM = M / BM; nN = N / BM; nwg = nM * nN; G = G_; c = c_; }
    __host__ __device__ __forceinline__ bool next(int i, Unit& u) const {
        const long L = (long)i * G + c; if (L >= nwg) return false;
        int wgid = (int)L; { const int q = nwg / NXCD, r = nwg % NXCD, xcd = wgid % NXCD, off = wgid / NXCD; wgid = (xcd < r ? xcd * (q + 1) : r * (q + 1) + (xcd - r) * q) + off; }
        const int nig = WGM * nN, gid = wgid / nig, fm = gid * WGM, gsz = (nM - fm) < WGM ? (nM - fm) : WGM;
        u.pm = fm + ((wgid % nig) % gsz); u.pn = (wgid % nig) / gsz; if (u.pn >= skip_lo) u.pn += skip_n; u.pb = u.pn; u.ko = 0; return true;
    }
    __device__ __forceinline__ void a_ready(const Unit&) const {}
    __device__ __forceinline__ void done(const Unit&) const {}
};
struct SplitK2Order {
    int nM, G, c, khalf;
    __device__ __forceinline__ bool next(int i, Unit& u) const { const int L = i * G + c; if (L >= 2 * nM) return false; u.pm = L >> 1; u.pn = L & 1; u.pb = 0; u.ko = (L & 1) * khalf; return true; }
    __device__ __forceinline__ void a_ready(const Unit&) const {}
    __device__ __forceinline__ void done(const Unit&) const {}
};
struct MoeOrder {
    const int* tile_e; int n_units, NT, G, c; const PG8_LAS int* rtab;
    __device__ __forceinline__ bool next(int i, Unit& u) const {
        int rt, pn;
        if (G % (8 * NT) == 0) { const int x = c & 7, k = c >> 3, per_x = (G >> 3) / NT; rt = i * (G / NT) + x * per_x + k / NT; pn = k % NT; if (rt * NT >= n_units) return false; }
        else { const long L = (long)i * G + c; if (L >= n_units) return false; rt = (int)L / NT; pn = (int)L % NT; }
        u.pm = rt; u.pn = pn; u.pb = tile_e[rt] * NT + pn; u.ko = 0; return true;
    }
    __device__ __forceinline__ void a_ready(const Unit&) const {}
    __device__ __forceinline__ void done(const Unit&) const {}
};

struct MoeOrder1H {
    const int* tile_e; int ntile, G, c; const PG8_LAS int* rtab; unsigned* cnt; unsigned* full;
    __device__ __forceinline__ bool next(int i, Unit& u) const {
        int rt, pn;
        if (G == 256) { const int x = c & 7, k = c >> 3, R1 = ntile >> 6, rem = ntile & 63;
            if (i < R1) rt = i * 64 + x * 8 + (k >> 2);
            else if (i == R1) { const int j = (k >> 2) * 8 + x; if (j >= rem) return false; rt = R1 * 64 + j; }
            else return false;
            pn = k & 3; }
        else { const long L = (long)i * G + c; if (L >= (long)ntile * 4) return false; rt = (int)(L >> 2); pn = (int)(L & 3); }
        u.pm = rt; u.pn = pn; u.pb = tile_e[rt] * 4 + pn; u.ko = 0; return true; }
    __device__ __forceinline__ void a_ready(const Unit&) const {}
    __device__ __forceinline__ void done(const Unit& u) const {
        asm volatile("s_waitcnt vmcnt(0)" ::: "memory");
        if ((threadIdx.x & 63) == 0) { (void)__hip_atomic_fetch_add(cnt + 64 * u.pm, 1u, __ATOMIC_RELAXED, __HIP_MEMORY_SCOPE_AGENT);
            if (G == 256 && (u.pm >> 6) == (ntile >> 6) - 1) (void)__hip_atomic_fetch_add(full + 64 * (c & 7), 1u, __ATOMIC_RELAXED, __HIP_MEMORY_SCOPE_AGENT); } }
};
struct MoeOrder2H {
    const int* tile_e; int ntile, G, c; unsigned* cnt; unsigned need; unsigned* full; mutable bool fd = false;
    __device__ __forceinline__ bool next(int i, Unit& u) const {
        int rt, pn;
        if (G == 256) { const int x = c & 7, k = c >> 3, R1 = ntile >> 6, rem = ntile & 63;
            int ntx = rem > x ? (rem - x + 7) >> 3 : 0; if (ntx > 7) ntx = 0;
            const int U = 8 * (8 * R1 + ntx), Hc = 4 * ntx, Lc = 32 - Hc;
            int ra = (U - 2 * Lc) >> 5; if (ra < 0) ra = 0;
            int idx;
            if (i < ra) idx = i * 32 + k; else { if (k < Hc) return false; idx = ra * 32 + (i - ra) * Lc + (k - Hc); }
            if (idx >= U) return false;
            const int rp = idx >> 3; pn = idx & 7;
            rt = rp < 8 * R1 ? ((rp >> 3) * 64 + x * 8 + (rp & 7)) : (R1 * 64 + (rp - 8 * R1) * 8 + x); }
        else { const long L = (long)i * G + c; if (L >= (long)ntile * 8) return false; rt = (int)(L >> 3); pn = (int)(L & 7); }
        u.pm = rt; u.pn = pn; u.pb = tile_e[rt] * 8 + pn; u.ko = 0; return true; }
#ifdef HO_NOWAIT
    __device__ __forceinline__ void a_ready(const Unit&) const {}
#else
    __device__ __forceinline__ void a_ready(const Unit& u) const {
        const bool fr_ = (G == 256) && u.pm < ((ntile >> 6) << 6);
        if (fr_ && fd) return;
        const unsigned* w_ = fr_ ? full + 64 * (c & 7) : cnt + 64 * u.pm; const unsigned nd_ = fr_ ? 256u : need;
        if (threadIdx.x < 64) { unsigned polls = 0;
            while ((unsigned)__builtin_amdgcn_readfirstlane(__hip_atomic_load(w_, __ATOMIC_RELAXED, __HIP_MEMORY_SCOPE_AGENT)) < nd_) {
                __builtin_amdgcn_s_sleep(2); if (++polls > (1u << 22)) break; }
            __builtin_amdgcn_fence(__ATOMIC_ACQUIRE, "agent");
            asm volatile("s_waitcnt vmcnt(0)" ::: "memory"); }
        asm volatile("" ::: "memory"); __builtin_amdgcn_s_barrier(); asm volatile("" ::: "memory");
        if (fr_) fd = true; }
#endif
    __device__ __forceinline__ void done(const Unit&) const {}
};

__device__ __forceinline__ unsigned cvt_pk_bf16(float lo, float hi) { unsigned r; asm volatile("v_cvt_pk_bf16_f32 %0, %1, %2" : "=v"(r) : "v"(lo), "v"(hi)); return r; }
__device__ __forceinline__ float bf_lo(unsigned w) { return __uint_as_float(w << 16); }
__device__ __forceinline__ float bf_hi(unsigned w) { return __uint_as_float(w & 0xffff0000u); }
__device__ __forceinline__ f32x2 gelu_pk(f32x2 v) {
    const f32x2 av = __builtin_elementwise_abs(v), d = av * 0.2316418882f + 1.0f;
    f32x2 t; t.x = __builtin_amdgcn_rcpf(d.x); t.y = __builtin_amdgcn_rcpf(d.y);
    f32x2 q = t * 0.5307027145f + (-0.7265760135f); q = q * t + 0.7107068705f; q = q * t + (-0.142248368f); q = q * t + 0.127414796f; q = q * t;
    const f32x2 s = (v * v) * (-0.72134752044f);
    f32x2 e; e.x = __builtin_amdgcn_exp2f(s.x); e.y = __builtin_amdgcn_exp2f(s.y);
    const f32x2 m = v * (q * e), r = v - m;
    f32x2 o; o.x = v.x < 0.f ? m.x : r.x; o.y = v.y < 0.f ? m.y : r.y; return o;
}
__device__ __forceinline__ float silu_f(float x) { return x * __builtin_amdgcn_rcpf(1.0f + __builtin_amdgcn_exp2f(-1.4426950408889634f * x)); }

enum { EM_PLAIN = 0, EM_WIN = 1, EM_RESID = 2, EM_LOGITS = 3, EM_SWIGLU = 4, EM_ROWSCALE = 5, EM_VT8 = 7, EM_RESID_ST = 8, EM_XQ = 9, EM_RESID_LN = 10, EM_SWIGLU_WT = 11   };
typedef unsigned u32x2 __attribute__((ext_vector_type(2)));
__device__ __forceinline__ unsigned pk_fp8x4(float a, float b, float c, float d) { int w = __builtin_amdgcn_cvt_pk_fp8_f32(a, b, __builtin_bit_cast(int, a), false); w = __builtin_amdgcn_cvt_pk_fp8_f32(c, d, w, true); return (unsigned)w; }
__device__ __forceinline__ unsigned pk_fp8x4o(float a, float b, float c, float d, int old) { int w = __builtin_amdgcn_cvt_pk_fp8_f32(a, b, old, false); w = __builtin_amdgcn_cvt_pk_fp8_f32(c, d, w, true); return (unsigned)w; }
template <int MODE> struct Epi {
    static constexpr bool PERM = true, AFTER_DRAIN = false;
    bf16_t* O; int ldc;
    const bf16_t* R;
    const float* aux;
    float* OF;
    int lyr;
    float alpha;
    const float* aux2 = nullptr; const float* aux3 = nullptr;
    __device__ __forceinline__ void store8(bf16_t* p, f32x4 v0, f32x4 v1) const {
        u32x4 w; w.x = cvt_pk_bf16(v0[0], v0[1]); w.y = cvt_pk_bf16(v0[2], v0[3]); w.z = cvt_pk_bf16(v1[0], v1[1]); w.w = cvt_pk_bf16(v1[2], v1[3]); *(u32x4*)p = w; }
    __device__ __forceinline__ void store8_wt(bf16_t* p, f32x4 v0, f32x4 v1) const {
        u32x4 w; w.x = cvt_pk_bf16(v0[0], v0[1]); w.y = cvt_pk_bf16(v0[2], v0[3]); w.z = cvt_pk_bf16(v1[0], v1[1]); w.w = cvt_pk_bf16(v1[2], v1[3]);
        asm volatile("global_store_dwordx4 %0, %1, off sc1\n\ts_nop 1" :: "v"(p), "v"(w) : "memory"); }
    __device__ __forceinline__ void operator()(const f32x4 (&acc)[2][2][4][2], const Unit& u, int wr, int wc, int fr, int fq) const {
        const int row0 = u.pm * BM + wr * 64 + fr;
        if constexpr (MODE == EM_LOGITS) {
            if (wc < 2) {
#pragma unroll
                for (int ai = 0; ai < 2; ++ai)
#pragma unroll
                    for (int m = 0; m < 4; ++m) { float* p = OF + (size_t)u.pn * (32768 * 64) + (size_t)(row0 + ai * HALF + m * 16) * 64 + wc * 32 + 8 * fq;
                        *(f32x4*)p = acc[ai][0][m][0]; *(f32x4*)(p + 4) = acc[ai][0][m][1]; }
            }
        } else if constexpr (MODE == EM_VT8) {
            unsigned char* O8 = (unsigned char*)O;
#pragma unroll
            for (int ai = 0; ai < 2; ++ai)
#pragma unroll
                for (int m = 0; m < 4; ++m) { const int row = row0 + ai * HALF + m * 16;
#pragma unroll
                    for (int bj = 0; bj < 2; ++bj) { const int col0 = u.pn * BM + bj * HALF + wc * 32 + 8 * fq; const f32x4 v0 = acc[ai][bj][m][0] * alpha, v1 = acc[ai][bj][m][1] * alpha;
                        u32x2 w; w.x = pk_fp8x4(v0[0], v0[1], v0[2], v0[3]); w.y = pk_fp8x4(v1[0], v1[1], v1[2], v1[3]);
                        unsigned char* bp = O8 + ((size_t)(col0 >> 14) * 1024 + row) * 16384 + (col0 & 16383 & ~63); const int g = (col0 & 63) >> 2, d = 4 * (g >> 3) + ((g & 7) >> 1);
                        *(unsigned*)(bp + 4 * d) = w.x; *(unsigned*)(bp + 4 * d + 32) = w.y; } }
        } else if constexpr (MODE == EM_SWIGLU || MODE == EM_SWIGLU_WT) {
            const int col0 = u.pn * HALF + wc * 32 + 8 * fq;
#pragma unroll
            for (int ai = 0; ai < 2; ++ai)
#pragma unroll
                for (int m = 0; m < 4; ++m) { f32x4 v0, v1;
#pragma unroll
                    for (int j = 0; j < 4; ++j) { v0[j] = silu_f(acc[ai][0][m][0][j]) * acc[ai][1][m][0][j]; v1[j] = silu_f(acc[ai][0][m][1][j]) * acc[ai][1][m][1][j]; }
                    if constexpr (MODE == EM_SWIGLU_WT) store8_wt(O + (size_t)(row0 + ai * HALF + m * 16) * ldc + col0, v0, v1);
                    else store8(O + (size_t)(row0 + ai * HALF + m * 16) * ldc + col0, v0, v1); }
        } else {
            const int col0 = u.pn * BM + wc * 32 + 8 * fq;
            const bool rope = (MODE == EM_WIN) && lyr == 0 && u.pn < 8 && wc == 0;
            const bool gelu = (MODE == EM_WIN) && lyr == 1 && u.pn < 8;
            const bool glu = (MODE == EM_WIN) && lyr == 0 && u.pn >= 12;
            f32x4 cA[2][2], cB[2][2];
            if constexpr (MODE == EM_XQ) {
#pragma unroll
                for (int bj = 0; bj < 2; ++bj)
#pragma unroll
                    for (int n = 0; n < 2; ++n) { cA[bj][n] = *(const f32x4*)(OF + col0 + bj * HALF + 4 * n); cB[bj][n] = *(const f32x4*)(OF + 512 + col0 + bj * HALF + 4 * n); } }
            if constexpr (MODE == EM_RESID_LN) {
#pragma unroll
                for (int bj = 0; bj < 2; ++bj)
#pragma unroll
                    for (int n = 0; n < 2; ++n) { cA[bj][n] = *(const f32x4*)(aux2 + col0 + bj * HALF + 4 * n) * alpha; cB[bj][n] = *(const f32x4*)(aux3 + col0 + bj * HALF + 4 * n) * alpha; } }
#pragma unroll
            for (int ai = 0; ai < 2; ++ai)
#pragma unroll
                for (int m = 0; m < 4; ++m) { const int row = row0 + ai * HALF + m * 16; bf16_t* rowp = O + (size_t)row * ldc + col0;
                    float rs = 1.f; if constexpr (MODE == EM_ROWSCALE) rs = aux[row];
                    f32x2 mr = (f32x2){0.f, 1.f}; if constexpr (MODE == EM_XQ || MODE == EM_RESID_LN) mr = *(const f32x2*)(aux + 2 * (size_t)row);
                    float s1 = 0.f, s2 = 0.f;
                    f32x4 cs0, cs1, sn0, sn1;
                    if constexpr (MODE == EM_WIN) { if (rope) { const float* cp = aux + (size_t)row * 32 + (fq & 1) * 8; cs0 = *(const f32x4*)cp; cs1 = *(const f32x4*)(cp + 4); sn0 = *(const f32x4*)(cp + 16); sn1 = *(const f32x4*)(cp + 20); } }
                    if (MODE == EM_WIN && glu) { f32x4 c0, c1;
#pragma unroll
                        for (int j = 0; j < 4; ++j) { c0[j] = acc[ai][0][m][0][j] * __builtin_amdgcn_rcpf(1.0f + __builtin_amdgcn_exp2f(-1.4426950408889634f * acc[ai][1][m][0][j]));
                                                      c1[j] = acc[ai][0][m][1][j] * __builtin_amdgcn_rcpf(1.0f + __builtin_amdgcn_exp2f(-1.4426950408889634f * acc[ai][1][m][1][j])); }
                        store8(O + (size_t)row * ldc + 3072 + (u.pn - 12) * HALF + wc * 32 + 8 * fq, c0, c1); continue; }
#pragma unroll
                    for (int bj = 0; bj < 2; ++bj) { f32x4 v0 = acc[ai][bj][m][0], v1 = acc[ai][bj][m][1];
                        if constexpr (MODE == EM_WIN) {
                            if (rope) {
                                f32x4 p0, p1;
#pragma unroll
                                for (int j = 0; j < 4; ++j) { p0[j] = __shfl_xor(v0[j], 32); p1[j] = __shfl_xor(v1[j], 32); }
                                const float sg = (fq < 2) ? -1.f : 1.f;
#pragma unroll
                                for (int j = 0; j < 4; ++j) { v0[j] = v0[j] * cs0[j] + sg * p0[j] * sn0[j]; v1[j] = v1[j] * cs1[j] + sg * p1[j] * sn1[j]; }
                            } else if (gelu) {
                                f32x2 a = gelu_pk((f32x2){v0[0], v0[1]}), b = gelu_pk((f32x2){v0[2], v0[3]}), c = gelu_pk((f32x2){v1[0], v1[1]}), d = gelu_pk((f32x2){v1[2], v1[3]});
                                v0 = (f32x4){a.x, a.y, b.x, b.y}; v1 = (f32x4){c.x, c.y, d.x, d.y};
                            }
                        }
                        if constexpr (MODE == EM_XQ) { const float t = -mr.x * mr.y; v0 = v0 * mr.y + (cA[bj][0] * t + cB[bj][0]); v1 = v1 * mr.y + (cA[bj][1] * t + cB[bj][1]); }
                        if constexpr (MODE == EM_RESID_LN) { const u32x4 rw = __builtin_nontemporal_load((const u32x4*)(R + (size_t)row * ldc + col0 + bj * HALF));
                            const f32x4 y0 = ((f32x4){bf_lo(rw.x), bf_hi(rw.x), bf_lo(rw.y), bf_hi(rw.y)} - mr.x) * mr.y, y1 = ((f32x4){bf_lo(rw.z), bf_hi(rw.z), bf_lo(rw.w), bf_hi(rw.w)} - mr.x) * mr.y;
                            v0 = v0 + (y0 * cA[bj][0] + cB[bj][0]); v1 = v1 + (y1 * cA[bj][1] + cB[bj][1]); }
                        if constexpr (MODE == EM_RESID || MODE == EM_RESID_ST) { const u32x4 rw = __builtin_nontemporal_load((const u32x4*)(R + (size_t)row * ldc + col0 + bj * HALF));
                            v0[0] += alpha * bf_lo(rw.x); v0[1] += alpha * bf_hi(rw.x); v0[2] += alpha * bf_lo(rw.y); v0[3] += alpha * bf_hi(rw.y);
                            v1[0] += alpha * bf_lo(rw.z); v1[1] += alpha * bf_hi(rw.z); v1[2] += alpha * bf_lo(rw.w); v1[3] += alpha * bf_hi(rw.w); }
                        if constexpr (MODE == EM_RESID_ST) { s1 += ((v0[0] + v0[1]) + (v0[2] + v0[3])) + ((v1[0] + v1[1]) + (v1[2] + v1[3]));
                            s2 += ((v0[0] * v0[0] + v0[1] * v0[1]) + (v0[2] * v0[2] + v0[3] * v0[3])) + ((v1[0] * v1[0] + v1[1] * v1[1]) + (v1[2] * v1[2] + v1[3] * v1[3])); }
                        if constexpr (MODE == EM_ROWSCALE) { v0 = v0 * rs; v1 = v1 * rs; }
                        if (MODE == EM_WIN && lyr == 0 && u.pn < 8) {
                            u32x2 w8; w8.x = pk_fp8x4(v0[0], v0[1], v0[2], v0[3]); w8.y = pk_fp8x4(v1[0], v1[1], v1[2], v1[3]);
                            *(u32x2*)((unsigned char*)OF + (size_t)row * 2048 + col0 + bj * HALF) = w8; }
                        else store8(rowp + bj * HALF, v0, v1); }
                    if constexpr (MODE == EM_RESID_ST) { s1 += __shfl_xor(s1, 16); s2 += __shfl_xor(s2, 16); s1 += __shfl_xor(s1, 32); s2 += __shfl_xor(s2, 32);
                        if (fq == 0) *(f32x2*)(OF + ((size_t)row * 32 + u.pn * 4 + wc) * 2) = (f32x2){s1, s2}; } }
        }
    }
};

template <class Epi, class Sched, bool ALIGN_EPI = false, bool SP2 = false>
__device__ __forceinline__ void gemm_phase(PG8_LAS unsigned char* lds, const Gemm g, const Sched& S, const Epi& E) {
    int tid_ = threadIdx.x; asm volatile("" : "+v"(tid_)); const int tid = tid_, wid = __builtin_amdgcn_readfirstlane(tid >> 6), lane = tid & 63, wr = wid >> 2, wc = wid & 3, fr = lane & 15, fq = lane >> 4;
    const int K = g.K, nt = K / BK, LD = g.ld;
    unsigned voffA[2], voffB[2];
#pragma unroll
    for (int i = 0; i < 2; ++i) { int R, C; stage_rc(tid * 16 + i * 8192, R, C); const int Rb = Epi::PERM ? ((R & ~31) + perm32(R & 31)) : R;
        voffA[i] = (unsigned)(R * LD + C) * 2u; voffB[i] = (unsigned)(Rb * LD + C) * 2u; }
    const size_t kstep = (size_t)(BK * 2);
    const size_t hstep = (size_t)HALF * LD * 2;
    const size_t tstep = 2 * hstep;
    const unsigned ldsw = (unsigned)wid * 1024u;
    const int aoff = lds_byte(wr * 64 + fr, fq * 8), boff = lds_byte(wc * 32 + fr, fq * 8);
#define PG8_SA(b, h) (((b) * 2 + (h)) * HTB)
#define PG8_SB(b, h) ((4 + (b) * 2 + (h)) * HTB)
#define PG8_STAGE(bufoff, gbase, voff) do { _Pragma("unroll") for (int _i = 0; _i < 2; ++_i) \
        __builtin_amdgcn_global_load_lds((const unsigned*)((const char*)(gbase) + (voff)[_i]), (PG8_LAS unsigned*)(lds + (bufoff) + ldsw + _i * 8192), 16, 0, 0); } while (0)
#define PG8_LDA(dst, b, h) do { _Pragma("unroll") for (int m = 0; m < 4; ++m) _Pragma("unroll") for (int k = 0; k < 2; ++k) dst[m][k] = *(const PG8_LAS bf16x8*)(lds + PG8_SA(b, h) + aoff + m * 2048 + k * 1024); } while (0)
#define PG8_LDB(dst, b, h) do { _Pragma("unroll") for (int n = 0; n < 2; ++n) _Pragma("unroll") for (int k = 0; k < 2; ++k) dst[n][k] = *(const PG8_LAS bf16x8*)(lds + PG8_SB(b, h) + boff + n * 2048 + k * 1024); } while (0)
#define PG8_MMA(ai, bj, At, Bt) do { __builtin_amdgcn_s_setprio(1); _Pragma("unroll") for (int m = 0; m < 4; ++m) _Pragma("unroll") for (int n = 0; n < 2; ++n) _Pragma("unroll") for (int k = 0; k < 2; ++k) \
        acc[ai][bj][m][n] = __builtin_amdgcn_mfma_f32_16x16x32_bf16(Bt[n][k], At[m][k], acc[ai][bj][m][n], 0, 0, 0); __builtin_amdgcn_s_setprio(0); } while (0)
#define PG8_WAIT_V(n) asm volatile("s_waitcnt vmcnt(" #n ")" ::: "memory")
#define PG8_WAIT_L(n) asm volatile("s_waitcnt lgkmcnt(" #n ")" ::: "memory")
#define PG8_BAR __builtin_amdgcn_s_barrier()
#define PG8_SCHED __builtin_amdgcn_sched_barrier(0)
    Unit cur, nxt; int ui = 0;
    if (!S.next(0, cur)) return;
    f32x4 acc[2][2][4][2];
#pragma unroll
    for (int a = 0; a < 2; ++a)
#pragma unroll
        for (int b = 0; b < 2; ++b)
#pragma unroll
            for (int m = 0; m < 4; ++m)
#pragma unroll
                for (int n = 0; n < 2; ++n) acc[a][b][m][n] = (f32x4){0.f, 0.f, 0.f, 0.f};
    bf16x8 At[4][2], B0[2][2], B1[2][2];
    const char* cA = (const char*)g.A + (size_t)cur.pm * tstep + (size_t)cur.ko * 2; const char* cB = (const char*)g.Bt + (size_t)cur.pb * tstep + (size_t)cur.ko * 2;
    S.a_ready(cur);
    if constexpr (SP2) {
        PG8_STAGE(PG8_SB(0, 0), cB, voffB); PG8_STAGE(PG8_SB(0, 1), cB + hstep, voffB); PG8_STAGE(PG8_SA(0, 0), cA, voffA); PG8_STAGE(PG8_SA(0, 1), cA + hstep, voffA);
        if (wr == 1) PG8_BAR;
        PG8_WAIT_V(2); PG8_BAR;
        PG8_STAGE(PG8_SB(1, 0), cB + kstep, voffB); PG8_STAGE(PG8_SA(1, 0), cA + kstep, voffA); PG8_STAGE(PG8_SB(1, 1), cB + hstep + kstep, voffB);
        PG8_WAIT_V(6); PG8_BAR;
    } else {
        PG8_STAGE(PG8_SB(0, 0), cB, voffB); PG8_STAGE(PG8_SA(0, 0), cA, voffA); PG8_STAGE(PG8_SB(0, 1), cB + hstep, voffB); PG8_STAGE(PG8_SA(0, 1), cA + hstep, voffA);
        if (wr == 1) PG8_BAR;
        PG8_WAIT_V(4); PG8_BAR;
        PG8_STAGE(PG8_SB(1, 0), cB + kstep, voffB); PG8_STAGE(PG8_SA(1, 0), cA + kstep, voffA); PG8_STAGE(PG8_SB(1, 1), cB + hstep + kstep, voffB);
        PG8_WAIT_V(6); PG8_BAR;
    }
    for (;;) {
        const bool has_next = S.next(ui + 1, nxt);
        const char* nA = has_next ? (const char*)g.A + (size_t)nxt.pm * tstep + (size_t)nxt.ko * 2 : cA; const char* nB = has_next ? (const char*)g.Bt + (size_t)nxt.pb * tstep + (size_t)nxt.ko * 2 : cB;
        for (int t = 0; t < nt; t += 2) {
            const bool last = (t == nt - 2);
            const char* a1 = cA + (size_t)(t + 1) * kstep;
            const char* a2 = last ? nA : cA + (size_t)(t + 2) * kstep; const char* b2 = last ? nB : cB + (size_t)(t + 2) * kstep;
            const char* a3 = a2 + kstep; const char* b3 = b2 + kstep;
            if (last && has_next) S.a_ready(nxt);
            if constexpr (SP2) {
            PG8_LDB(B0, 0, 0); PG8_LDB(B1, 0, 1); PG8_SCHED; PG8_LDA(At, 0, 0); PG8_STAGE(PG8_SA(1, 1), a1 + hstep, voffA);
            PG8_WAIT_V(8); PG8_WAIT_L(0); PG8_BAR; PG8_MMA(0, 0, At, B0); PG8_MMA(0, 1, At, B1); PG8_BAR; PG8_SCHED;
            PG8_LDA(At, 0, 1); PG8_STAGE(PG8_SB(0, 0), b2, voffB); PG8_STAGE(PG8_SB(0, 1), b2 + hstep, voffB); PG8_STAGE(PG8_SA(0, 0), a2, voffA);
            PG8_WAIT_V(8); PG8_WAIT_L(0); PG8_BAR; PG8_MMA(1, 0, At, B0); PG8_MMA(1, 1, At, B1); PG8_BAR; PG8_SCHED;
            PG8_LDB(B0, 1, 0); PG8_LDB(B1, 1, 1); PG8_SCHED; PG8_LDA(At, 1, 0); PG8_STAGE(PG8_SA(0, 1), a2 + hstep, voffA);
            PG8_WAIT_V(8); PG8_WAIT_L(0); PG8_BAR; PG8_MMA(0, 0, At, B0); PG8_MMA(0, 1, At, B1); PG8_BAR; PG8_SCHED;
            PG8_LDA(At, 1, 1); PG8_STAGE(PG8_SB(1, 0), b3, voffB); PG8_STAGE(PG8_SB(1, 1), b3 + hstep, voffB); PG8_STAGE(PG8_SA(1, 0), a3, voffA);
            PG8_WAIT_V(8); PG8_WAIT_L(0); PG8_BAR; PG8_MMA(1, 0, At, B0); PG8_MMA(1, 1, At, B1); PG8_BAR; PG8_SCHED;
            } else {
            PG8_LDB(B0, 0, 0); PG8_SCHED; PG8_LDA(At, 0, 0); PG8_STAGE(PG8_SA(1, 1), a1 + hstep, voffA);
            PG8_WAIT_L(8); PG8_BAR; PG8_WAIT_L(0); PG8_MMA(0, 0, At, B0); PG8_BAR; PG8_SCHED;
            PG8_LDB(B1, 0, 1); PG8_STAGE(PG8_SB(0, 0), b2, voffB);
            PG8_BAR; PG8_WAIT_L(0); PG8_MMA(0, 1, At, B1); PG8_BAR;
            PG8_LDA(At, 0, 1); PG8_STAGE(PG8_SA(0, 0), a2, voffA);
            PG8_BAR; PG8_WAIT_L(0); PG8_MMA(1, 0, At, B0); PG8_BAR; PG8_SCHED;
            PG8_STAGE(PG8_SB(0, 1), b2 + hstep, voffB);
            PG8_WAIT_V(6); PG8_BAR; PG8_MMA(1, 1, At, B1); PG8_BAR;
            PG8_LDB(B0, 1, 0); PG8_SCHED; PG8_LDA(At, 1, 0); PG8_STAGE(PG8_SA(0, 1), a2 + hstep, voffA);
            PG8_WAIT_L(8); PG8_BAR; PG8_WAIT_L(0); PG8_MMA(0, 0, At, B0); PG8_BAR; PG8_SCHED;
            PG8_LDB(B1, 1, 1); PG8_STAGE(PG8_SB(1, 0), b3, voffB);
            PG8_BAR; PG8_WAIT_L(0); PG8_MMA(0, 1, At, B1); PG8_BAR;
            PG8_LDA(At, 1, 1); PG8_STAGE(PG8_SA(1, 0), a3, voffA);
            PG8_BAR; PG8_WAIT_L(0); PG8_MMA(1, 0, At, B0); PG8_BAR; PG8_SCHED;
            PG8_STAGE(PG8_SB(1, 1), b3 + hstep, voffB);
            PG8_WAIT_V(6); PG8_BAR; PG8_MMA(1, 1, At, B1); PG8_BAR;
            }
        }
        if constexpr (ALIGN_EPI) { if (wr == 0) PG8_BAR; }
        if constexpr (!Epi::AFTER_DRAIN) { int fr_ = fr, fq_ = fq; asm volatile("" : "+v"(fr_), "+v"(fq_));
            E(acc, cur, wr, wc, fr_, fq_); S.done(cur); }
        if (!has_next) break;
#pragma unroll
        for (int a = 0; a < 2; ++a)
#pragma unroll
            for (int b = 0; b < 2; ++b)
#pragma unroll
                for (int m = 0; m < 4; ++m)
#pragma unroll
                    for (int n = 0; n < 2; ++n) acc[a][b][m][n] = (f32x4){0.f, 0.f, 0.f, 0.f};
        cur = nxt; cA = nA; cB = nB; ++ui;
        if constexpr (ALIGN_EPI) { if (wr == 1) PG8_BAR; }
    }
    PG8_WAIT_V(0);
    if constexpr (!ALIGN_EPI) { if (wr == 0) PG8_BAR; }
    PG8_BAR;
    if constexpr (Epi::AFTER_DRAIN) { E.fused(acc, cur, wr, wc, fr, fq, lds, wid, lane); S.done(cur); }
#undef PG8_SA
#undef PG8_SB
#undef PG8_STAGE
#undef PG8_LDA
#undef PG8_LDB
#undef PG8_MMA
#undef PG8_WAIT_V
#undef PG8_WAIT_L
#undef PG8_BAR
#undef PG8_SCHED
}
template <class Epi, class Sched, bool ALIGN_EPI = false, bool SP2 = true>
__device__ __forceinline__ void gemm_phase_g(PG8_LAS unsigned char* lds, const Gemm g, const Sched& S, const Epi& E) {
    int tid_ = threadIdx.x; asm volatile("" : "+v"(tid_)); const int tid = tid_, wid = __builtin_amdgcn_readfirstlane(tid >> 6), lane = tid & 63, wr = wid >> 2, wc = wid & 3, fr = lane & 15, fq = lane >> 4;
    const int K = g.K, nt = K / BK, LD = g.ld;
    unsigned voffA[2], voffB[2];
#pragma unroll
    for (int i = 0; i < 2; ++i) { int R, C; stage_rc(tid * 16 + i * 8192, R, C); const int Rb = Epi::PERM ? ((R & ~31) + perm32(R & 31)) : R;
        voffA[i] = (unsigned)(R * LD + C) * 2u; voffB[i] = (unsigned)(Rb * LD + C) * 2u; }
    static_assert(SP2, "gather variant: SP2 loop only");
    unsigned gac[2][2], gan[2][2];
#define PG8_ROWOFF(dst, ui_) do { _Pragma("unroll") for (int i_ = 0; i_ < 2; ++i_) { int R_, C_; stage_rc(tid * 16 + i_ * 8192, R_, C_); \
        _Pragma("unroll") for (int h_ = 0; h_ < 2; ++h_) dst[h_][i_] = (unsigned)S.rtab[(ui_) * 256 + h_ * 128 + R_] * (unsigned)(LD * 2) + (unsigned)C_ * 2u; } } while (0)
    const size_t kstep = (size_t)(BK * 2);
    const size_t hstep = (size_t)HALF * LD * 2;
    const size_t tstep = 2 * hstep;
    const unsigned ldsw = (unsigned)wid * 1024u;
    const int aoff = lds_byte(wr * 64 + fr, fq * 8), boff = lds_byte(wc * 32 + fr, fq * 8);
#define PG8_SA(b, h) (((b) * 2 + (h)) * HTB)
#define PG8_SB(b, h) ((4 + (b) * 2 + (h)) * HTB)
#define PG8_STAGE(bufoff, gbase, voff) do { _Pragma("unroll") for (int _i = 0; _i < 2; ++_i) \
        __builtin_amdgcn_global_load_lds((const unsigned*)((const char*)(gbase) + (voff)[_i]), (PG8_LAS unsigned*)(lds + (bufoff) + ldsw + _i * 8192), 16, 0, 0); } while (0)
#define PG8_LDA(dst, b, h) do { _Pragma("unroll") for (int m = 0; m < 4; ++m) _Pragma("unroll") for (int k = 0; k < 2; ++k) dst[m][k] = *(const PG8_LAS bf16x8*)(lds + PG8_SA(b, h) + aoff + m * 2048 + k * 1024); } while (0)
#define PG8_LDB(dst, b, h) do { _Pragma("unroll") for (int n = 0; n < 2; ++n) _Pragma("unroll") for (int k = 0; k < 2; ++k) dst[n][k] = *(const PG8_LAS bf16x8*)(lds + PG8_SB(b, h) + boff + n * 2048 + k * 1024); } while (0)
#define PG8_MMA(ai, bj, At, Bt) do { __builtin_amdgcn_s_setprio(1); _Pragma("unroll") for (int m = 0; m < 4; ++m) _Pragma("unroll") for (int n = 0; n < 2; ++n) _Pragma("unroll") for (int k = 0; k < 2; ++k) \
        acc[ai][bj][m][n] = __builtin_amdgcn_mfma_f32_16x16x32_bf16(Bt[n][k], At[m][k], acc[ai][bj][m][n], 0, 0, 0); __builtin_amdgcn_s_setprio(0); } while (0)
#define PG8_WAIT_V(n) asm volatile("s_waitcnt vmcnt(" #n ")" ::: "memory")
#define PG8_WAIT_L(n) asm volatile("s_waitcnt lgkmcnt(" #n ")" ::: "memory")
#define PG8_BAR __builtin_amdgcn_s_barrier()
#define PG8_SCHED __builtin_amdgcn_sched_barrier(0)
    Unit cur, nxt; int ui = 0;
    if (!S.next(0, cur)) return;
    f32x4 acc[2][2][4][2];
#pragma unroll
    for (int a = 0; a < 2; ++a)
#pragma unroll
        for (int b = 0; b < 2; ++b)
#pragma unroll
            for (int m = 0; m < 4; ++m)
#pragma unroll
                for (int n = 0; n < 2; ++n) acc[a][b][m][n] = (f32x4){0.f, 0.f, 0.f, 0.f};
    bf16x8 At[4][2], B0[2][2], B1[2][2];
    PG8_ROWOFF(gac, 0);
    const char* cA = (const char*)g.A + (size_t)cur.ko * 2; const char* cB = (const char*)g.Bt + (size_t)cur.pb * tstep + (size_t)cur.ko * 2;
    S.a_ready(cur);
    if constexpr (SP2) {
        PG8_STAGE(PG8_SB(0, 0), cB, voffB); PG8_STAGE(PG8_SB(0, 1), cB + hstep, voffB); PG8_STAGE(PG8_SA(0, 0), cA, gac[0]); PG8_STAGE(PG8_SA(0, 1), cA, gac[1]);
        if (wr == 1) PG8_BAR;
        PG8_WAIT_V(2); PG8_BAR;
        PG8_STAGE(PG8_SB(1, 0), cB + kstep, voffB); PG8_STAGE(PG8_SA(1, 0), cA + kstep, gac[0]); PG8_STAGE(PG8_SB(1, 1), cB + hstep + kstep, voffB);
        PG8_WAIT_V(6); PG8_BAR;
    } else {
        PG8_STAGE(PG8_SB(0, 0), cB, voffB); PG8_STAGE(PG8_SA(0, 0), cA, voffA); PG8_STAGE(PG8_SB(0, 1), cB + hstep, voffB); PG8_STAGE(PG8_SA(0, 1), cA + hstep, voffA);
        if (wr == 1) PG8_BAR;
        PG8_WAIT_V(4); PG8_BAR;
        PG8_STAGE(PG8_SB(1, 0), cB + kstep, voffB); PG8_STAGE(PG8_SA(1, 0), cA + kstep, gac[0]); PG8_STAGE(PG8_SB(1, 1), cB + hstep + kstep, voffB);
        PG8_WAIT_V(6); PG8_BAR;
    }
    for (;;) {
        const bool has_next = S.next(ui + 1, nxt);
        if (has_next) PG8_ROWOFF(gan, ui + 1); else { gan[0][0] = gac[0][0]; gan[0][1] = gac[0][1]; gan[1][0] = gac[1][0]; gan[1][1] = gac[1][1]; }
        const char* nA = has_next ? (const char*)g.A + (size_t)nxt.ko * 2 : cA; const char* nB = has_next ? (const char*)g.Bt + (size_t)nxt.pb * tstep + (size_t)nxt.ko * 2 : cB;
        for (int t = 0; t < nt; t += 2) {
            const bool last = (t == nt - 2);
            const char* a1 = cA + (size_t)(t + 1) * kstep;
            const char* a2 = last ? nA : cA + (size_t)(t + 2) * kstep; const char* b2 = last ? nB : cB + (size_t)(t + 2) * kstep;
            const char* a3 = a2 + kstep; const char* b3 = b2 + kstep;
            const unsigned g2a[2] = {last ? gan[0][0] : gac[0][0], last ? gan[0][1] : gac[0][1]}, g2b[2] = {last ? gan[1][0] : gac[1][0], last ? gan[1][1] : gac[1][1]};
            if (last && has_next) S.a_ready(nxt);
            if constexpr (SP2) {
            PG8_LDB(B0, 0, 0); PG8_LDB(B1, 0, 1); PG8_SCHED; PG8_LDA(At, 0, 0); PG8_STAGE(PG8_SA(1, 1), a1, gac[1]);
            PG8_WAIT_V(8); PG8_WAIT_L(0); PG8_BAR; PG8_MMA(0, 0, At, B0); PG8_MMA(0, 1, At, B1); PG8_BAR; PG8_SCHED;
            PG8_LDA(At, 0, 1); PG8_STAGE(PG8_SB(0, 0), b2, voffB); PG8_STAGE(PG8_SB(0, 1), b2 + hstep, voffB); PG8_STAGE(PG8_SA(0, 0), a2, g2a);
            PG8_WAIT_V(8); PG8_WAIT_L(0); PG8_BAR; PG8_MMA(1, 0, At, B0); PG8_MMA(1, 1, At, B1); PG8_BAR; PG8_SCHED;
            PG8_LDB(B0, 1, 0); PG8_LDB(B1, 1, 1); PG8_SCHED; PG8_LDA(At, 1, 0); PG8_STAGE(PG8_SA(0, 1), a2, g2b);
            PG8_WAIT_V(8); PG8_WAIT_L(0); PG8_BAR; PG8_MMA(0, 0, At, B0); PG8_MMA(0, 1, At, B1); PG8_BAR; PG8_SCHED;
            PG8_LDA(At, 1, 1); PG8_STAGE(PG8_SB(1, 0), b3, voffB); PG8_STAGE(PG8_SB(1, 1), b3 + hstep, voffB); PG8_STAGE(PG8_SA(1, 0), a3, g2a);
            PG8_WAIT_V(8); PG8_WAIT_L(0); PG8_BAR; PG8_MMA(1, 0, At, B0); PG8_MMA(1, 1, At, B1); PG8_BAR; PG8_SCHED;
            } else {
            PG8_LDB(B0, 0, 0); PG8_SCHED; PG8_LDA(At, 0, 0); PG8_STAGE(PG8_SA(1, 1), a1, gac[1]);
            PG8_WAIT_L(8); PG8_BAR; PG8_WAIT_L(0); PG8_MMA(0, 0, At, B0); PG8_BAR; PG8_SCHED;
            PG8_LDB(B1, 0, 1); PG8_STAGE(PG8_SB(0, 0), b2, voffB);
            PG8_BAR; PG8_WAIT_L(0); PG8_MMA(0, 1, At, B1); PG8_BAR;
            PG8_LDA(At, 0, 1); PG8_STAGE(PG8_SA(0, 0), a2, g2a);
            PG8_BAR; PG8_WAIT_L(0); PG8_MMA(1, 0, At, B0); PG8_BAR; PG8_SCHED;
            PG8_STAGE(PG8_SB(0, 1), b2 + hstep, voffB);
            PG8_WAIT_V(6); PG8_BAR; PG8_MMA(1, 1, At, B1); PG8_BAR;
            PG8_LDB(B0, 1, 0); PG8_SCHED; PG8_LDA(At, 1, 0); PG8_STAGE(PG8_SA(0, 1), a2, g2b);
            PG8_WAIT_L(8); PG8_BAR; PG8_WAIT_L(0); PG8_MMA(0, 0, At, B0); PG8_BAR; PG8_SCHED;
            PG8_LDB(B1, 1, 1); PG8_STAGE(PG8_SB(1, 0), b3, voffB);
            PG8_BAR; PG8_WAIT_L(0); PG8_MMA(0, 1, At, B1); PG8_BAR;
            PG8_LDA(At, 1, 1); PG8_STAGE(PG8_SA(1, 0), a3, g2a);
            PG8_BAR; PG8_WAIT_L(0); PG8_MMA(1, 0, At, B0); PG8_BAR; PG8_SCHED;
            PG8_STAGE(PG8_SB(1, 1), b3 + hstep, voffB);
            PG8_WAIT_V(6); PG8_BAR; PG8_MMA(1, 1, At, B1); PG8_BAR;
            }
        }
        if constexpr (ALIGN_EPI) { if (wr == 0) PG8_BAR; }
        if constexpr (!Epi::AFTER_DRAIN) { int fr_ = fr, fq_ = fq; asm volatile("" : "+v"(fr_), "+v"(fq_));
            E(acc, cur, wr, wc, fr_, fq_); S.done(cur); }
        if (!has_next) break;
#pragma unroll
        for (int a = 0; a < 2; ++a)
#pragma unroll
            for (int b = 0; b < 2; ++b)
#pragma unroll
                for (int m = 0; m < 4; ++m)
#pragma unroll
                    for (int n = 0; n < 2; ++n) acc[a][b][m][n] = (f32x4){0.f, 0.f, 0.f, 0.f};
        cur = nxt; cA = nA; cB = nB; ++ui; gac[0][0] = gan[0][0]; gac[0][1] = gan[0][1]; gac[1][0] = gan[1][0]; gac[1][1] = gan[1][1];
        if constexpr (ALIGN_EPI) { if (wr == 1) PG8_BAR; }
    }
    PG8_WAIT_V(0);
    if constexpr (!ALIGN_EPI) { if (wr == 0) PG8_BAR; }
    PG8_BAR;
    if constexpr (Epi::AFTER_DRAIN) { E.fused(acc, cur, wr, wc, fr, fq, lds, wid, lane); S.done(cur); }
#undef PG8_SA
#undef PG8_SB
#undef PG8_STAGE
#undef PG8_LDA
#undef PG8_LDB
#undef PG8_MMA
#undef PG8_WAIT_V
#undef PG8_WAIT_L
#undef PG8_BAR
#undef PG8_SCHED
#undef PG8_ROWOFF
}
}
namespace att {
constexpr int D = 128;
constexpr float THR = 8.f;
constexpr bool WSKIP = false;
constexpr float SCALE = 0.08838834764831845f;
constexpr int NW = 8, QBLK = 32, KVBLK = 64, QB = NW * QBLK;
constexpr int SHM_V = KVBLK * D * 2, SHM_K = KVBLK * D * 2;
constexpr int LDS_BYTES = 2 * SHM_V + 2 * SHM_K + NW * 64 * 4;

using bf16 = __hip_bfloat16;
typedef short bf16x8 __attribute__((ext_vector_type(8)));
typedef short s16x4 __attribute__((ext_vector_type(4)));
typedef float f32x16 __attribute__((ext_vector_type(16)));
typedef float f32x4 __attribute__((ext_vector_type(4)));
typedef unsigned u32x4 __attribute__((ext_vector_type(4)));
template <class A, class Bt> struct same_t { static constexpr bool v = false; };
template <class A> struct same_t<A, A> { static constexpr bool v = true; };

#define KSWZ(row, colB) ((row) * 256 + ((colB) ^ (((row) & 7) << 4)))
#define SBAR() __builtin_amdgcn_sched_barrier(0)
__device__ __forceinline__ int v_st(int k, int c) { const int kk = (k & ~0xC) | ((k & 4) << 1) | ((k & 8) >> 1); return ((kk >> 3) * 4 + (c >> 5)) * 512 + ((kk & 7) * 32 + (c & 31)) * 2; }
__device__ __forceinline__ int v_rd_base(int lane) { return ((lane & 3) << 3) | (((lane >> 2) & 3) << 6) | (((lane >> 4) & 1) << 5) | (((lane >> 5) & 1) << 8); }
constexpr int v_rd_off(int d0, int ks, int half) { return d0 * 512 + ks * 4096 + half * 2048; }
__device__ __forceinline__ int crow(int r, int hi) { return (r & 3) + 8 * (r >> 2) + 4 * hi; }
__device__ __forceinline__ unsigned cvtpk(float lo, float hi) {
    unsigned r; asm volatile("v_cvt_pk_bf16_f32 %0, %1, %2" : "=v"(r) : "v"(lo), "v"(hi)); return r;
}
__device__ __forceinline__ bf16x8 pack8(f32x4 a, f32x4 b) {
    u32x4 w = {cvtpk(a[0], a[1]), cvtpk(a[2], a[3]), cvtpk(b[0], b[1]), cvtpk(b[2], b[3])};
    return *reinterpret_cast<bf16x8*>(&w);
}
template <class T> __device__ __forceinline__ bf16x8 load8(const T* p) {
    if constexpr (same_t<T, float>::v) { return pack8(*(const f32x4*)p, *(const f32x4*)(p + 4)); }
    else { return *reinterpret_cast<const bf16x8*>(p); }
}
__device__ __forceinline__ void mask_tile(f32x16& p0, f32x16& p1, int dq, unsigned W) {
    const float NEG = -__builtin_inff();
#pragma unroll
    for (int r = 0; r < 16; ++r) {
        const int c = (r & 3) + 8 * (r >> 2);
        if ((unsigned)(dq - c) >= W) p0[r] = NEG;
        if ((unsigned)(dq - c - 32) >= W) p1[r] = NEG;
    }
}
__device__ __forceinline__ void partialSM(f32x16& p0, f32x16& p1, float& m_reg, float& mn, float& alpha) {
    float pmax = p0[0]; for (int r = 1; r < 16; ++r) pmax = fmaxf(pmax, p0[r]); for (int r = 0; r < 16; ++r) pmax = fmaxf(pmax, p1[r]);
    { auto rr = __builtin_amdgcn_permlane32_swap(__float_as_uint(pmax), __float_as_uint(pmax), false, false);
      pmax = fmaxf(__uint_as_float(rr[0]), __uint_as_float(rr[1])); }
    constexpr float C2 = 1.4426950408889634f * SCALE;
    if (__builtin_expect(__all((pmax - m_reg) * SCALE <= THR), 1)) { mn = m_reg; alpha = 1.f; }
    else { mn = fmaxf(m_reg, pmax); alpha = __builtin_amdgcn_exp2f((m_reg - mn) * C2); m_reg = mn; }
    const float mnL = -mn * C2;
    for (int r = 0; r < 16; ++r) p0[r] = fmaf(p0[r], C2, mnL); for (int r = 0; r < 16; ++r) p1[r] = fmaf(p1[r], C2, mnL);
    for (int r = 0; r < 16; ++r) p0[r] = __builtin_amdgcn_exp2f(p0[r]);
}
__device__ __forceinline__ void finishSM(f32x16& p0, f32x16& p1, float alpha, float& l_reg, bf16x8& pa0, bf16x8& pa1, bf16x8& pa2, bf16x8& pa3) {
    for (int r = 0; r < 16; ++r) p1[r] = __builtin_amdgcn_exp2f(p1[r]);
    float ps = 0; for (int r = 0; r < 16; ++r) ps += p0[r]; for (int r = 0; r < 16; ++r) ps += p1[r];
    { auto rr = __builtin_amdgcn_permlane32_swap(__float_as_uint(ps), __float_as_uint(ps), false, false);
      ps = __uint_as_float(rr[0]) + __uint_as_float(rr[1]); }
    l_reg = l_reg * alpha + ps;
#define PK4(P, B_, OUT) do { unsigned a0 = cvtpk(P[B_+0], P[B_+1]), a1 = cvtpk(P[B_+2], P[B_+3]);                          \
        unsigned b0 = cvtpk(P[B_+4], P[B_+5]), b1 = cvtpk(P[B_+6], P[B_+7]);                                             \
        auto r0 = __builtin_amdgcn_permlane32_swap(a0, b0, false, false); auto r1 = __builtin_amdgcn_permlane32_swap(a1, b1, false, false); \
        u32x4 w = {r0[0], r1[0], r0[1], r1[1]}; OUT = *reinterpret_cast<bf16x8*>(&w); } while (0)
    PK4(p0, 0, pa0); PK4(p0, 8, pa1); PK4(p1, 0, pa2); PK4(p1, 8, pa3);
#undef PK4
}
template <int KB, bool SK>
__device__ __forceinline__ void qkt(f32x16& p0, f32x16& p1, const char* K_lds, int r32, int hi, const bf16x8* qr, bool act) {
    if (SK && !act) { const float NEG = -__builtin_inff();
#pragma unroll
        for (int r = 0; r < 16; ++r) { p0[r] = NEG; p1[r] = NEG; } return; }
    p0 = f32x16{}; p1 = f32x16{};
    const char* kb[4];
#pragma unroll
    for (int dd = 0; dd < 4; ++dd) kb[dd] = K_lds + KB * SHM_K + KSWZ(r32, (dd * 16 + hi * 8) * 2);
#pragma unroll
    for (int d0 = 0; d0 < 8; ++d0) { const char* a = kb[d0 & 3] + (d0 >> 2) * 128;
        bf16x8 b0 = *reinterpret_cast<const bf16x8*>(a);
        bf16x8 b1 = *reinterpret_cast<const bf16x8*>(a + 32 * 256);
        p0 = __builtin_amdgcn_mfma_f32_32x32x16_bf16(b0, qr[d0], p0, 0, 0, 0);
        p1 = __builtin_amdgcn_mfma_f32_32x32x16_bf16(b1, qr[d0], p1, 0, 0, 0); }
}
template <int VB, bool SK>
__device__ __forceinline__ void pv_tile(f32x16* o, int vb0, bf16x8 pa0, bf16x8 pa1, bf16x8 pa2, bf16x8 pa3, bool act) {
    if (SK && !act) return;
#define TRRD(dst, off) asm volatile("ds_read_b64_tr_b16 %0, %1 offset:%2" : "=&v"(dst) : "v"(vb0), "i"(off) : "memory")
#define PV_D0(d0) do { s16x4 l0, l1, l2, l3, h0, h1, h2, h3; constexpr int b_ = VB * SHM_V + v_rd_off(d0, 0, 0);     \
        TRRD(l0, b_); TRRD(h0, b_ + 2048); TRRD(l1, b_ + 4096); TRRD(h1, b_ + 6144); TRRD(l2, b_ + 8192); TRRD(h2, b_ + 10240); TRRD(l3, b_ + 12288); TRRD(h3, b_ + 14336); \
        asm volatile("s_waitcnt lgkmcnt(0)" ::: "memory"); SBAR();                 \
        o[d0] = __builtin_amdgcn_mfma_f32_32x32x16_bf16(pa0, (bf16x8){l0[0], l0[1], l0[2], l0[3], h0[0], h0[1], h0[2], h0[3]}, o[d0], 0, 0, 0);   \
        o[d0] = __builtin_amdgcn_mfma_f32_32x32x16_bf16(pa1, (bf16x8){l1[0], l1[1], l1[2], l1[3], h1[0], h1[1], h1[2], h1[3]}, o[d0], 0, 0, 0);   \
        o[d0] = __builtin_amdgcn_mfma_f32_32x32x16_bf16(pa2, (bf16x8){l2[0], l2[1], l2[2], l2[3], h2[0], h2[1], h2[2], h2[3]}, o[d0], 0, 0, 0);   \
        o[d0] = __builtin_amdgcn_mfma_f32_32x32x16_bf16(pa3, (bf16x8){l3[0], l3[1], l3[2], l3[3], h3[0], h3[1], h3[2], h3[3]}, o[d0], 0, 0, 0); } while (0)
    PV_D0(0); PV_D0(1); PV_D0(2); PV_D0(3);
#undef PV_D0
#undef TRRD
}

template <class TIn, class TOut> struct BlockRef { const TIn* Q; const TIn* K; const TIn* V; TOut* O; int P0; };
template <class TIn> struct Seam {
    bf16x8 qr[8];
    bf16x8 st_v0, st_v1, st_k0, st_k1; f32x4 sf0, sf1, sf2, sf3;
    f32x4 tq[16];
};
__device__ __forceinline__ int swa_jlo(int P0, int W) { const int lowk = P0 - W + 1; return lowk > 0 ? lowk / KVBLK : 0; }
#define ROW(p, k0, rr) ((p) + (size_t)(k0) * KVP + (unsigned)((rr) * KVP + sc))
#define VMW() asm volatile("s_waitcnt vmcnt(0)" ::: "memory")
#define VMWN(n) asm volatile("s_waitcnt vmcnt(%0)" :: "i"(n) : "memory")
#define SLOAD_H(Kp, Vp, k0) do { S.st_v0 = load8<TIn>(ROW(Vp, k0, sr)); S.st_v1 = load8<TIn>(ROW(Vp, k0, 32 + sr));              \
                         S.st_k0 = load8<TIn>(ROW(Kp, k0, sr)); S.st_k1 = load8<TIn>(ROW(Kp, k0, 32 + sr)); } while (0)
#define SWRITE_HK(bf) do { *(bf16x8*)(K_lds + (bf) * SHM_K + kws) = S.st_k0; *(bf16x8*)(K_lds + (bf) * SHM_K + kws + 32 * 256) = S.st_k1; } while (0)
#define SWRITE_HV(bf) do { *(bf16x8*)(V_lds + (bf) * SHM_V + vst0) = S.st_v0; *(bf16x8*)(V_lds + (bf) * SHM_V + vst1) = S.st_v1; } while (0)
#define SWRITE_H(bf) do { SWRITE_HV(bf); SWRITE_HK(bf); } while (0)
#define SLOAD_F(p, k0) do { S.sf0 = *(const f32x4*)ROW(p, k0, sr); S.sf1 = *(const f32x4*)(ROW(p, k0, sr) + 4);                \
                            S.sf2 = *(const f32x4*)ROW(p, k0, 32 + sr); S.sf3 = *(const f32x4*)(ROW(p, k0, 32 + sr) + 4); } while (0)
#define SWRITE_KF(bf) do { *(bf16x8*)(K_lds + (bf) * SHM_K + kws) = pack8(S.sf0, S.sf1); *(bf16x8*)(K_lds + (bf) * SHM_K + kws + 32 * 256) = pack8(S.sf2, S.sf3); } while (0)
#define SWRITE_VF(bf) do { *(bf16x8*)(V_lds + (bf) * SHM_V + vst0) = pack8(S.sf0, S.sf1); *(bf16x8*)(V_lds + (bf) * SHM_V + vst1) = pack8(S.sf2, S.sf3); } while (0)
template <class TIn, class TOut, int QP, int KVP, int OPI>
__device__ __forceinline__ void causal_swa_prime(const BlockRef<TIn, TOut>& cur, int W, char* lds, Seam<TIn>& S) {
    constexpr bool F32 = same_t<TIn, float>::v;
    int tid_ = threadIdx.x; asm volatile("" : "+v"(tid_)); const int tid = tid_, wid = __builtin_amdgcn_readfirstlane(tid >> 6), lane = tid & 63, r32 = lane & 31, hi = lane >> 5;
    const int sr = tid >> 4, sc = (tid & 15) * 8, kws = KSWZ(sr, sc * 2); char* K_lds = lds + 2 * SHM_V;
    const int kb0 = swa_jlo(cur.P0, W) * KVBLK;
    for (int d0 = 0; d0 < 8; ++d0) S.qr[d0] = load8<TIn>(cur.Q + (unsigned)((wid * QBLK + r32) * QP + d0 * 16 + hi * 8));
    if constexpr (F32) { SLOAD_F((const float*)cur.K, kb0); VMW(); SWRITE_KF(0); SBAR(); SLOAD_F((const float*)cur.V, kb0); }
    else { SLOAD_H(cur.K, cur.V, kb0); VMW(); SWRITE_HK(0); }
    __syncthreads();
}
template <class TIn, class TOut, int QP, int KVP, int OPI>
__device__ __forceinline__ void causal_swa_block(const BlockRef<TIn, TOut>& cur, const BlockRef<TIn, TOut>& nxt, int skv, int W, char* lds, Seam<TIn>& S) {
    constexpr bool F32 = same_t<TIn, float>::v;
    int tid_ = threadIdx.x; asm volatile("" : "+v"(tid_)); const int tid = tid_, wid = __builtin_amdgcn_readfirstlane(tid >> 6), lane = tid & 63, r32 = lane & 31, hi = lane >> 5;
    const int j_lo = swa_jlo(cur.P0, W);
    int j_hi = (cur.P0 + QB - 1) / KVBLK + 1; if (j_hi > skv / KVBLK) j_hi = skv / KVBLK;
    const int NT = j_hi - j_lo;
    const int kbn = swa_jlo(nxt.P0, W) * KVBLK;
    const int qlo = cur.P0 + wid * QBLK, qm = qlo + r32 - 4 * hi;
    char* V_lds = lds; char* K_lds = lds + 2 * SHM_V;
    float* ws = (float*)(lds + 2 * SHM_V + 2 * SHM_K) + wid * 64; float* li_l = ws, * al_l = ws + 32;
    float m_reg = -1e30f, l_reg = 0; f32x16 o[4] = {};
    const int sr = tid >> 4, sc = (tid & 15) * 8, vst0 = v_st(sr, sc), vst1 = v_st(32 + sr, sc), kws = KSWZ(sr, sc * 2);
    const int vb0 = (int)(uintptr_t)V_lds + v_rd_base(lane);
    const TIn* Kh = cur.K; const TIn* Vh = cur.V;
#define RESC(a) do { if (__any((a) < 1.f)) { if (hi == 0) al_l[r32] = (a); asm volatile("s_waitcnt lgkmcnt(0)" ::: "memory");              \
                     for (int d_ = 0; d_ < 4; ++d_) for (int r = 0; r < 16; ++r) o[d_][r] *= al_l[crow(r, hi)]; } } while (0)
#define KBASE(t) ((j_lo + (t)) * KVBLK)
#define ACT(t) (KBASE(t) <= qlo + QBLK - 1 && KBASE(t) + KVBLK - 1 >= qlo - W + 1)
#define MASKT(P0_, P1_, t) do { const int kb_ = KBASE(t); if ((!SK || ACT(t)) && (kb_ + KVBLK - 1 > qlo || kb_ <= qlo + QBLK - 1 - W)) mask_tile(P0_, P1_, qm - kb_, (unsigned)W); } while (0)
    constexpr int NQL = F32 ? 16 : 8;
    constexpr bool SK = WSKIP && !F32;
#define SEAM_K0() do { VMWN(NQL); if constexpr (F32) { SWRITE_KF(0); SBAR(); SLOAD_F((const float*)nxt.V, kbn); } else { SWRITE_HK(0); } SBAR(); } while (0)
    f32x16 pA0, pA1, pB0, pB1; float mnA, mnB, alA, alB; bf16x8 pa0, pa1, pa2, pa3;
    if constexpr (F32) { VMW(); SWRITE_VF(0); SBAR(); } else { SWRITE_HV(0); SBAR(); }
    if (NT > 1) { if constexpr (F32) SLOAD_F((const float*)Kh, KBASE(1)); else SLOAD_H(Kh, Vh, KBASE(1)); }
    SBAR(); qkt<0, SK>(pA0, pA1, K_lds, r32, hi, S.qr, ACT(0));
    if constexpr (F32) { if (NT > 1) { VMW(); SWRITE_KF(1); SBAR(); SLOAD_F((const float*)Vh, KBASE(1)); } }
    MASKT(pA0, pA1, 0); partialSM(pA0, pA1, m_reg, mnA, alA);
    if (NT > 1) { VMW(); if constexpr (F32) { SWRITE_VF(1); SBAR(); if (NT > 2) SLOAD_F((const float*)Kh, KBASE(2)); } else SWRITE_H(1); }
    __syncthreads();
#define HALF_STEP(PX0, PX1, mnX, alX, PY0, PY1, alY, t, KB, VB, SB) do {                                                      \
        SBAR(); qkt<KB, SK>(PX0, PX1, K_lds, r32, hi, S.qr, ACT(t));                                             \
        finishSM(PY0, PY1, alY, l_reg, pa0, pa1, pa2, pa3); SBAR();                                                           \
        if ((t) + 1 < NT) { if constexpr (F32) { VMW(); SWRITE_KF(SB); SBAR(); SLOAD_F((const float*)Vh, KBASE((t) + 1)); }  \
                            else { SLOAD_H(Kh, Vh, KBASE((t) + 1)); } SBAR(); }                                               \
        pv_tile<VB, SK>(o, vb0, pa0, pa1, pa2, pa3, ACT((t) - 1)); MASKT(PX0, PX1, (t)); partialSM(PX0, PX1, m_reg, mnX, alX);                                        \
        __syncthreads();                                                                                                      \
        if ((t) + 1 < NT) { VMW(); if constexpr (F32) { SWRITE_VF(SB); SBAR(); if ((t) + 2 < NT) SLOAD_F((const float*)Kh, KBASE((t) + 2)); } \
                            else { SWRITE_H(SB); } }                                                                          \
        RESC(alX); __syncthreads(); } while (0)
    for (int t = 1; t + 1 < NT; t += 2) {
        HALF_STEP(pB0, pB1, mnB, alB, pA0, pA1, alA, t, 1, 0, 0);
        HALF_STEP(pA0, pA1, mnA, alA, pB0, pB1, alB, t + 1, 0, 1, 1);
    }
    const bool even = (NT & 1) == 0;
    if (even) { SBAR(); qkt<1, SK>(pB0, pB1, K_lds, r32, hi, S.qr, ACT(NT - 1)); SBAR(); }
#define QROW(e) (nxt.Q + (size_t)(wid * QBLK + r32) * QP + ((e) >> 1) * 16 + hi * 8 + ((e) & 1) * 4)
    if constexpr (F32) { SLOAD_F((const float*)nxt.K, kbn); SBAR();
#pragma unroll
        for (int e = 0; e < 8; ++e) S.tq[e] = *(const f32x4*)QROW(e); }
    else { SLOAD_H(nxt.K, nxt.V, kbn); SBAR();
#pragma unroll
        for (int d0 = 0; d0 < 8; ++d0) S.qr[d0] = load8<TIn>(nxt.Q + (unsigned)((wid * QBLK + r32) * QP + d0 * 16 + hi * 8)); }
    SBAR();
    finishSM(pA0, pA1, alA, l_reg, pa0, pa1, pa2, pa3); SBAR();
    if constexpr (F32) {
#pragma unroll
        for (int e = 8; e < 16; ++e) S.tq[e] = *(const f32x4*)QROW(e); SBAR(); }
#undef QROW
    pv_tile<0, SK>(o, vb0, pa0, pa1, pa2, pa3, ACT(even ? NT - 2 : NT - 1));
    if (even) { MASKT(pB0, pB1, NT - 1); partialSM(pB0, pB1, m_reg, mnB, alB); __syncthreads(); RESC(alB);
        finishSM(pB0, pB1, alB, l_reg, pa0, pa1, pa2, pa3); SBAR(); pv_tile<1, SK>(o, vb0, pa0, pa1, pa2, pa3, ACT(NT - 1)); }
    SBAR(); SEAM_K0();
    if (hi == 0) li_l[r32] = l_reg; asm volatile("s_waitcnt lgkmcnt(0)" ::: "memory");
    float rli[16];
#pragma unroll
    for (int r = 0; r < 16; ++r) rli[r] = __builtin_amdgcn_rcpf(li_l[crow(r, hi)]);
    TOut* Ow = cur.O + (unsigned)((wid * QBLK) * OPI);
#pragma unroll
    for (int r = 0; r < 16; ++r) { const int orow = crow(r, hi);
#pragma unroll
        for (int d0 = 0; d0 < 4; ++d0) { const float v = o[d0][r] * rli[r];
            if constexpr (same_t<TOut, float>::v) { Ow[(size_t)orow * OPI + d0 * 32 + r32] = v; }
            else { const float vn = __shfl_xor(v, 1);
                   if ((r32 & 1) == 0) *(unsigned*)(Ow + (unsigned)(orow * OPI + d0 * 32 + r32)) = cvtpk(v, vn); } } }
    if constexpr (F32) {
#pragma unroll
        for (int d0 = 0; d0 < 8; ++d0) S.qr[d0] = pack8(S.tq[2 * d0], S.tq[2 * d0 + 1]); }
    __syncthreads();
#undef RESC
#undef KBASE
#undef ACT
#undef MASKT
#undef SEAM_K0
#undef HALF_STEP
}
#undef ROW
#undef VMW
#undef VMWN
#undef SLOAD_H
#undef SWRITE_HK
#undef SWRITE_HV
#undef SWRITE_H
#undef SLOAD_F
#undef SWRITE_KF
#undef SWRITE_VF

}

#ifndef ATT_SATMODE
#define ATT_SATMODE 1
#endif
#if ATT_SATMODE
#define ATT_CL(x) (x)
#else
#define ATT_CL(x) fminf((x), 448.f)
#endif
#ifndef ATT_STATPRIO
#define ATT_STATPRIO 0
#endif
#ifndef ATT_PSH
#define ATT_PSH 1.0f
#endif
#ifndef ATT_TAU
#define ATT_TAU 3.0f
#endif
#ifndef ATT_SCHED
#define ATT_SCHED { _Pragma("unroll") for (int sg_ = 0; sg_ < 6; ++sg_) { __builtin_amdgcn_sched_group_barrier(0x008, 1, 0); __builtin_amdgcn_sched_group_barrier(0x402, ATT_VPM, 0); } }
#endif
#ifndef ATT_VPM
#define ATT_VPM 10
#endif
namespace att2 {
using att::bf16; using att::bf16x8; using att::s16x4; using att::f32x16; using att::f32x4; using att::u32x4;
constexpr float SCALE = 0.08838834764831845f;
constexpr int MX3_OFF = 132096  , AL3_OFF = MX3_OFF + 2048, LI3_OFF = AL3_OFF + 1024;
constexpr int V7_OFF = 0  , K7_OFF = 32768  , PB7_OFF = 49152  ;
template <int OPI>
__device__ __forceinline__ void diff_block7(const unsigned char* Q8, const unsigned char* K8, const unsigned char* VT8, bf16* O, int P0, char* lds) {
    typedef int v4i_ __attribute__((ext_vector_type(4))); typedef int v8i_ __attribute__((ext_vector_type(8)));
    typedef __attribute__((address_space(1))) unsigned char gcu8_; typedef __attribute__((address_space(1))) v4i_ gv4i_;
    int tid_ = threadIdx.x; asm volatile("" : "+v"(tid_));
    const int tid = tid_, wid = __builtin_amdgcn_readfirstlane(tid >> 6), lane = tid & 63, r32 = lane & 31, hi = lane >> 5;
    const int pr = wid & 3, role = wid >> 2;
    const int NT = P0 / 64 + 2;
    char* V_lds = lds + V7_OFF; char* K_lds = lds + K7_OFF; char* pb_l = lds + PB7_OFF;
    float* mx_l = (float*)(lds + MX3_OFF); float* al_l = (float*)(lds + AL3_OFF) + wid * 32; float* li_l = (float*)(lds + LI3_OFF);
    const int kkey = role * 32 + r32, ksw = (kkey >> 1) & 7;
    const char* kbase = K_lds + kkey * 128;
    const int skey = tid >> 3, sch = tid & 7, kws8 = skey * 128 + ((sch ^ ((skey >> 1) & 7)) << 4);
    const int svr = tid >> 2, sg0 = (tid & 3) * 4;
    int vws[4];
#pragma unroll
    for (int e = 0; e < 4; ++e) { const int g = sg0 + e, d = (g & 1) * 8 + 4 * (g >> 3) + ((g & 7) >> 1); vws[e] = svr * 64 + ((((d >> 2) ^ ((svr >> 2) & 3)) << 2) | (d & 3)) * 4; }
    const int vrow = role * 128 + r32, vsw = (vrow >> 2) & 3;
    const char* vbase = V_lds + vrow * 64;
    const int vc0 = ((2 * hi) ^ vsw) << 4, vc1 = ((2 * hi + 1) ^ vsw) << 4;
    const int qpos = P0 + pr * 32 + r32, qlo = P0 + pr * 32;
    constexpr float C2 = 1.4426950408889634f * SCALE;
    v8i_ qr8[2];
#pragma unroll
    for (int c = 0; c < 2; ++c) { const unsigned char* qp = Q8 + (unsigned)((pr * 32 + r32) * 2048 + 64 * c + 32 * hi);
        qr8[c] = __builtin_shufflevector(*(const v4i_*)qp, *(const v4i_*)(qp + 16), 0, 1, 2, 3, 4, 5, 6, 7); }
    typedef __attribute__((address_space(3))) unsigned las_u32_;
    const int dk_key = wid * 8 + (lane >> 3);
    unsigned dk_off = (unsigned)(dk_key * 2048 + (((lane & 7) ^ ((dk_key >> 1) & 7)) << 4));
    const int dv_r0 = wid * 32 + (lane >> 2), dv_r1 = dv_r0 + 16;
    unsigned dv_off0 = (unsigned)(dv_r0 * 16384 + (((lane & 3) ^ ((dv_r0 >> 2) & 3)) << 4)), dv_off1 = (unsigned)(dv_r1 * 16384 + (((lane & 3) ^ ((dv_r1 >> 2) & 3)) << 4));
    asm volatile("" : "+v"(dk_off), "+v"(dv_off0), "+v"(dv_off1));
#define DMAK(bf, k0) do { const gcu8_* kp_ = (const gcu8_*)K8 + (size_t)(k0) * 2048; asm volatile("" : "+s"(kp_)); \
        __builtin_amdgcn_global_load_lds((const __attribute__((address_space(1))) unsigned*)(kp_ + dk_off), (las_u32_*)(K_lds + (bf) * 8192 + wid * 1024), 16, 0, 0); } while (0)
#define DMAV(bf, k0) do { const gcu8_* vp_ = (const gcu8_*)VT8 + (k0); asm volatile("" : "+s"(vp_)); \
        __builtin_amdgcn_global_load_lds((const __attribute__((address_space(1))) unsigned*)(vp_ + dv_off0), (las_u32_*)(V_lds + (bf) * 16384 + wid * 2048), 16, 0, 0); \
        __builtin_amdgcn_global_load_lds((const __attribute__((address_space(1))) unsigned*)(vp_ + dv_off1), (las_u32_*)(V_lds + (bf) * 16384 + wid * 2048 + 1024), 16, 0, 0); } while (0)
#define VMW() asm volatile("s_waitcnt vmcnt(0)" ::: "memory")
#define QKM(dst, BUF) do { dst = (f32x16){}; \
        _Pragma("unroll") for (int c = 0; c < 2; ++c) { const char* kp2_ = kbase + (BUF) * 8192; \
            const v8i_ kf = __builtin_shufflevector(*(const v4i_*)(kp2_ + (((4 * c + 2 * hi) ^ ksw) << 4)), *(const v4i_*)(kp2_ + (((4 * c + 2 * hi + 1) ^ ksw) << 4)), 0, 1, 2, 3, 4, 5, 6, 7); \
            dst = __builtin_amdgcn_mfma_scale_f32_32x32x64_f8f6f4(kf, qr8[c], dst, 0, 0, 0, 0x7F7F7F7F, 0, 0x7F7F7F7F); } } while (0)
#define MASK(p, t) \
        { const int kb_ = (t) * 64 + role * 32; if (kb_ + 31 > qlo) { const int dq = qpos - kb_ - 4 * hi; const float NEG = -__builtin_inff(); \
            _Pragma("unroll") for (int r = 0; r < 16; ++r) { const int c = (r & 3) + 8 * (r >> 2); if (c > dq) p[r] = NEG; } } }
#define MX3(a, b, c) fmaxf(fmaxf((a), (b)), (c))
#define PMAX(p) \
        float pmax = fmaxf(MX3(MX3(p[0], p[1], p[2]), MX3(p[3], p[4], p[5]), MX3(p[6], p[7], p[8])), MX3(MX3(p[9], p[10], p[11]), MX3(p[12], p[13], p[14]), p[15])); \
        { auto rr_ = __builtin_amdgcn_permlane32_swap(__float_as_uint(pmax), __float_as_uint(pmax), false, false); pmax = MX3(__uint_as_float(rr_[0]), __uint_as_float(rr_[1]), -3.0e38f); }
#define SOFTPUB(p, SL) \
        { p = p * C2 + mnL;                                                \
          _Pragma("unroll") for (int r = 0; r < 16; ++r) p[r] = __builtin_amdgcn_exp2f(p[r]); \
          l4 += ((f32x4){p[0], p[1], p[2], p[3]} + (f32x4){p[4], p[5], p[6], p[7]}) + ((f32x4){p[8], p[9], p[10], p[11]} + (f32x4){p[12], p[13], p[14], p[15]}); }     \
        { _Pragma("unroll") for (int q4 = 0; q4 < 4; ++q4) ownw[q4] = (int)pg8::pk_fp8x4o(ATT_CL(p[4 * q4]), ATT_CL(p[4 * q4 + 1]), ATT_CL(p[4 * q4 + 2]), ATT_CL(p[4 * q4 + 3]), ownw[q4]); mx_own = pmax; \
          *(v4i_*)(pb_l + (SL) * 8192 + wid * 1024 + lane * 16) = ownw; } \
        if (hi == 0) mx_l[(SL) * 256 + wid * 32 + r32] = pmax;
#define PVLOAD(VB, SL) \
        const v4i_ h0 = *(const v4i_*)(pb_l + (SL) * 8192 + (wid & 3) * 1024 + lane * 16), h1 = *(const v4i_*)(pb_l + (SL) * 8192 + ((wid & 3) + 4) * 1024 + lane * 16); \
        v8i_ vf[4]; _Pragma("unroll") for (int d0 = 0; d0 < 4; ++d0) { const char* vp3_ = vbase + (VB) * 16384 + d0 * 2048; \
            vf[d0] = __builtin_shufflevector(*(const v4i_*)(vp3_ + vc0), *(const v4i_*)(vp3_ + vc1), 0, 1, 2, 3, 4, 5, 6, 7); }
#define PVMMA(SCA) do { const v8i_ pa = __builtin_shufflevector(h0, h1, 0, 1, 2, 3, 4, 5, 6, 7); \
        _Pragma("unroll") for (int d0 = 0; d0 < 4; ++d0) o[d0] = __builtin_amdgcn_mfma_scale_f32_32x32x64_f8f6f4(pa, vf[d0], o[d0], 0, 0, 0, (SCA), 0, 0x7F7F7F7F); } while (0)
#define PVT(VB, SL) do { PVLOAD(VB, SL) PVMMA(0x7F7F7F7F); } while (0)
    float ref = 0.f, mnL = 0.f, mx_own = 0.f;
    f32x4 l4 = {0.f, 0.f, 0.f, 0.f}; f32x16 o[4] = {};
    f32x16 pA, pB;
    v4i_ ownw = {0, 0, 0, 0};
    DMAK(0, 0); DMAK(1, 64); DMAV(0, 0);
    VMW();
    __syncthreads();
    QKM(pA, 0); QKM(pB, 1);
    MASK(pA, 0) MASK(pB, 1)
    { PMAX(pA)
      if (hi == 0) mx_l[256 + wid * 32 + r32] = pmax;
      __syncthreads();
 ref = __builtin_ceilf(fmaxf(pmax, mx_l[256 + (wid ^ 4) * 32 + r32]) * C2); mnL = ATT_PSH - ref;
      if (2 < NT) DMAK(0, 128);
      SOFTPUB(pA, 0)
      VMW();
      __syncthreads(); }
#define SEG(BUF, t, cur, nxt) do { \
        if ((t) + 2 < NT) DMAK(BUF, ((t) + 2) * 64);                        \
        DMAV(BUF, (t) * 64); \
        const float pm2 = mx_l[((BUF) ^ 1) * 256 + (wid ^ 4) * 32 + r32]; \
        PVLOAD((BUF) ^ 1, (BUF) ^ 1) \
        int sca = 0x7F7F7F7F; \
        { const float mc2 = fmaxf(mx_own, pm2) * C2;                         \
          const bool up_ = mc2 - ref > ATT_TAU;                              \
          if (__any(up_)) { const float rn = up_ ? __builtin_ceilf(mc2) : ref; const float dl = ref - rn; const float alpha = __builtin_amdgcn_exp2f(dl); ref = rn; mnL = ATT_PSH - rn; l4 = l4 * alpha; \
              sca = (127 + (int)dl) * 0x01010101; \
              if (hi == 0) al_l[r32] = alpha; asm volatile("s_waitcnt lgkmcnt(0)" ::: "memory"); \
              _Pragma("unroll") for (int d_ = 0; d_ < 4; ++d_) _Pragma("unroll") for (int r = 0; r < 16; ++r) o[d_][r] *= al_l[att::crow(r, hi)]; } } \
        QKM(nxt, (BUF) ^ 1);                                                \
        PVMMA(sca); \
        { PMAX(cur) \
          SOFTPUB(cur, BUF) } \
        ATT_SCHED \
        if ((t) + 1 < NT) MASK(nxt, (t) + 1) \
        VMW(); \
        __syncthreads(); \
    } while (0)
    SEG(1, 1, pB, pA);
    for (int t = 2; t < NT; t += 2) { SEG(0, t, pA, pB); SEG(1, t + 1, pB, pA); }
    PVT(1, 1);
    float l_reg = (l4[0] + l4[1]) + (l4[2] + l4[3]);
    { auto rr = __builtin_amdgcn_permlane32_swap(__float_as_uint(l_reg), __float_as_uint(l_reg), false, false); l_reg = __uint_as_float(rr[0]) + __uint_as_float(rr[1]); }
    if (hi == 0) li_l[wid * 32 + r32] = l_reg;
    __syncthreads();
    { const float lt = (l_reg + li_l[(wid ^ 4) * 32 + r32]) * 4.0f; if (hi == 0) al_l[r32] = lt; asm volatile("s_waitcnt lgkmcnt(0)" ::: "memory"); }
    float rli[16];
#pragma unroll
    for (int r = 0; r < 16; ++r) rli[r] = __builtin_amdgcn_rcpf(al_l[att::crow(r, hi)]);
    bf16* Ow = O + (unsigned)((pr * 32) * OPI + role * 128);
#pragma unroll
    for (int r = 0; r < 16; ++r) { const int orow = att::crow(r, hi);
#pragma unroll
        for (int d0 = 0; d0 < 4; ++d0) { const float v = o[d0][r] * rli[r]; const float vn = __shfl_xor(v, 1);
            if ((r32 & 1) == 0) *(unsigned*)(Ow + (unsigned)(orow * OPI + d0 * 32 + r32)) = att::cvtpk(v, vn); } }
    __syncthreads();
#undef SEG
#undef PVT
#undef PVMMA
#undef PVLOAD
#undef SOFTPUB
#undef QKM
#undef MASK
#undef PMAX
#undef MX3
#undef VMW
#undef DMAV
#undef DMAK
}
}

constexpr int T = 32768, DM = 2048, SEQ = 16384, INW = 5120, NMEMT = 512, RMAX = 73728;
constexpr int NWAVES = 8;
constexpr float ALPHA = 1.4142135623730951f;
constexpr float LN_EPS = 1e-5f;
constexpr size_t MiB = 1u << 20;
constexpr size_t WS_CTL = 0, CTL_ZERO_BYTES = 1 * MiB;
constexpr size_t WS_CSN = 1 * MiB, WS_LOG = 5 * MiB;
constexpr size_t WS_TOKE = 13 * MiB, WS_TOKW = WS_TOKE + 256 * 1024, WS_TOKD = WS_TOKW + 256 * 1024, WS_WGC = WS_TOKD + 256 * 1024;
constexpr size_t WS_ROWW = 14 * MiB, WS_TILE = WS_ROWW + 512 * 1024, WS_ROWT = WS_TILE + 64 * 1024;
constexpr size_t WS_RS = 15 * MiB, WS_CSQ = 15 * MiB + 512 * 1024;
constexpr size_t WS_MEMB = 16 * MiB, WS_KV = 18 * MiB, WS_VTM = 19 * MiB;
constexpr size_t WS_WIN = 20 * MiB, WS_WOUT = 60 * MiB, WS_XQ = 76 * MiB, WS_XO = 80 * MiB, WS_MEMKV = 84 * MiB, WS_ROUT = 88 * MiB, WS_W13 = 90 * MiB, WS_W2 = 346 * MiB;
constexpr size_t WS_XA = 474 * MiB, WS_XB = 602 * MiB, WS_H = 730 * MiB, WS_QK8 = 1050 * MiB, WS_VT8 = 1114 * MiB, WS_END = 1146 * MiB;
constexpr size_t DO_MIX = 0, DO_OP = 128 * MiB, DO_QC = 0, DO_OC = 32 * MiB, DO_HB = 0;
constexpr int CW_BAR = 4096, CW_HO = 16384;
constexpr int RING_BYTES = 131072;
constexpr int LDSCTL_OFF = RING_BYTES, MISC_OFF = LDSCTL_OFF + 320, SCR_OFF = LDSCTL_OFF + 1024;
constexpr int LDS_BYTES = 147456;

#define GAS __attribute__((address_space(1)))
#define LAS __attribute__((address_space(3)))
typedef unsigned short bf16;
typedef unsigned v4u __attribute__((ext_vector_type(4)));
typedef unsigned v2u __attribute__((ext_vector_type(2)));
typedef float f32x4 __attribute__((ext_vector_type(4)));
typedef float f32x2 __attribute__((ext_vector_type(2)));
typedef float f32x16 __attribute__((ext_vector_type(16)));
typedef short bf16x8 __attribute__((ext_vector_type(8)));
typedef GAS unsigned gu32;
typedef GAS unsigned long long gu64;
#define RLX_AGENT __ATOMIC_RELAXED, __HIP_MEMORY_SCOPE_AGENT
#define LDS_WAIT() asm volatile("s_waitcnt lgkmcnt(0)" ::: "memory")
#define VM_WAIT() asm volatile("s_waitcnt vmcnt(0)" ::: "memory")
__device__ __forceinline__ unsigned f2bf(float f) { unsigned u = __builtin_bit_cast(unsigned, f); return (u + 0x7fffu + ((u >> 16) & 1u)) >> 16; }
__device__ __forceinline__ unsigned pk2(float lo, float hi) { return f2bf(lo) | (f2bf(hi) << 16); }
__device__ __forceinline__ float bflo(unsigned w) { return __uint_as_float(w << 16); }
__device__ __forceinline__ float bfhi(unsigned w) { return __uint_as_float(w & 0xffff0000u); }

#define XB_TMO      128
#define XB_XCNT(j)  (256  + 64 * (j))
#define XB_XSUB(j)  (1280 + 64 * (j))
#define XB_XGEN(j)  (2304 + 64 * (j))
#define XB_TOP      3328
#define XB_TOPGEN   3392
#define XCD_BAR_WORDS 3456
#define XB_SPIN_CAP (1u << 20)

__device__ __forceinline__ unsigned xb_ld(unsigned* p)              { return __hip_atomic_load(p, __ATOMIC_RELAXED, __HIP_MEMORY_SCOPE_AGENT); }
__device__ __forceinline__ unsigned xb_add(unsigned* p, unsigned v) { return __hip_atomic_fetch_add(p, v, __ATOMIC_RELAXED, __HIP_MEMORY_SCOPE_AGENT); }
__device__ __forceinline__ unsigned xb_xcc_id() { return (unsigned)__builtin_amdgcn_s_getreg((3 << 11) | 20) & 0xFu; }
#define XB_SPIN(cond, bar) do { unsigned _sp = 0; while (cond) { __builtin_amdgcn_s_sleep(1); \
    if ((++_sp & 255u) == 0u) { if (xb_ld(&(bar)[XB_TMO])) break; if (_sp > XB_SPIN_CAP) { atomicAdd(&(bar)[XB_TMO], 1u); break; } } } } while (0)

struct XcdBarrier { unsigned* bar; unsigned x; volatile LAS unsigned* st; };
__device__ __forceinline__ XcdBarrier xcd_barrier_post(unsigned* bar, volatile LAS unsigned* st) {
    XcdBarrier b; b.bar = bar; b.x = xb_xcc_id(); b.st = st;
    if (threadIdx.x == 0) (void)xb_add(&bar[XB_XCNT(b.x)], 1u);
    return b;
}
__device__ __forceinline__ void xcd_barrier_complete(unsigned* bar, unsigned x, unsigned& nloc, unsigned& nx) {
    const unsigned G = gridDim.x * gridDim.y * gridDim.z;
    unsigned sum, cnt, mine, sp = 0u;
    for (;;) {
        sum = 0u; cnt = 0u; mine = 0u;
#pragma unroll
        for (unsigned j = 0; j < 16; ++j) { const unsigned c = xb_ld(&bar[XB_XCNT(j)]); sum += c; cnt += (c > 0u) ? 1u : 0u; mine = (j == x) ? c : mine; }
        if (sum == G) break;
        __builtin_amdgcn_s_sleep(1);
        if ((++sp & 255u) == 0u) { if (xb_ld(&bar[XB_TMO])) break; if (sp > XB_SPIN_CAP) { atomicAdd(&bar[XB_TMO], 1u); break; } }
    }
    nloc = mine > 0u ? mine : 1u; nx = cnt > 0u ? cnt : 1u;
}
__device__ __forceinline__ void xcd_barrier(const XcdBarrier& b) {
    asm volatile("s_waitcnt vmcnt(0)" ::: "memory");
    __syncthreads();
    if (threadIdx.x == 0) {
        unsigned* bar = b.bar;
        __builtin_amdgcn_s_waitcnt(0);
        unsigned nloc = b.st[0], nx = b.st[1];
        if (nloc == 0u) { xcd_barrier_complete(bar, b.x, nloc, nx); b.st[0] = nloc; b.st[1] = nx; }
        const unsigned old = xb_add(&bar[XB_XSUB(b.x)], 1u);
        const unsigned gen = old / nloc;
        if (old + 1u == (gen + 1u) * nloc) {
            __builtin_amdgcn_fence(__ATOMIC_RELEASE, "agent");
            asm volatile("s_waitcnt vmcnt(0)" ::: "memory");
            const unsigned og = xb_add(&bar[XB_TOP], 1u);
            const unsigned tg = og / nx;
            if (og + 1u == (tg + 1u) * nx) xb_add(&bar[XB_TOPGEN], 1u);
            else XB_SPIN(xb_ld(&bar[XB_TOPGEN]) == tg, bar);
            __builtin_amdgcn_fence(__ATOMIC_ACQUIRE, "agent");
            xb_add(&bar[XB_XGEN(b.x)], 1u);
            asm volatile("s_waitcnt vmcnt(0)" ::: "memory");
        } else {
            XB_SPIN(xb_ld(&bar[XB_XGEN(b.x)]) == gen, bar);
            __builtin_amdgcn_fence(__ATOMIC_ACQUIRE, "agent");
            asm volatile("s_waitcnt vmcnt(0)" ::: "memory");
        }
    }
    __syncthreads();
}

struct Args { const void* in[35]; unsigned char* out; unsigned char* ws; int ph_lo, ph_hi; };
struct Frame {
    LAS unsigned char* lds; volatile LAS unsigned* MISC;
    int tid, lane, wave, G, bx;
};
constexpr int TAB_OFF = LDSCTL_OFF + 512;
__device__ __forceinline__ unsigned char* tabp(const Frame& F, int k) {
    const volatile LAS unsigned* t = (const volatile LAS unsigned*)(F.lds + TAB_OFF) + 2 * k;
    const unsigned lo = __builtin_amdgcn_readfirstlane(t[0]), hi = __builtin_amdgcn_readfirstlane(t[1]);
    return (unsigned char*)((GAS unsigned char*)(((unsigned long long)hi << 32) | lo));
}
#define INP(k) ((const float*)tabp(F, (k)))
#define INPI(k) ((const int*)tabp(F, (k)))
#define WSP() (tabp(F, 36))
#define OUTP() (tabp(F, 35))
__device__ __forceinline__ void refresh(Frame& F) {
    int t = F.tid; asm volatile("" : "+v"(t)); F.tid = t; F.lane = t & 63; F.wave = __builtin_amdgcn_readfirstlane(t >> 6);
    int g = F.G, b = F.bx; asm volatile("" : "+s"(g), "+s"(b)); F.G = g; F.bx = b;
}
__device__ __forceinline__ float wave_sum(float v) {
#pragma unroll
    for (int o = 1; o < 64; o <<= 1) v += __shfl_xor(v, o);
    return v;
}
__constant__ double INVF_REV[16] = {0.15915494309189535, 0.0700865215877985, 0.03086376340470123, 0.013591370636193905, 0.005985185712713705, 0.002635675898667414,
    0.001160663641240061, 0.0005111175045375439, 0.00022507907903927653, 9.911730936901935e-05, 4.364795279280289e-05, 1.9221100684944863e-05,
    8.464330808241401e-06, 3.727408601915352e-06, 1.6414262627950345e-06, 7.228293068832865e-07};

struct TDesc { const float* src; bf16* dst; int N, K; const float* gs; };
__device__ __forceinline__ TDesc tr_decode(const Frame& F, unsigned char* ws, int it) {
    int r = it; const float* W; bf16* WT; int K, N, nblk, q; int mode = 0; const float* gs = nullptr;
    if (r < 5120) { const int l = r / 2560; q = r % 2560; W = INP(3) + (size_t)l * 2048 * 5120; K = 2048; N = 5120; nblk = 80; WT = (bf16*)(ws + WS_WIN) + (size_t)l * 5120 * 2048; if (l == 0) mode = 4; }
    else if ((r -= 5120) < 2048) { const int l = r / 1024; q = r % 1024; W = INP(4) + (size_t)l * 2048 * 2048; K = 2048; N = 2048; nblk = 32; WT = (bf16*)(ws + WS_WOUT) + (size_t)l * 2048 * 2048; }
    else if ((r -= 2048) < 512) { const int l = r / 256; q = r % 256; W = INP(26) + (size_t)l * 2048 * 512; K = 2048; N = 512; nblk = 8; WT = (bf16*)(ws + WS_XQ) + (size_t)l * 512 * 2048; gs = INP(5) + l * 2048; }
    else if ((r -= 512) < 512) { const int l = r / 256; q = r % 256; W = INP(27) + (size_t)l * 512 * 2048; K = 512; N = 2048; nblk = 32; WT = (bf16*)(ws + WS_XO) + (size_t)l * 2048 * 512; }
    else if ((r -= 512) < 512) { q = r; W = INP(25); K = 2048; N = 1024; nblk = 16; WT = (bf16*)(ws + WS_MEMKV); }
    else if ((r -= 512) < 16384) { const int le = r / 256; q = r % 256; W = INP(32) + (size_t)le * 2048 * 512; K = 2048; N = 512; nblk = 8; WT = (bf16*)(ws + WS_W13) + (size_t)le * 1024 * 2048; mode = 1; }
    else if ((r -= 16384) < 16384) { const int le = r / 256; q = r % 256; W = INP(33) + (size_t)le * 2048 * 512; K = 2048; N = 512; nblk = 8; WT = (bf16*)(ws + WS_W13) + (size_t)le * 1024 * 2048; mode = 2; }
    else { r -= 16384; const int le = r / 256; q = r % 256; W = INP(34) + (size_t)le * 512 * 2048; K = 512; N = 2048; nblk = 32; WT = (bf16*)(ws + WS_W2) + (size_t)le * 2048 * 512; }
    const int kb = q / nblk, nb = q % nblk, n0 = 64 * nb, k0 = 64 * kb;
    int drow = n0; if (mode == 1 || mode == 2) drow = (n0 >> 7) * 256 + (n0 & 127) + (mode == 2 ? 128 : 0);
    if (mode == 4) { mode = 0;
        if (n0 >= 4096) { const int cc = n0 - 4096; drow = 3072 + (cc >> 7) * 256 + 128 + (cc & 127); } else if (n0 >= 3072) { const int cc = n0 - 3072; drow = 3072 + (cc >> 7) * 256 + (cc & 127); } }
    TDesc d; d.src = W + (size_t)k0 * N + n0 + F.lane; d.dst = WT + (size_t)drow * K + k0; d.N = N; d.K = K; d.gs = gs ? gs + k0 : nullptr; return d;
}
#define TR_LOAD(d, wv) do { _Pragma("unroll") for (int i_ = 0; i_ < 64; ++i_) wv[i_] = __builtin_nontemporal_load((d).src + (size_t)i_ * (d).N); } while (0)
#define TR_STORE(d, wv) do { \
        if ((d).gs) { _Pragma("unroll") for (int i_ = 0; i_ < 64; ++i_) wv[i_] *= (d).gs[i_]; } \
        _Pragma("unroll") for (int i_ = 0; i_ < 32; ++i_) scr[F.lane * 33 + i_] = pk2(wv[2 * i_], wv[2 * i_ + 1]); \
        LDS_WAIT(); asm volatile("" ::: "memory"); \
        { const int c_ = F.lane & 7; \
          _Pragma("unroll") for (int j_ = 0; j_ < 8; ++j_) { const int n_ = (F.lane >> 3) + 8 * j_; const LAS unsigned* s_ = scr + n_ * 33 + 4 * c_; \
              v4u o_; o_.x = s_[0]; o_.y = s_[1]; o_.z = s_[2]; o_.w = s_[3]; \
              __builtin_nontemporal_store(o_, (v4u*)((d).dst + (size_t)n_ * (d).K + 8 * c_)); } } \
        LDS_WAIT(); asm volatile("" ::: "memory"); } while (0)
__device__ __forceinline__ void p_prologue(Frame& F, int dummy_) {
    unsigned char* ws = WSP();
    LAS unsigned* scr = (LAS unsigned*)(F.lds + F.wave * 16384);
    const int gw = F.bx * NWAVES + F.wave, NGW = F.G * NWAVES;
    constexpr int NITEMS = 5120 + 2048 + 512 + 512 + 512 + 16384 * 3;
    if (gw < NITEMS) {
        int it = gw; TDesc da = tr_decode(F, ws, it), db = da; float A[64], B[64]; TR_LOAD(da, A);
        for (;;) {
            const int itb = it + NGW; const bool hb = itb < NITEMS;
            if (hb) { db = tr_decode(F, ws, itb); TR_LOAD(db, B); }
            TR_STORE(da, A);
            if (!hb) break;
            const int ita = itb + NGW; const bool ha = ita < NITEMS;
            if (ha) { da = tr_decode(F, ws, ita); TR_LOAD(da, A); }
            TR_STORE(db, B);
            if (!ha) break;
            it = ita;
        }
    }
    const int gt = F.bx * 512 + F.tid, NT = F.G * 512;
    { bf16* RO = (bf16*)(ws + WS_ROUT); const float* rg = INP(28); const float* re = INP(30);
      for (int i = gt; i < 2 * 256 * 2048; i += NT) { const int l = i >> 19, n = (i >> 11) & 255, k = i & 2047;
          float v = 0.f; if (n < 4) v = rg[(size_t)l * 2048 * 4 + k * 4 + n]; else if (n < 36) v = re[(size_t)l * 2048 * 32 + k * 32 + (n - 4)];
          RO[i] = (bf16)f2bf(v); } }
    { const f32x4* x = (const f32x4*)INP(0); v4u* xa = (v4u*)(ws + WS_XA);
      for (int i0 = gt; i0 < T * DM / 8; i0 += 4 * NT) { f32x4 p[4], q[4];
#pragma unroll
          for (int u = 0; u < 4; ++u) { const int i = i0 + u * NT; if (i < T * DM / 8) { p[u] = __builtin_nontemporal_load(x + 2 * (size_t)i); q[u] = __builtin_nontemporal_load(x + 2 * (size_t)i + 1); } }
#pragma unroll
          for (int u = 0; u < 4; ++u) { const int i = i0 + u * NT; if (i < T * DM / 8) { v4u o; o.x = pk2(p[u][0], p[u][1]); o.y = pk2(p[u][2], p[u][3]); o.z = pk2(q[u][0], q[u][1]); o.w = pk2(q[u][2], q[u][3]); __builtin_nontemporal_store(o, xa + i); } } }
      const f32x4* m = (const f32x4*)INP(1); v4u* mb = (v4u*)(ws + WS_MEMB);
      for (int i = gt; i < NMEMT * DM / 8; i += NT) { const f32x4 p = m[2 * (size_t)i], q = m[2 * (size_t)i + 1]; v4u o; o.x = pk2(p[0], p[1]); o.y = pk2(p[2], p[3]); o.z = pk2(q[0], q[1]); o.w = pk2(q[2], q[3]); mb[i] = o; } }
    { const float* wq = INP(26); const float* g1 = INP(5); const float* b1 = INP(6); float* csq = (float*)(ws + WS_CSQ); LAS float* red = (LAS float*)(F.lds + SCR_OFF);
      for (int blk = F.bx; blk < 256; blk += F.G) { const int l = blk >> 7, n0 = (blk & 127) * 4, c = F.tid & 3, ks = F.tid >> 2;
          float s = 0.f, q = 0.f;
#pragma unroll
          for (int i = 0; i < 16; ++i) { const int k = ks * 16 + i; const float w = wq[((size_t)l * 2048 + k) * 512 + n0 + c]; s += __uint_as_float(f2bf(g1[l * 2048 + k] * w) << 16); q += b1[l * 2048 + k] * w; }
#pragma unroll
          for (int o = 4; o < 64; o <<= 1) { s += __shfl_xor(s, o); q += __shfl_xor(q, o); }
          __syncthreads();
          if (F.lane < 4) { red[F.wave * 8 + F.lane * 2] = s; red[F.wave * 8 + F.lane * 2 + 1] = q; }
          __syncthreads();
          if (F.tid < 8) { float a = 0.f;
#pragma unroll
              for (int w8 = 0; w8 < 8; ++w8) a += red[w8 * 8 + F.tid];
              csq[l * 1024 + (F.tid & 1) * 512 + n0 + (F.tid >> 1)] = a; } } }
    { const int* pos = INPI(2); float* csn = (float*)(ws + WS_CSN);
      for (int i = gt; i < T * 16; i += NT) { const int row = i >> 4, j = i & 15; double rev = (double)pos[row] * INVF_REV[j]; rev -= __builtin_rint(rev); const float f = (float)rev;
          csn[row * 32 + j] = __builtin_amdgcn_cosf(f); csn[row * 32 + 16 + j] = __builtin_amdgcn_sinf(f); } }
}

typedef att::BlockRef<att::bf16, att::bf16> ABlk;
#define DIFFBLK diff_block3
__device__ __forceinline__ void p_diff_attn2(Frame& F, char* lds, const bf16* H, bf16* OP) {
#if ATT_SATMODE
    __builtin_amdgcn_s_setreg((0 << 11) | (23 << 6) | 1, 1);
#endif
#if ATT_STATPRIO
    if (F.wave >= 4) __builtin_amdgcn_s_setprio(1);
#endif
    for (int L = F.bx; L < 1024; L += F.G) {
        const int c = L & 255, i = L >> 8, x = c & 7, k = c >> 3, combo = 2 * x + (i >> 1), b = combo >> 3, h = (combo >> 1) & 3, m = combo & 1, j = (i & 1) * 32 + k;
        const size_t row0 = (size_t)b * SEQ;
        for (int pass = 0; pass < 2; ++pass) { const int qb = pass ? 127 - j : j;
            const unsigned char* QK8 = WSP() + WS_QK8; const unsigned char* VT8 = WSP() + WS_VT8;
            att2::diff_block7<2048>(QK8 + (row0 + (size_t)qb * 128) * 2048 + (2 * h + m) * 128, QK8 + row0 * 2048 + 1024 + (2 * h + m) * 128,
                VT8 + ((size_t)b * 1024 + h * 256) * 16384, (att::bf16*)(OP + (row0 + (size_t)qb * 128) * 2048 + m * 1024 + h * 256), qb * 128, lds); }
    }
#if ATT_STATPRIO
    __builtin_amdgcn_s_setprio(0);
#endif
#if ATT_SATMODE
    __builtin_amdgcn_s_setreg((0 << 11) | (23 << 6) | 1, 0);
#endif
}
__device__ __forceinline__ ABlk cross_ref(const bf16* QC, const bf16* KV, bf16* OC, int L) {
    const int b = L >> 8, head = (L >> 6) & 3, qb = L & 63;
    ABlk r; const size_t row0 = (size_t)b * SEQ + (size_t)qb * 256;
    r.Q = (const att::bf16*)(QC + row0 * 512 + head * 128);
    r.K = (const att::bf16*)(KV + (size_t)b * 256 * 1024 + head * 128);
    r.V = (const att::bf16*)(KV + (size_t)b * 256 * 1024 + 512 + head * 128);
    r.O = (att::bf16*)(OC + row0 * 512 + head * 128);
    r.P0 = 1 << 20; return r;
}
__device__ __forceinline__ void p_cross_attn(Frame& F, char* lds, const bf16* QC, const bf16* KV, bf16* OC) {
    const int nblk = (512 - F.bx + F.G - 1) / F.G;
    if (nblk <= 0) return;
    att::Seam<att::bf16> S;
    ABlk cur = cross_ref(QC, KV, OC, F.bx);
    att::causal_swa_prime<att::bf16, att::bf16, 512, 1024, 512>(cur, 1 << 30, lds, S);
    for (int n = 0;; ++n) {
        const bool last = (n + 1 >= nblk);
        const ABlk nxt = last ? cur : cross_ref(QC, KV, OC, F.bx + (n + 1) * F.G);
        att::causal_swa_block<att::bf16, att::bf16, 512, 1024, 512>(cur, nxt, 256, 1 << 30, lds, S);
        if (last) break;
        cur = nxt;
    }
}

__device__ __forceinline__ void p_cross_attn2(Frame& F, char* lds, const bf16* QC, const bf16* KV, const bf16* VTM, bf16* OC) {
    typedef float f32x16_ __attribute__((ext_vector_type(16)));
    const int tid = F.tid, lane = F.lane, wid = F.wave, r32 = lane & 31, hi = lane >> 5;
    char* Kl = lds; char* Vl = lds + 65536;
    constexpr float C2 = 1.4426950408889634f * 0.08838834764831845f;
    for (int it = F.bx; it < 256; it += F.G) {
        const int bh = it >> 5, b = bh >> 2, head = bh & 3;
        __syncthreads();
        for (int i = tid; i < 4096; i += 512) { const int key = i >> 4, c = i & 15;
            const v4u x = *(const v4u*)(KV + ((size_t)(b * 256 + key)) * 1024 + head * 128 + c * 8);
            *(v4u*)(Kl + key * 256 + ((c ^ (key & 15)) << 4)) = x; }
        for (int i = tid; i < 2048; i += 512) { const int v = i >> 4, sg = i & 15; const bf16* src = VTM + (size_t)(head * 128 + v) * 512 + b * 256 + sg * 16;
            const v4u A = *(const v4u*)src, B = *(const v4u*)(src + 8);
            *(v4u*)(Vl + v * 512 + (((2 * sg) ^ (v & 31)) << 4)) = (v4u){A.x, A.y, B.x, B.y};
            *(v4u*)(Vl + v * 512 + (((2 * sg + 1) ^ (v & 31)) << 4)) = (v4u){A.z, A.w, B.z, B.w}; }
        __syncthreads();
        for (int qq = 0; qq < 2; ++qq) {
            const size_t row0 = (size_t)b * SEQ + (size_t)((it & 31) * 2 + qq) * 256 + wid * 32;
            bf16x8 qf[8];
#pragma unroll
            for (int ks = 0; ks < 8; ++ks) qf[ks] = *(const bf16x8*)(QC + (row0 + r32) * 512 + head * 128 + ks * 16 + hi * 8);
            f32x16_ o[4] = {}; float m = -3.0e38f, l = 0.f;
#pragma unroll
            for (int hf = 0; hf < 2; ++hf) {
                f32x16_ s[4];
#pragma unroll
                for (int kq = 0; kq < 4; ++kq) { s[kq] = (f32x16_){}; const int krow = (hf * 4 + kq) * 32 + r32;
#pragma unroll
                    for (int ks = 0; ks < 8; ++ks) { const bf16x8 kf = *(const bf16x8*)(Kl + krow * 256 + (((2 * ks + hi) ^ (krow & 15)) << 4));
                        s[kq] = __builtin_amdgcn_mfma_f32_32x32x16_bf16(kf, qf[ks], s[kq], 0, 0, 0); } }
                float mh = s[0][0];
#pragma unroll
                for (int kq = 0; kq < 4; ++kq)
#pragma unroll
                    for (int r = 0; r < 16; ++r) mh = fmaxf(mh, s[kq][r]);
                { auto rr = __builtin_amdgcn_permlane32_swap(__float_as_uint(mh), __float_as_uint(mh), false, false); mh = fmaxf(__uint_as_float(rr[0]), __uint_as_float(rr[1])); }
                const float mn = fmaxf(m, mh);
                if (hf == 1) { const float al = __builtin_amdgcn_exp2f((m - mn) * C2); l *= al;
#pragma unroll
                    for (int vb = 0; vb < 4; ++vb) o[vb] = o[vb] * al; }
                m = mn; const float mo = -m * C2; float lh = 0.f;
#pragma unroll
                for (int kq = 0; kq < 4; ++kq)
#pragma unroll
                    for (int r = 0; r < 16; ++r) { const float e = __builtin_amdgcn_exp2f(s[kq][r] * C2 + mo); s[kq][r] = e; lh += e; }
                { auto rr = __builtin_amdgcn_permlane32_swap(__float_as_uint(lh), __float_as_uint(lh), false, false); lh = __uint_as_float(rr[0]) + __uint_as_float(rr[1]); }
                l += lh;
#pragma unroll
                for (int kq = 0; kq < 4; ++kq)
#pragma unroll
                    for (int u = 0; u < 2; ++u) { v4u pw; pw.x = pg8::cvt_pk_bf16(s[kq][8 * u], s[kq][8 * u + 1]); pw.y = pg8::cvt_pk_bf16(s[kq][8 * u + 2], s[kq][8 * u + 3]);
                        pw.z = pg8::cvt_pk_bf16(s[kq][8 * u + 4], s[kq][8 * u + 5]); pw.w = pg8::cvt_pk_bf16(s[kq][8 * u + 6], s[kq][8 * u + 7]);
                        const bf16x8 pb = __builtin_bit_cast(bf16x8, pw);
#pragma unroll
                        for (int vb = 0; vb < 4; ++vb) { const int vrow = vb * 32 + r32;
                            const bf16x8 vf = *(const bf16x8*)(Vl + vrow * 512 + (((2 * (2 * (hf * 4 + kq) + u) + hi) ^ (vrow & 31)) << 4));
                            o[vb] = __builtin_amdgcn_mfma_f32_32x32x16_bf16(vf, pb, o[vb], 0, 0, 0); } }
            }
            const float rl = __builtin_amdgcn_rcpf(l);
            bf16* op = OC + (row0 + r32) * 512 + head * 128 + 4 * hi;
#pragma unroll
            for (int vb = 0; vb < 4; ++vb)
#pragma unroll
                for (int g = 0; g < 4; ++g) { v2u w; w.x = pg8::cvt_pk_bf16(o[vb][4 * g] * rl, o[vb][4 * g + 1] * rl); w.y = pg8::cvt_pk_bf16(o[vb][4 * g + 2] * rl, o[vb][4 * g + 3] * rl);
                    *(v2u*)(op + 32 * vb + 8 * g) = w; }
        }
    }
    __syncthreads();
}

__device__ __forceinline__ void p_combine(Frame& F, int dummy_, const bf16* OP, bf16* MIX) {
    const float* lq1 = INP(11); const float* lk1 = INP(12); const float* lq2 = INP(13); const float* lk2 = INP(14);
    const float* sg = INP(15);
    const int l = F.lane;
    const float d1 = wave_sum(lq1[l] * lk1[l] + lq1[l + 64] * lk1[l + 64]), d2 = wave_sum(lq2[l] * lk2[l] + lq2[l + 64] * lk2[l + 64]);
    const float lam = __expf(d1) - __expf(d2) + 0.2f;
    const int h = l >> 4, d0 = (l & 15) * 16;
    float g[16];
#pragma unroll
    for (int j = 0; j < 16; ++j) g[j] = sg[d0 + j] * 0.8f;
    const int gw = F.bx * NWAVES + F.wave, NGW = F.G * NWAVES;
    for (int row = gw; row < T; row += NGW) {
        const v4u* p1 = (const v4u*)(OP + (size_t)row * 2048 + h * 256 + d0); const v4u* p2 = (const v4u*)(OP + (size_t)row * 2048 + 1024 + h * 256 + d0);
        const v4u a0 = __builtin_nontemporal_load(p1), a1 = __builtin_nontemporal_load(p1 + 1), b0 = __builtin_nontemporal_load(p2), b1 = __builtin_nontemporal_load(p2 + 1);
        float o[16];
        o[0] = bflo(a0.x) - lam * bflo(b0.x); o[1] = bfhi(a0.x) - lam * bfhi(b0.x); o[2] = bflo(a0.y) - lam * bflo(b0.y); o[3] = bfhi(a0.y) - lam * bfhi(b0.y);
        o[4] = bflo(a0.z) - lam * bflo(b0.z); o[5] = bfhi(a0.z) - lam * bfhi(b0.z); o[6] = bflo(a0.w) - lam * bflo(b0.w); o[7] = bfhi(a0.w) - lam * bfhi(b0.w);
        o[8] = bflo(a1.x) - lam * bflo(b1.x); o[9] = bfhi(a1.x) - lam * bfhi(b1.x); o[10] = bflo(a1.y) - lam * bflo(b1.y); o[11] = bfhi(a1.y) - lam * bfhi(b1.y);
        o[12] = bflo(a1.z) - lam * bflo(b1.z); o[13] = bfhi(a1.z) - lam * bfhi(b1.z); o[14] = bflo(a1.w) - lam * bflo(b1.w); o[15] = bfhi(a1.w) - lam * bfhi(b1.w);
        float ss = 0.f;
#pragma unroll
        for (int j = 0; j < 16; ++j) ss += o[j] * o[j];
        ss += __shfl_xor(ss, 1); ss += __shfl_xor(ss, 2); ss += __shfl_xor(ss, 4); ss += __shfl_xor(ss, 8);
        const float rs = 1.0f / sqrtf(ss * (1.0f / 256.0f) + LN_EPS);
        v4u w0, w1;
        w0.x = pk2(o[0] * rs * g[0], o[1] * rs * g[1]); w0.y = pk2(o[2] * rs * g[2], o[3] * rs * g[3]); w0.z = pk2(o[4] * rs * g[4], o[5] * rs * g[5]); w0.w = pk2(o[6] * rs * g[6], o[7] * rs * g[7]);
        w1.x = pk2(o[8] * rs * g[8], o[9] * rs * g[9]); w1.y = pk2(o[10] * rs * g[10], o[11] * rs * g[11]); w1.z = pk2(o[12] * rs * g[12], o[13] * rs * g[13]); w1.w = pk2(o[14] * rs * g[14], o[15] * rs * g[15]);
        v4u* q = (v4u*)(MIX + (size_t)row * 2048 + h * 256 + d0); q[0] = w0; q[1] = w1;
    }
}

constexpr int CW_WQ = 8192;
__device__ __forceinline__ int wq_next(Frame& F, int k) {
    LAS int* slot = (LAS int*)(F.lds + SCR_OFF + 8192);
    __syncthreads();
    if (F.tid == 0) *slot = (int)__hip_atomic_fetch_add((unsigned*)(WSP() + WS_CTL) + CW_WQ + 64 * k, 1u, __ATOMIC_RELAXED, __HIP_MEMORY_SCOPE_AGENT);
    __syncthreads();
    return *slot;
}
template <int R> __device__ __forceinline__ void conv_rows(f32x2 (&acc)[32], const f32x2 (&w)[31], const LAS unsigned* ctt) {
    if constexpr (R < 62) {
        const unsigned p = ctt[R * 512]; const f32x2 val = (f32x2){bflo(p), bfhi(p)};
#pragma unroll
        for (int j = 0; j < 31; ++j) { if (R - j >= 0 && R - j < 32) acc[(R - j) & 31] = w[j] * val + acc[(R - j) & 31]; }
        conv_rows<R + 1>(acc, w, ctt);
    }
}
__device__ __forceinline__ void p_conformer(Frame& F, int dummy_, const bf16* H, bf16* MIX) {
    const float* cw = INP(16); const float* cb = INP(17); const float* cg = INP(18); const float* cbeta = INP(19);
    LAS unsigned* ct = (LAS unsigned*)F.lds;
    LAS float* red = (LAS float*)(F.lds + SCR_OFF);
    LAS float* stat = (LAS float*)(F.lds + SCR_OFF + 1024);
    const int tid = F.tid;
    f32x2 w[31];
#pragma unroll
    for (int j = 0; j < 31; ++j) w[j] = *(const f32x2*)(cw + j * 1024 + 2 * tid);
    const f32x2 bb = *(const f32x2*)(cb + 2 * tid), gg = *(const f32x2*)(cg + 2 * tid), be = *(const f32x2*)(cbeta + 2 * tid);
    for (;;) {
        const int item = wq_next(F, 0); if (item >= T / 32) break;
        const int t0 = item * 32, tl0 = t0 & (SEQ - 1);
        { const int cgp = tid & 127, rq = tid >> 7;
#pragma unroll 4
          for (int r = rq; r < 64; r += 4) { const int tl = tl0 - 30 + r; v4u o = (v4u){0u, 0u, 0u, 0u};
              if (r < 62 && tl >= 0) o = *(const v4u*)(H + (size_t)(t0 - 30 + r) * INW + 3072 + cgp * 8);
              if (r < 62) *(LAS v4u*)(ct + r * 512 + cgp * 4) = o; } }
        __syncthreads();
        f32x2 acc[32];
#pragma unroll
        for (int t = 0; t < 32; ++t) acc[t] = bb;
        conv_rows<0>(acc, w, ct + tid);
#pragma unroll
        for (int t = 0; t < 32; ++t) { const float s = wave_sum(acc[t].x + acc[t].y); if (F.lane == 0) red[F.wave * 32 + t] = s; }
        __syncthreads();
        if (tid < 32) { float s = 0.f;
#pragma unroll
            for (int k = 0; k < 8; ++k) s += red[k * 32 + tid]; stat[tid] = s * (1.0f / 1024.0f); }
        __syncthreads();
#pragma unroll
        for (int t = 0; t < 32; ++t) { const float mu = stat[t]; acc[t] = acc[t] - mu; }
        __syncthreads();
#pragma unroll
        for (int t = 0; t < 32; ++t) { const float s = wave_sum(acc[t].x * acc[t].x + acc[t].y * acc[t].y); if (F.lane == 0) red[F.wave * 32 + t] = s; }
        __syncthreads();
        if (tid < 32) { float s = 0.f;
#pragma unroll
            for (int k = 0; k < 8; ++k) s += red[k * 32 + tid]; stat[tid] = 1.0f / sqrtf(s * (1.0f / 1024.0f) + LN_EPS); }
        __syncthreads();
#pragma unroll
        for (int t = 0; t < 32; ++t) { const float rs = stat[t]; const float y0 = acc[t].x * rs * gg.x + be.x, y1 = acc[t].y * rs * gg.y + be.y;
            const float s0 = y0 * __builtin_amdgcn_rcpf(1.f + __expf(-y0)), s1 = y1 * __builtin_amdgcn_rcpf(1.f + __expf(-y1));
            *(unsigned*)(MIX + (size_t)(t0 + t) * 2048 + 1024 + 2 * tid) = pk2(s0, s1); }
    }
    __syncthreads();
}

__device__ __forceinline__ void p_sgu(Frame& F, int dummy_, const bf16* H, bf16* MIX) {
    const float* lg = INP(20); const float* lb = INP(21); const float* sw = INP(22); const float* sb = INP(23);
    constexpr int VP = 136;
    constexpr int OPP = 264;
    LAS bf16* vgt = (LAS bf16*)F.lds;
    LAS bf16* wl = (LAS bf16*)(F.lds + 256 * VP * 2);
    LAS float* st = (LAS float*)(F.lds + 256 * VP * 2 + 128 * VP * 2);
    const int tid = F.tid, lane = F.lane, wid = F.wave;
    const int wt = tid >> 2, wsq = tid & 3;
    const int s2 = tid & 63, cq = tid >> 6;
    const int c8 = (tid & 31) * 8, tq = tid >> 5;
    for (int chunk = F.bx; chunk < T / 128; chunk += F.G) {
        const size_t r0 = (size_t)chunk * 128;
        __syncthreads();
        f32x4 wp[8]; v4u za[4], zb[4];
#define SGU_LOADG(g_) do { const float* wp_ = sw + ((size_t)(g_) * 128 + wt) * 128 + wsq * 32; _Pragma("unroll") for (int k = 0; k < 8; ++k) wp[k] = *(const f32x4*)(wp_ + 4 * k); \
            const bf16* zp_ = H + (r0 + 2 * s2) * INW + 1024 + (g_) * 256 + cq * 32; _Pragma("unroll") for (int k = 0; k < 4; ++k) { za[k] = *(const v4u*)(zp_ + 8 * k); zb[k] = *(const v4u*)(zp_ + INW + 8 * k); } } while (0)
        SGU_LOADG(0);
        for (int r8 = 0; r8 < 16; r8 += 8) { v4u z0[8], z1[8];
#pragma unroll
          for (int i = 0; i < 8; ++i) { const bf16* zp = H + (r0 + wid * 16 + r8 + i) * INW + 1024 + lane * 8; z0[i] = *(const v4u*)zp; z1[i] = *(const v4u*)(zp + 512); }
#pragma unroll
          for (int i = 0; i < 8; ++i) {
              float v[16] = {bflo(z0[i].x), bfhi(z0[i].x), bflo(z0[i].y), bfhi(z0[i].y), bflo(z0[i].z), bfhi(z0[i].z), bflo(z0[i].w), bfhi(z0[i].w), bflo(z1[i].x), bfhi(z1[i].x), bflo(z1[i].y), bfhi(z1[i].y), bflo(z1[i].z), bfhi(z1[i].z), bflo(z1[i].w), bfhi(z1[i].w)};
              float sm = 0.f;
#pragma unroll
              for (int j = 0; j < 16; ++j) sm += v[j];
              const float mu = wave_sum(sm) * (1.0f / 1024.0f); float q = 0.f;
#pragma unroll
              for (int j = 0; j < 16; ++j) { const float d = v[j] - mu; q += d * d; }
              const float rs = 1.0f / sqrtf(wave_sum(q) * (1.0f / 1024.0f) + LN_EPS);
              if (lane == 0) { st[2 * (wid * 16 + r8 + i)] = mu; st[2 * (wid * 16 + r8 + i) + 1] = rs; } } }
        for (int g = 0; g < 4; ++g) {
            __syncthreads();
            {
#pragma unroll
              for (int k = 0; k < 4; ++k) { const f32x4 p = wp[2 * k], q = wp[2 * k + 1]; const int s0 = wsq * 32 + 8 * k, t = wt;
                  v4u o; o.x = pk2(s0 + 0 <= t ? p[0] : 0.f, s0 + 1 <= t ? p[1] : 0.f); o.y = pk2(s0 + 2 <= t ? p[2] : 0.f, s0 + 3 <= t ? p[3] : 0.f);
                  o.z = pk2(s0 + 4 <= t ? q[0] : 0.f, s0 + 5 <= t ? q[1] : 0.f); o.w = pk2(s0 + 6 <= t ? q[2] : 0.f, s0 + 7 <= t ? q[3] : 0.f);
                  *(LAS v4u*)(wl + t * VP + s0) = o; } }
            { const float mu0 = st[4 * s2], rs0 = st[4 * s2 + 1], mu1 = st[4 * s2 + 2], rs1 = st[4 * s2 + 3];
#pragma unroll
              for (int k = 0; k < 4; ++k) { const int c0 = cq * 32 + 8 * k; const float* gp = lg + g * 256 + c0; const float* bp = lb + g * 256 + c0;
                  const f32x4 g0 = *(const f32x4*)gp, g1 = *(const f32x4*)(gp + 4), b0 = *(const f32x4*)bp, b1 = *(const f32x4*)(bp + 4);
                  LAS unsigned* vo = (LAS unsigned*)(vgt + c0 * VP + 2 * s2);
#define NRM(zw, half, gv, bv, mu_, rs_) ((half ? bfhi(zw) : bflo(zw)) - mu_) * rs_ * gv + bv
                  vo[0 * (VP / 2)] = pk2(NRM(za[k].x, 0, g0[0], b0[0], mu0, rs0), NRM(zb[k].x, 0, g0[0], b0[0], mu1, rs1));
                  vo[1 * (VP / 2)] = pk2(NRM(za[k].x, 1, g0[1], b0[1], mu0, rs0), NRM(zb[k].x, 1, g0[1], b0[1], mu1, rs1));
                  vo[2 * (VP / 2)] = pk2(NRM(za[k].y, 0, g0[2], b0[2], mu0, rs0), NRM(zb[k].y, 0, g0[2], b0[2], mu1, rs1));
                  vo[3 * (VP / 2)] = pk2(NRM(za[k].y, 1, g0[3], b0[3], mu0, rs0), NRM(zb[k].y, 1, g0[3], b0[3], mu1, rs1));
                  vo[4 * (VP / 2)] = pk2(NRM(za[k].z, 0, g1[0], b1[0], mu0, rs0), NRM(zb[k].z, 0, g1[0], b1[0], mu1, rs1));
                  vo[5 * (VP / 2)] = pk2(NRM(za[k].z, 1, g1[1], b1[1], mu0, rs0), NRM(zb[k].z, 1, g1[1], b1[1], mu1, rs1));
                  vo[6 * (VP / 2)] = pk2(NRM(za[k].w, 0, g1[2], b1[2], mu0, rs0), NRM(zb[k].w, 0, g1[2], b1[2], mu1, rs1));
                  vo[7 * (VP / 2)] = pk2(NRM(za[k].w, 1, g1[3], b1[3], mu0, rs0), NRM(zb[k].w, 1, g1[3], b1[3], mu1, rs1));
#undef NRM
              } }
            if (g + 1 < 4) SGU_LOADG(g + 1);
            __syncthreads();
            const int wr = wid >> 1, wc = wid & 1, r32 = lane & 31, hi = lane >> 5;
            f32x16 acc[4] = {};
            for (int ks = 0; ks < 2 * wr + 2; ++ks) { const bf16x8 af = *(const LAS bf16x8*)(wl + (wr * 32 + r32) * VP + ks * 16 + hi * 8);
#pragma unroll
                for (int cb = 0; cb < 4; ++cb) { const bf16x8 bfr = *(const LAS bf16x8*)(vgt + (wc * 128 + cb * 32 + r32) * VP + ks * 16 + hi * 8);
                    acc[cb] = __builtin_amdgcn_mfma_f32_32x32x16_bf16(af, bfr, acc[cb], 0, 0, 0); } }
            __syncthreads();
            LAS bf16* ot = vgt;
#pragma unroll
            for (int r = 0; r < 16; ++r) { const int t = wr * 32 + (r & 3) + 8 * (r >> 2) + 4 * hi; const float bias = sb[g * 128 + t];
#pragma unroll
                for (int cb = 0; cb < 4; ++cb) ot[t * OPP + wc * 128 + cb * 32 + r32] = (bf16)f2bf(acc[cb][r] + bias); }
            __syncthreads();
#pragma unroll
            for (int k = 0; k < 8; ++k) { const int t = tq + 16 * k; const v4u sv = *(const LAS v4u*)(ot + t * OPP + c8); v4u o; const v4u uk = *(const v4u*)(H + (r0 + t) * INW + g * 256 + c8);
                o.x = pk2(bflo(uk.x) * bflo(sv.x), bfhi(uk.x) * bfhi(sv.x)); o.y = pk2(bflo(uk.y) * bflo(sv.y), bfhi(uk.y) * bfhi(sv.y));
                o.z = pk2(bflo(uk.z) * bflo(sv.z), bfhi(uk.z) * bfhi(sv.z)); o.w = pk2(bflo(uk.w) * bflo(sv.w), bfhi(uk.w) * bfhi(sv.w));
                *(v4u*)(MIX + (r0 + t) * 2048 + g * 256 + c8) = o; }
        }
#undef SGU_LOADG
    }
    __syncthreads();
}
__device__ __forceinline__ void p_sconv(Frame& F, int dummy_, const bf16* H, bf16* MIX) {
    const float* scw = INP(24);
    const int cgp = F.tid & 127, run = F.tid >> 7;
    float w0[8], w1[8], w2[8];
#pragma unroll
    for (int j = 0; j < 8; ++j) { w0[j] = scw[cgp * 8 + j]; w1[j] = scw[1024 + cgp * 8 + j]; w2[j] = scw[2048 + cgp * 8 + j]; }
    for (;;) {
        const int item = wq_next(F, 1); if (item >= T / 64) break;
        const int t0 = item * 64 + run * 16; const int tl0 = t0 & (SEQ - 1);
        float pm2[8], pm1[8];
#pragma unroll
        for (int j = 0; j < 8; ++j) { pm2[j] = 0.f; pm1[j] = 0.f; }
        for (int tt = -2; tt < 16; ++tt) {
            if (tl0 + tt < 0) continue;
            const bf16* hp = H + (size_t)(t0 + tt) * INW + 2048 + cgp * 8;
            const v4u gc = __builtin_nontemporal_load((const v4u*)(hp + 1024)), xi = __builtin_nontemporal_load((const v4u*)(hp + 2048));
            float p[8] = {bflo(gc.x) * bflo(xi.x), bfhi(gc.x) * bfhi(xi.x), bflo(gc.y) * bflo(xi.y), bfhi(gc.y) * bfhi(xi.y), bflo(gc.z) * bflo(xi.z), bfhi(gc.z) * bfhi(xi.z), bflo(gc.w) * bflo(xi.w), bfhi(gc.w) * bfhi(xi.w)};
            if (tt >= 0) { const v4u gb = __builtin_nontemporal_load((const v4u*)hp); const float gbf[8] = {bflo(gb.x), bfhi(gb.x), bflo(gb.y), bfhi(gb.y), bflo(gb.z), bfhi(gb.z), bflo(gb.w), bfhi(gb.w)};
                float o[8];
#pragma unroll
                for (int j = 0; j < 8; ++j) o[j] = gbf[j] * (w0[j] * pm2[j] + w1[j] * pm1[j] + w2[j] * p[j]);
                v4u w; w.x = pk2(o[0], o[1]); w.y = pk2(o[2], o[3]); w.z = pk2(o[4], o[5]); w.w = pk2(o[6], o[7]);
                *(v4u*)(MIX + (size_t)(t0 + tt) * 2048 + 1024 + cgp * 8) = w; }
#pragma unroll
            for (int j = 0; j < 8; ++j) { pm2[j] = pm1[j]; pm1[j] = p[j]; }
        }
    }
}

template <int MODE>
__device__ __forceinline__ void p_ln(Frame& F, bf16* Y, const bf16* YE, const int* tokd, float* OUTF, const float* gam, const float* bet) {
    const int l = F.lane;
    f32x4 g[8], b[8];
#pragma unroll
    for (int j = 0; j < 4; ++j) { g[2 * j] = *(const f32x4*)(gam + 8 * l + 512 * j); g[2 * j + 1] = *(const f32x4*)(gam + 8 * l + 512 * j + 4); b[2 * j] = *(const f32x4*)(bet + 8 * l + 512 * j); b[2 * j + 1] = *(const f32x4*)(bet + 8 * l + 512 * j + 4); }
    const int gw = F.bx * NWAVES + F.wave, NGW = F.G * NWAVES;
    for (int rowb = gw; rowb < T; rowb += 2 * NGW) {
        v4u w[2][4], e0[2][4], e1[2][4];
#pragma unroll
        for (int u = 0; u < 2; ++u) { const int row = rowb + u * NGW; if (row < T) { const bf16* yp = Y + (size_t)row * 2048 + 8 * l;
#pragma unroll
            for (int j = 0; j < 4; ++j) w[u][j] = __builtin_nontemporal_load((const v4u*)(yp + 512 * j));
            if constexpr (MODE == 1 || MODE == 2) { const int d0 = tokd[2 * row], d1 = tokd[2 * row + 1];
                const bf16* p0 = YE + (size_t)d0 * 2048 + 8 * l; const bf16* p1 = YE + (size_t)d1 * 2048 + 8 * l;
#pragma unroll
                for (int j = 0; j < 4; ++j) { e0[u][j] = __builtin_nontemporal_load((const v4u*)(p0 + 512 * j)); e1[u][j] = __builtin_nontemporal_load((const v4u*)(p1 + 512 * j));     } } } }
#pragma unroll
        for (int u = 0; u < 2; ++u) { const int row = rowb + u * NGW; if (row < T) {
            f32x4 v[8];
#pragma unroll
            for (int j = 0; j < 4; ++j) { v[2 * j] = (f32x4){bflo(w[u][j].x), bfhi(w[u][j].x), bflo(w[u][j].y), bfhi(w[u][j].y)}; v[2 * j + 1] = (f32x4){bflo(w[u][j].z), bfhi(w[u][j].z), bflo(w[u][j].w), bfhi(w[u][j].w)}; }
            if constexpr (MODE == 1 || MODE == 2) {
#pragma unroll
                for (int j = 0; j < 4; ++j) { const v4u w0 = e0[u][j], w1 = e1[u][j];
                    v[2 * j] = v[2 * j] * ALPHA + ((f32x4){bflo(w0.x), bfhi(w0.x), bflo(w0.y), bfhi(w0.y)} + (f32x4){bflo(w1.x), bfhi(w1.x), bflo(w1.y), bfhi(w1.y)});
                    v[2 * j + 1] = v[2 * j + 1] * ALPHA + ((f32x4){bflo(w0.z), bfhi(w0.z), bflo(w0.w), bfhi(w0.w)} + (f32x4){bflo(w1.z), bfhi(w1.z), bflo(w1.w), bfhi(w1.w)}); }
            }
            float sm = 0.f;
#pragma unroll
            for (int j = 0; j < 8; ++j) sm += (v[j][0] + v[j][1]) + (v[j][2] + v[j][3]);
            const float mu = wave_sum(sm) * (1.0f / 2048.0f); float q = 0.f;
#pragma unroll
            for (int j = 0; j < 8; ++j) { v[j] = v[j] - mu; q += (v[j][0] * v[j][0] + v[j][1] * v[j][1]) + (v[j][2] * v[j][2] + v[j][3] * v[j][3]); }
            const float rs = 1.0f / sqrtf(wave_sum(q) * (1.0f / 2048.0f) + LN_EPS);
#pragma unroll
            for (int j = 0; j < 8; ++j) v[j] = v[j] * rs * g[j] + b[j];
            if constexpr (MODE == 2) { float* op = OUTF + (size_t)row * 2048 + 8 * l;
#pragma unroll
                for (int j = 0; j < 4; ++j) { *(f32x4*)(op + 512 * j) = v[2 * j]; *(f32x4*)(op + 512 * j + 4) = v[2 * j + 1]; } }
            else { bf16* yp = (MODE == 3 ? (bf16*)OUTF : Y) + (size_t)row * 2048 + 8 * l;
#pragma unroll
                for (int j = 0; j < 4; ++j) { v4u o; o.x = pk2(v[2 * j][0], v[2 * j][1]); o.y = pk2(v[2 * j][2], v[2 * j][3]); o.z = pk2(v[2 * j + 1][0], v[2 * j + 1][1]); o.w = pk2(v[2 * j + 1][2], v[2 * j + 1][3]); *(v4u*)(yp + 512 * j) = o; } } } }
    }
}

__device__ __forceinline__ void p_router_route(Frame& F, int lyr, bf16* X, const float* gam, const float* bet) {
    typedef float f32x4_t __attribute__((ext_vector_type(4)));
    unsigned char* ws = WSP();
    const bf16* WR = (const bf16*)(ws + WS_ROUT) + (size_t)lyr * 256 * 2048;
    const float* rgb = INP(29) + lyr * 4; const float* reb = INP(31) + lyr * 32;
    int* toke = (int*)(ws + WS_TOKE); float* tokw = (float*)(ws + WS_TOKW); int* wgc = (int*)(ws + WS_WGC);
    constexpr int BP = 264;
    LAS bf16* Bs = (LAS bf16*)F.lds;
    LAS float* LGs = (LAS float*)(F.lds + 2 * 48 * BP * 2);
    LAS int* hist = (LAS int*)(F.lds + SCR_OFF);
    { int* rowt = (int*)(ws + WS_ROWT); for (int i = F.bx * 512 + F.tid; i < RMAX; i += F.G * 512) rowt[i] = 0; }
    const int tid = F.tid, lane = F.lane, wid = F.wave, r16 = lane & 15, kq = lane >> 4;
    for (int grp = F.bx; grp < T / 128; grp += F.G) {
        __syncthreads();
        if (tid < 32) hist[tid] = 0;
        { f32x4 g[8], b[8];
#pragma unroll
          for (int j = 0; j < 4; ++j) { g[2 * j] = *(const f32x4*)(gam + 8 * lane + 512 * j); g[2 * j + 1] = *(const f32x4*)(gam + 8 * lane + 512 * j + 4); b[2 * j] = *(const f32x4*)(bet + 8 * lane + 512 * j); b[2 * j + 1] = *(const f32x4*)(bet + 8 * lane + 512 * j + 4); }
          for (int it = 0; it < 4; ++it) { v4u w[4][4];
#pragma unroll
              for (int u = 0; u < 4; ++u) { const bf16* yp = X + ((size_t)grp * 128 + wid * 16 + 4 * it + u) * 2048 + 8 * lane;
#pragma unroll
                  for (int j = 0; j < 4; ++j) w[u][j] = *(const v4u*)(yp + 512 * j); }
#pragma unroll
              for (int u = 0; u < 4; ++u) { bf16* yp = X + ((size_t)grp * 128 + wid * 16 + 4 * it + u) * 2048 + 8 * lane; f32x4 v[8];
#pragma unroll
                  for (int j = 0; j < 4; ++j) { v[2 * j] = (f32x4){bflo(w[u][j].x), bfhi(w[u][j].x), bflo(w[u][j].y), bfhi(w[u][j].y)}; v[2 * j + 1] = (f32x4){bflo(w[u][j].z), bfhi(w[u][j].z), bflo(w[u][j].w), bfhi(w[u][j].w)}; }
                  float sm = 0.f;
#pragma unroll
                  for (int j = 0; j < 8; ++j) sm += (v[j][0] + v[j][1]) + (v[j][2] + v[j][3]);
                  const float mu = wave_sum(sm) * (1.0f / 2048.0f); float q = 0.f;
#pragma unroll
                  for (int j = 0; j < 8; ++j) { v[j] = v[j] - mu; q += (v[j][0] * v[j][0] + v[j][1] * v[j][1]) + (v[j][2] * v[j][2] + v[j][3] * v[j][3]); }
                  const float rs = 1.0f / sqrtf(wave_sum(q) * (1.0f / 2048.0f) + LN_EPS);
#pragma unroll
                  for (int j = 0; j < 4; ++j) { const f32x4 a0 = v[2 * j] * rs * g[2 * j] + b[2 * j], a1 = v[2 * j + 1] * rs * g[2 * j + 1] + b[2 * j + 1];
                      v4u o; o.x = pk2(a0[0], a0[1]); o.y = pk2(a0[2], a0[3]); o.z = pk2(a1[0], a1[1]); o.w = pk2(a1[2], a1[3]); *(v4u*)(yp + 512 * j) = o; } } }
          asm volatile("s_waitcnt vmcnt(0)" ::: "memory"); }
        const bf16* ap = X + ((size_t)grp * 128 + wid * 16 + r16) * 2048 + 8 * kq;
        f32x4_t acc[3] = {};
        bf16x8 a_cur[8], a_nxt[8]; v4u b_st[3];
#define RR_LOADB(ch) do { _Pragma("unroll") for (int j = 0; j < 3; ++j) { const int idx = tid + 512 * j, n = idx >> 5, c16 = idx & 31; b_st[j] = *(const v4u*)(WR + (size_t)n * 2048 + (ch) * 256 + 8 * c16); } } while (0)
#define RR_WRITEB(buf) do { _Pragma("unroll") for (int j = 0; j < 3; ++j) { const int idx = tid + 512 * j, n = idx >> 5, c16 = idx & 31; *(LAS v4u*)(Bs + (buf) * 48 * BP + n * BP + 8 * c16) = b_st[j]; } } while (0)
#define RR_LOADA(dst, ch) do { _Pragma("unroll") for (int ks = 0; ks < 8; ++ks) dst[ks] = *(const bf16x8*)(ap + (ch) * 256 + 32 * ks); } while (0)
        RR_LOADB(0); RR_LOADA(a_cur, 0);
        RR_WRITEB(0);
        __syncthreads();
#pragma unroll
        for (int ch = 0; ch < 8; ++ch) {
            if (ch + 1 < 8) { RR_LOADB(ch + 1); if (ch & 1) RR_LOADA(a_cur, ch + 1); else RR_LOADA(a_nxt, ch + 1); }
#pragma unroll
            for (int ks = 0; ks < 8; ++ks) { const bf16x8 af = (ch & 1) ? a_nxt[ks] : a_cur[ks];
#pragma unroll
                for (int cb = 0; cb < 3; ++cb) { const bf16x8 bfr = *(const LAS bf16x8*)(Bs + (ch & 1) * 48 * BP + (16 * cb + r16) * BP + 32 * ks + 8 * kq);
                    acc[cb] = __builtin_amdgcn_mfma_f32_16x16x32_bf16(af, bfr, acc[cb], 0, 0, 0); } }
            if (ch + 1 < 8) { RR_WRITEB((ch + 1) & 1); __syncthreads(); }
        }
#undef RR_LOADA
#undef RR_WRITEB
#undef RR_LOADB
#pragma unroll
        for (int cb = 0; cb < 3; ++cb)
#pragma unroll
            for (int t = 0; t < 4; ++t) LGs[(wid * 16 + 4 * kq + t) * 49 + 16 * cb + r16] = acc[cb][t];
        __syncthreads();
        if (tid < 128) { const int t = grp * 128 + tid; const LAS float* lp = LGs + tid * 49;
            float gl[4] = {lp[0] + rgb[0], lp[1] + rgb[1], lp[2] + rgb[2], lp[3] + rgb[3]};
            int gi = 0; float gm = gl[0];
#pragma unroll
            for (int j = 1; j < 4; ++j) if (gl[j] > gm) { gm = gl[j]; gi = j; }
            float den = 0.f;
#pragma unroll
            for (int j = 0; j < 4; ++j) den += __expf(gl[j] - gm);
            const float ggate = 1.0f / den;
            const LAS float* ep = lp + 4 + gi * 8; const float* rb = reb + gi * 8;
            float el[8] = {ep[0] + rb[0], ep[1] + rb[1], ep[2] + rb[2], ep[3] + rb[3], ep[4] + rb[4], ep[5] + rb[5], ep[6] + rb[6], ep[7] + rb[7]};
            int i0 = 0; float v0 = el[0];
#pragma unroll
            for (int j = 1; j < 8; ++j) if (el[j] > v0) { v0 = el[j]; i0 = j; }
            int i1 = -1; float v1 = -3.0e38f;
#pragma unroll
            for (int j = 0; j < 8; ++j) if (j != i0 && el[j] > v1) { v1 = el[j]; i1 = j; }
            const float p0 = 1.0f / (1.0f + __expf(v1 - v0)), p1 = 1.0f - p0;
            const int ea = gi * 8 + i0, eb = gi * 8 + i1;
            toke[2 * t] = ea; toke[2 * t + 1] = eb; tokw[2 * t] = p0 * ggate; tokw[2 * t + 1] = p1 * ggate;
            __hip_atomic_fetch_add(hist + ea, 1, __ATOMIC_RELAXED, __HIP_MEMORY_SCOPE_WORKGROUP); __hip_atomic_fetch_add(hist + eb, 1, __ATOMIC_RELAXED, __HIP_MEMORY_SCOPE_WORKGROUP); }
        __syncthreads();
        if (tid < 32) wgc[grp * 32 + tid] = hist[tid];
    }
    __syncthreads();
}
__device__ __forceinline__ void p_route(Frame& F, int dummy_, int lyr) {
    unsigned char* ws = WSP();
    const float* LG = (const float*)(OUTP() + DO_OP); const float* LG2 = LG + (size_t)T * 64; const float* rgb = INP(29) + lyr * 4; const float* reb = INP(31) + lyr * 32;
    int* toke = (int*)(ws + WS_TOKE); float* tokw = (float*)(ws + WS_TOKW); int* wgc = (int*)(ws + WS_WGC);
    LAS int* hist = (LAS int*)(F.lds + SCR_OFF);
    { int* rowt = (int*)(ws + WS_ROWT); for (int i = F.bx * 512 + F.tid; i < RMAX; i += F.G * 512) rowt[i] = 0; }
    for (int grp = F.bx; grp < T / 128; grp += F.G) {
        __syncthreads();
        if (F.tid < 32) hist[F.tid] = 0;
        __syncthreads();
        if (F.tid < 128) { const int t = grp * 128 + F.tid; const float* lp = LG + (size_t)t * 64;
            const float* lp2 = LG2 + (size_t)t * 64; const f32x4 gl4 = *(const f32x4*)lp + *(const f32x4*)lp2; float gl[4] = {gl4[0] + rgb[0], gl4[1] + rgb[1], gl4[2] + rgb[2], gl4[3] + rgb[3]};
            int gi = 0; float gm = gl[0];
#pragma unroll
            for (int j = 1; j < 4; ++j) if (gl[j] > gm) { gm = gl[j]; gi = j; }
            float den = 0.f;
#pragma unroll
            for (int j = 0; j < 4; ++j) den += __expf(gl[j] - gm);
            const float ggate = 1.0f / den;
            const f32x4 e0 = *(const f32x4*)(lp + 4 + gi * 8) + *(const f32x4*)(lp2 + 4 + gi * 8), e1 = *(const f32x4*)(lp + 8 + gi * 8) + *(const f32x4*)(lp2 + 8 + gi * 8); const float* rb = reb + gi * 8;
            float el[8] = {e0[0] + rb[0], e0[1] + rb[1], e0[2] + rb[2], e0[3] + rb[3], e1[0] + rb[4], e1[1] + rb[5], e1[2] + rb[6], e1[3] + rb[7]};
            int i0 = 0; float v0 = el[0];
#pragma unroll
            for (int j = 1; j < 8; ++j) if (el[j] > v0) { v0 = el[j]; i0 = j; }
            int i1 = -1; float v1 = -3.0e38f;
#pragma unroll
            for (int j = 0; j < 8; ++j) if (j != i0 && el[j] > v1) { v1 = el[j]; i1 = j; }
            const float p0 = 1.0f / (1.0f + __expf(v1 - v0)), p1 = 1.0f - p0;
            const int ea = gi * 8 + i0, eb = gi * 8 + i1;
            toke[2 * t] = ea; toke[2 * t + 1] = eb; tokw[2 * t] = p0 * ggate; tokw[2 * t + 1] = p1 * ggate;
            __hip_atomic_fetch_add(hist + ea, 1, __ATOMIC_RELAXED, __HIP_MEMORY_SCOPE_WORKGROUP); __hip_atomic_fetch_add(hist + eb, 1, __ATOMIC_RELAXED, __HIP_MEMORY_SCOPE_WORKGROUP); }
        __syncthreads();
        if (F.tid < 32) wgc[grp * 32 + F.tid] = hist[F.tid];
    }
    __syncthreads();
}
__device__ __forceinline__ void p_dispatch(Frame& F, int dummy_, const bf16* X, bf16* XG) {
    unsigned char* ws = WSP();
    const int* toke = (const int*)(ws + WS_TOKE); const float* tokw = (const float*)(ws + WS_TOKW); int* tokd = (int*)(ws + WS_TOKD); const int* wgc = (const int*)(ws + WS_WGC);
    float* roww = (float*)(ws + WS_ROWW); int* tile = (int*)(ws + WS_TILE); int* rowt = (int*)(ws + WS_ROWT);
    LAS int* part = (LAS int*)(F.lds + SCR_OFF);
    LAS int* base = part + 1024;
    LAS int* pst = base + 32;
    LAS int* earr = pst + 64;
    LAS int* darr = earr + 256;
    for (int grp = F.bx; grp < T / 128; grp += F.G) {
        __syncthreads();
        { const int e = F.tid & 31, p = F.tid >> 5; int below = 0, tot = 0;
          for (int i = p * 16; i < p * 16 + 16; ++i) { const int c = wgc[i * 32 + e]; tot += c; if (i < grp) below += c; }
          part[p * 32 + e] = below; part[512 + p * 32 + e] = tot; }
        __syncthreads();
        if (F.tid < 32) { int below = 0, tot = 0;
            for (int p = 0; p < 16; ++p) { below += part[p * 32 + F.tid]; tot += part[512 + p * 32 + F.tid]; }
            base[F.tid] = below; earr[F.tid] = tot; }
        __syncthreads();
        if (F.tid == 0) { int s = 0; for (int e = 0; e < 32; ++e) { pst[e] = s; s += (earr[e] + 255) & ~255; } pst[32] = s; }
        __syncthreads();
        if (grp == 0) {
            const int ntile = pst[32] >> 8;
            if (F.tid < 320) { int e = 0;
                for (int k = 1; k < 32; ++k) if (pst[k] <= F.tid * 256) e = k;
                tile[F.tid] = e; }
            if (F.tid == 0) tile[400] = ntile;
        }
        int mye = 0, mytok = 0;
        if (F.tid < 256) { mytok = grp * 128 + (F.tid >> 1); mye = toke[2 * mytok + (F.tid & 1)]; }
        __syncthreads();
        if (F.tid < 256) earr[F.tid] = mye;
        __syncthreads();
        if (F.tid < 256) { int rank = 0;
            for (int k = 0; k < F.tid; ++k) rank += (earr[k] == mye) ? 1 : 0;
            const int dest = pst[mye] + base[mye] + rank;
            tokd[2 * mytok + (F.tid & 1)] = dest; roww[dest] = tokw[2 * mytok + (F.tid & 1)]; rowt[dest] = mytok; }
        __syncthreads();
    }
    __syncthreads();
}

#ifndef ALIGN_SHORTK
#define ALIGN_SHORTK true
#endif
#ifndef ROUTER_GEMM
#define ROUTER_GEMM 0
#endif
#ifndef HO_BARRIER
#define HO_BARRIER false
#endif
#ifndef MIXSEL
#define MIXSEL 15
#endif
#ifndef PHMASK
#define PHMASK 0xFFFFFFFF
#endif
#define PH_ON(k) ((PHMASK >> (k)) & 1)
#ifndef DUPMASK
#define DUPMASK 0
#endif
#define REP(k) for (int rep_ = 0; rep_ < 1 + ((DUPMASK >> (k)) & 1); ++rep_)
__global__ void __launch_bounds__(NWAVES * 64, 2) fwd_kernel(Args args) {
    extern __shared__ __attribute__((aligned(16))) unsigned char lds[];
    Frame F;
    F.lds = (LAS unsigned char*)lds;
    F.MISC = (volatile LAS unsigned*)(F.lds + MISC_OFF);
    F.tid = threadIdx.x; F.lane = F.tid & 63; F.wave = __builtin_amdgcn_readfirstlane(F.tid >> 6);
    F.G = gridDim.x; F.bx = blockIdx.x;
    for (int u = F.tid; u < (LDS_BYTES - LDSCTL_OFF) / 4; u += NWAVES * 64) ((LAS unsigned*)(F.lds + LDSCTL_OFF))[u] = 0u;
    __syncthreads();
    if (F.tid < 37) { const unsigned long long p = F.tid < 35 ? (unsigned long long)args.in[F.tid] : (F.tid == 35 ? (unsigned long long)args.out : (unsigned long long)args.ws);
        LAS unsigned* t = (LAS unsigned*)(F.lds + TAB_OFF) + 2 * F.tid; t[0] = (unsigned)p; t[1] = (unsigned)(p >> 32); }
    const int lo = args.ph_lo, hi = args.ph_hi; int ph = 0;
    __syncthreads();
    XcdBarrier bar = xcd_barrier_post((unsigned*)(WSP() + WS_CTL) + CW_BAR, F.MISC + 8);
#define PHASE_BEGIN if (lo <= ph && ph < hi) { refresh(F); unsigned char* const ws = WSP(); unsigned char* const dout = OUTP(); (void)ws; (void)dout;
#define PHASE_END(sync) if ((sync) && ph + 1 < hi) xcd_barrier(bar); } ++ph;
#define XA_ ((bf16*)(ws + WS_XA))
#define XB_ ((bf16*)(ws + WS_XB))
#define HB_ ((bf16*)(ws + WS_H))
#define KV_ ((bf16*)(ws + WS_KV))
#define MIX_ ((bf16*)(dout + DO_MIX))
#define OPB_ ((bf16*)(dout + DO_OP))
#define QC_ ((bf16*)(dout + DO_QC))
#define OC_ ((bf16*)(dout + DO_OC))
#define HBM_ ((bf16*)(dout + DO_HB))

    PHASE_BEGIN
#if PH_ON(0)
        REP(0)
        p_prologue(F, 0);
#endif
#ifdef PROBE_BAR
        for (int xb_ = 0; xb_ < PROBE_BAR; ++xb_) xcd_barrier(bar);
#endif
    PHASE_END(true)
    for (int lyr = 0; lyr < 2; ++lyr) {
        PHASE_BEGIN
#if PH_ON(2)
        REP(2)
        {
            pg8::Gemm g{XA_, (const bf16*)(ws + WS_WIN) + (size_t)lyr * 5120 * 2048, T, INW, 2048, 2048}; pg8::StaticOrder S; S.init(T, lyr == 0 ? INW - 1024 : INW, F.G, F.bx);
            if (lyr == 0) { S.skip_lo = 8; S.skip_n = 4; }
            pg8::Epi<pg8::EM_WIN> E{HB_, INW, nullptr, (const float*)(ws + WS_CSN), (float*)(ws + WS_QK8), lyr, 0.f};
            pg8::gemm_phase<pg8::Epi<pg8::EM_WIN>, pg8::StaticOrder, true, true>(F.lds, g, S, E);
            if (lyr == 0) {
                pg8::Gemm g2{(const bf16*)(ws + WS_WIN) + (size_t)2048 * 2048, XA_, 1024, T, 2048, 2048}; pg8::StaticOrder S2; S2.init(1024, T, F.G, F.bx);
                pg8::Epi<pg8::EM_VT8> E2{(bf16*)(ws + WS_VT8), 0, nullptr, nullptr, nullptr, 0, 4.0f};
                pg8::gemm_phase<pg8::Epi<pg8::EM_VT8>, pg8::StaticOrder, true, true>(F.lds, g2, S2, E2);
            }
        }
#endif
        PHASE_END(true)
        PHASE_BEGIN
#if PH_ON(3)
        REP(3)
            if (lyr == 0) p_diff_attn2(F, (char*)lds, HB_, OPB_);
#endif
        PHASE_END(false)
        PHASE_BEGIN
#if PH_ON(1)
        REP(1)
        if (lyr == 0) {
            pg8::Gemm g{(const bf16*)(ws + WS_MEMB), (const bf16*)(ws + WS_MEMKV), NMEMT, 512, 2048, 2048}; pg8::StaticOrder S; S.init(NMEMT, 512, F.G, F.bx);
            pg8::Epi<pg8::EM_PLAIN> E{KV_, 1024, nullptr, nullptr, nullptr, 0, 0.f};
            pg8::gemm_phase<pg8::Epi<pg8::EM_PLAIN>, pg8::StaticOrder, true, true>(F.lds, g, S, E);
            pg8::Gemm g2{(const bf16*)(ws + WS_MEMKV) + (size_t)512 * 2048, (const bf16*)(ws + WS_MEMB), 512, NMEMT, 2048, 2048}; pg8::StaticOrder S2; S2.init(512, NMEMT, F.G, (F.bx + F.G - 4) % F.G);
            pg8::Epi<pg8::EM_PLAIN> E2{(bf16*)(ws + WS_VTM), 512, nullptr, nullptr, nullptr, 0, 0.f};
            pg8::gemm_phase<pg8::Epi<pg8::EM_PLAIN>, pg8::StaticOrder, true, true>(F.lds, g2, S2, E2);
        }
#endif
        PHASE_END(false)
        PHASE_BEGIN
#if PH_ON(4)
        REP(4)
            if (lyr == 0) p_conformer(F, 0, HB_, MIX_);
#endif
        PHASE_END(false)
        PHASE_BEGIN
#if PH_ON(5)
        REP(5)
            if (lyr == 1) p_sgu(F, 0, HB_, MIX_);
#endif
        PHASE_END(false)
        PHASE_BEGIN
#if PH_ON(6)
        REP(6)
            if (lyr == 1) p_sconv(F, 0, HB_, MIX_);
#endif
        PHASE_END(true)
        PHASE_BEGIN
#if PH_ON(7)
        REP(7)
            if (lyr == 0) p_combine(F, 0, OPB_, MIX_);
#endif
        PHASE_END(lyr == 0)
        PHASE_BEGIN
#if PH_ON(8)
        REP(8)
        {
            pg8::Gemm g{MIX_, (const bf16*)(ws + WS_WOUT) + (size_t)lyr * 2048 * 2048, T, 2048, 2048, 2048}; pg8::StaticOrder S; S.init(T, 2048, F.G, F.bx);
            pg8::Epi<pg8::EM_RESID_ST> E{XB_, 2048, XA_, nullptr, (float*)(ws + WS_LOG), 0, ALPHA};
            pg8::gemm_phase<pg8::Epi<pg8::EM_RESID_ST>, pg8::StaticOrder, true, true>(F.lds, g, S, E);
        }
#endif
        PHASE_END(true)
        PHASE_BEGIN
#if PH_ON(10)
        REP(10)
        {
            pg8::Gemm g{XB_, (const bf16*)(ws + WS_XQ) + (size_t)lyr * 512 * 2048, T, 512, 2048, 2048}; pg8::StaticOrder S; S.init(T, 512, F.G, F.bx);
            {
              const float* st = (const float*)(ws + WS_LOG); float* rs = (float*)(ws + WS_RS); pg8::Unit u;
              for (int i = 0; i < 8 && S.next(i, u); ++i) { const int row = u.pm * 256 + (F.tid >> 1), hf = F.tid & 1;
                  const f32x4* p = (const f32x4*)(st + ((size_t)row * 32 + hf * 16) * 2); float s1 = 0.f, s2 = 0.f;
#pragma unroll
                  for (int j = 0; j < 8; ++j) { const f32x4 v = p[j]; s1 += v[0] + v[2]; s2 += v[1] + v[3]; }
                  s1 += __shfl_xor(s1, 1); s2 += __shfl_xor(s2, 1);
                  const float mu = s1 * (1.0f / 2048.0f), var = fmaxf(s2 * (1.0f / 2048.0f) - mu * mu, 0.f);
                  if (hf == 0) *(f32x2*)(rs + 2 * (size_t)row) = (f32x2){mu, 1.0f / sqrtf(var + LN_EPS)}; }
              VM_WAIT(); __syncthreads(); }
            pg8::Epi<pg8::EM_XQ> E{QC_, 512, nullptr, (const float*)(ws + WS_RS), (float*)(ws + WS_CSQ) + lyr * 1024, 0, 0.f};
            pg8::gemm_phase<pg8::Epi<pg8::EM_XQ>, pg8::StaticOrder, true, true>(F.lds, g, S, E);
        }
#endif
        PHASE_END(true)
        PHASE_BEGIN
#if PH_ON(11)
        REP(11)
            p_cross_attn2(F, (char*)lds, QC_, KV_, (const bf16*)(ws + WS_VTM), OC_);
#endif
        PHASE_END(true)
        PHASE_BEGIN
#if PH_ON(12)
        REP(12)
        {
            pg8::Gemm g{OC_, (const bf16*)(ws + WS_XO) + (size_t)lyr * 2048 * 512, T, 2048, 512, 512}; pg8::StaticOrder S; S.init(T, 2048, F.G, F.bx);
            pg8::Epi<pg8::EM_RESID_LN> E{XA_, 2048, XB_, (const float*)(ws + WS_RS), nullptr, 0, ALPHA, INP(5) + lyr * 2048, INP(6) + lyr * 2048};
            pg8::gemm_phase<pg8::Epi<pg8::EM_RESID_LN>, pg8::StaticOrder, ALIGN_SHORTK, true>(F.lds, g, S, E);
        }
#endif
        PHASE_END(true)
#if ROUTER_GEMM
        PHASE_BEGIN
#if PH_ON(13)
        REP(13)
            p_ln<0>(F, XA_, nullptr, nullptr, nullptr, INP(7) + lyr * 2048, INP(8) + lyr * 2048);
#endif
        PHASE_END(true)
#endif
#if ROUTER_GEMM
        PHASE_BEGIN
#if PH_ON(14)
        REP(14)
        {
            pg8::Gemm g{XA_, (const bf16*)(ws + WS_ROUT) + (size_t)lyr * 256 * 2048, T, 256, 1024, 2048}; pg8::SplitK2Order S{T / 256, F.G, F.bx, 1024};
            pg8::Epi<pg8::EM_LOGITS> E{nullptr, 0, nullptr, nullptr, (float*)(dout + DO_OP), 0, 0.f};
            pg8::gemm_phase<pg8::Epi<pg8::EM_LOGITS>, pg8::SplitK2Order, true, true>(F.lds, g, S, E);
        }
#endif
        PHASE_END(true)
        PHASE_BEGIN
#if PH_ON(15)
        REP(15)
            p_route(F, 0, lyr);
#endif
        PHASE_END(true)
#else
        PHASE_BEGIN
#if PH_ON(14)
        REP(14)
            p_router_route(F, lyr, XA_, INP(7) + lyr * 2048, INP(8) + lyr * 2048);
#endif
        PHASE_END(true)
#endif
        PHASE_BEGIN
#if PH_ON(16)
        REP(16)
            p_dispatch(F, 0, XA_, HB_);
#endif
        PHASE_END(true)
        PHASE_BEGIN
#if PH_ON(17)
        REP(17)
        {
            const int* tile = (const int*)(ws + WS_TILE); const int ntile = tile[400];
            LAS int* rtab = (LAS int*)(F.lds + SCR_OFF);
            pg8::Gemm g{XA_, (const bf16*)(ws + WS_W13) + (size_t)lyr * 32 * 1024 * 2048, RMAX, 32 * 1024, 2048, 2048};
            pg8::MoeOrder1H S{tile, ntile, F.G, F.bx, rtab, (unsigned*)(ws + WS_CTL) + CW_HO + 64 * 288 * lyr, (unsigned*)(ws + WS_CTL) + CW_HO + 64 * (576 + 8 * lyr)};
            { const int* rowt = (const int*)(ws + WS_ROWT); pg8::Unit u;
              for (int i = 0; i < 8 && S.next(i, u); ++i) if (F.tid < 256) rtab[i * 256 + F.tid] = rowt[u.pm * 256 + F.tid];
              __syncthreads(); }
            pg8::Epi<pg8::EM_SWIGLU_WT> E{HBM_, 512, nullptr, nullptr, nullptr, 0, 0.f};
            pg8::gemm_phase_g<pg8::Epi<pg8::EM_SWIGLU_WT>, pg8::MoeOrder1H, true, true>(F.lds, g, S, E);
        }
#endif
        PHASE_END(HO_BARRIER)
        PHASE_BEGIN
#if PH_ON(18)
        REP(18)
        {
            const int* tile = (const int*)(ws + WS_TILE); const int ntile = tile[400];
            pg8::Gemm g{HBM_, (const bf16*)(ws + WS_W2) + (size_t)lyr * 32 * 2048 * 512, RMAX, 32 * 2048, 512, 512};
            pg8::MoeOrder2H S{tile, ntile, F.G, F.bx, (unsigned*)(ws + WS_CTL) + CW_HO + 64 * 288 * lyr, 32u, (unsigned*)(ws + WS_CTL) + CW_HO + 64 * (576 + 8 * lyr)};
            pg8::Epi<pg8::EM_ROWSCALE> E{HB_, 2048, nullptr, (const float*)(ws + WS_ROWW), nullptr, 0, 0.f};
            pg8::gemm_phase<pg8::Epi<pg8::EM_ROWSCALE>, pg8::MoeOrder2H, ALIGN_SHORTK, true>(F.lds, g, S, E);
        }
#endif
        PHASE_END(true)
        PHASE_BEGIN
#if PH_ON(19)
        REP(19)
            if (lyr == 0) p_ln<1>(F, XA_, HB_, (const int*)(ws + WS_TOKD), nullptr, INP(9), INP(10));
#endif
        PHASE_END(false)
        PHASE_BEGIN
#if PH_ON(20)
        REP(20)
            if (lyr == 1) p_ln<2>(F, XA_, HB_, (const int*)(ws + WS_TOKD), (float*)dout, INP(9) + 2048, INP(10) + 2048);
#endif
        PHASE_END(true)
    }
#undef PHASE_BEGIN
#undef PHASE_END
}

extern "C" void kernel_launch(void* const* d_in, const int* in_sizes, int n_in, void* d_out, int out_size, void* d_ws, size_t ws_size, hipStream_t stream) {
    static int grid = 0;
    if (grid == 0) {
        if (n_in != 35 || in_sizes[0] != T * DM || out_size != T * DM || ws_size < WS_END) { fprintf(stderr, "kernel_launch: unexpected shapes / workspace (n_in %d, ws %zu)\n", n_in, ws_size); grid = -1; return; }
        int dev = 0, cus = 0;
        if (hipGetDevice(&dev) != hipSuccess || hipDeviceGetAttribute(&cus, hipDeviceAttributeMultiprocessorCount, dev) != hipSuccess) { grid = -1; return; }
        if (hipFuncSetAttribute((const void*)fwd_kernel, hipFuncAttributeMaxDynamicSharedMemorySize, LDS_BYTES) != hipSuccess) { fprintf(stderr, "kernel_launch: hipFuncSetAttribute failed\n"); grid = -1; return; }
        int per_cu = 0;
        if (hipOccupancyMaxActiveBlocksPerMultiprocessor(&per_cu, (const void*)fwd_kernel, NWAVES * 64, LDS_BYTES) != hipSuccess || per_cu < 1) { fprintf(stderr, "kernel_launch: occupancy query says %d\n", per_cu); }
        (void)hipGetLastError();
        grid = cus > 0 ? cus : 256;
    }
    if (grid < 0) return;
    (void)hipMemsetAsync((char*)d_ws + WS_CTL, 0, CTL_ZERO_BYTES, stream);
    Args a{};
    for (int i = 0; i < 35; ++i) a.in[i] = d_in[i];
    a.out = (unsigned char*)d_out; a.ws = (unsigned char*)d_ws; a.ph_lo = 0; a.ph_hi = 1000;
    hipLaunchKernelGGL(fwd_kernel, dim3(grid), dim3(NWAVES * 64), LDS_BYTES, stream, a);
}
```

```cpp
#define DUPMASK (0)
#include <hip/hip_runtime.h>
#include <hip/hip_bf16.h>
#include <cstdio>
#include <cstdint>
#include <cmath>

namespace pg8 {
#define PG8_LAS __attribute__((address_space(3)))
typedef unsigned short bf16_t;
typedef short bf16x8 __attribute__((ext_vector_type(8)));
typedef float f32x4 __attribute__((ext_vector_type(4)));
typedef float f32x2 __attribute__((ext_vector_type(2)));
typedef unsigned u32x4 __attribute__((ext_vector_type(4)));
constexpr int BM = 256, BK = 64, HALF = 128, HTB = HALF * BK * 2  , STAGE_BYTES = 8 * HTB, NXCD = 8, WGM = 8;

__host__ __device__ __forceinline__ int lds_byte(int r, int c) { const int st = (r >> 4) * 2 + (c >> 5), rr = r & 15, cc = c & 31, ob = rr * 64 + cc * 2; return st * 1024 + (ob ^ (((ob >> 9) & 1) << 5)); }
__host__ __device__ __forceinline__ void stage_rc(int b, int& R, int& C) { const int st = b / 1024, sb = b % 1024, swz = sb ^ (((sb >> 9) & 1) << 5); R = (st >> 1) * 16 + swz / 64; C = (st & 1) * 32 + (swz % 64) / 2; }
__host__ __device__ __forceinline__ int perm32(int rho) { const int n = rho >> 4, i = rho & 15; return 8 * (i >> 2) + 4 * n + (i & 3); }

struct Unit { int pm, pn, pb, ko; };
struct Gemm { const bf16_t* A; const bf16_t* Bt; int M, N, K, ld; };

struct StaticOrder {
    int nM, nN, nwg, G, c, skip_lo = 1 << 30, skip_n = 0;
    __host__ __device__ void init(int M, int N, int G_, int c_) { nM = M / BM; nN = N / BM; nwg = nM * nN; G = G_; c = c_; }
    __host__ __device__ __forceinline__ bool next(int i, Unit& u) const {
        const long L = (long)i * G + c; if (L >= nwg) return false;
        int wgid = (int)L; { const int q = nwg / NXCD, r = nwg % NXCD, xcd = wgid % NXCD, off = wgid / NXCD; wgid = (xcd < r ? xcd * (q + 1) : r * (q + 1) + (xcd - r) * q) + off; }
        const int nig = WGM * nN, gid = wgid / nig, fm = gid * WGM, gsz = (nM - fm) < WGM ? (nM - fm) : WGM;
        u.pm = fm + ((wgid % nig) % gsz); u.pn = (wgid % nig) / gsz; if (u.pn >= skip_lo) u.pn += skip_n; u.pb = u.pn; u.ko = 0; return true;
    }
    __device__ __forceinline__ void a_ready(const Unit&) const {}
    __device__ __forceinline__ void done(const Unit&) const {}
};
struct SplitK2Order {
    int nM, G, c, khalf;
    __device__ __forceinline__ bool next(int i, Unit& u) const { const int L = i * G + c; if (L >= 2 * nM) return false; u.pm = L >> 1; u.pn = L & 1; u.pb = 0; u.ko = (L & 1) * khalf; return true; }
    __device__ __forceinline__ void a_ready(const Unit&) const {}
    __device__ __forceinline__ void done(const Unit&) const {}
};
struct MoeOrder {
    const int* tile_e; int n_units, NT, G, c; const PG8_LAS int* rtab;
    __device__ __forceinline__ bool next(int i, Unit& u) const {
        int rt, pn;
        if (G % (8 * NT) == 0) { const int x = c & 7, k = c >> 3, per_x = (G >> 3) / NT; rt = i * (G / NT) + x * per_x + k / NT; pn = k % NT; if (rt * NT >= n_units) return false; }
        else { const long L = (long)i * G + c; if (L >= n_units) return false; rt = (int)L / NT; pn = (int)L % NT; }
        u.pm = rt; u.pn = pn; u.pb = tile_e[rt] * NT + pn; u.ko = 0; return true;
    }
    __device__ __forceinline__ void a_ready(const Unit&) const {}
    __device__ __forceinline__ void done(const Unit&) const {}
};

struct MoeOrder1H {
    const int* tile_e; int ntile, G, c; const PG8_LAS int* rtab; unsigned* cnt; unsigned* full;
    __device__ __forceinline__ bool next(int i, Unit& u) const {
        int rt, pn;
        if (G == 256) { const int x = c & 7, k = c >> 3, R1 = ntile >> 6, rem = ntile & 63;
            if (i < R1) rt = i * 64 + x * 8 + (k >> 2);
            else if (i == R1) { const int j = (k >> 2) * 8 + x; if (j >= rem) return false; rt = R1 * 64 + j; }
            else return false;
            pn = k & 3; }
        else { const long L = (long)i * G + c; if (L >= (long)ntile * 4) return false; rt = (int)(L >> 2); pn = (int)(L & 3); }
        u.pm = rt; u.pn = pn; u.pb = tile_e[rt] * 4 + pn; u.ko = 0; return true; }
    __device__ __forceinline__ void a_ready(const Unit&) const {}
    __device__ __forceinline__ void done(const Unit& u) const {
        asm volatile("s_waitcnt vmcnt(0)" ::: "memory");
        if ((threadIdx.x & 63) == 0) { (void)__hip_atomic_fetch_add(cnt + 64 * u.pm, 1u, __ATOMIC_RELAXED, __HIP_MEMORY_SCOPE_AGENT);
            if (G == 256 && (u.pm >> 6) == (ntile >> 6) - 1) (void)__hip_atomic_fetch_add(full + 64 * (c & 7), 1u, __ATOMIC_RELAXED, __HIP_MEMORY_SCOPE_AGENT); } }
};
struct MoeOrder2H {
    const int* tile_e; int ntile, G, c; unsigned* cnt; unsigned need; unsigned* full; mutable bool fd = false;
    __device__ __forceinline__ bool next(int i, Unit& u) const {
        int rt, pn;
        if (G == 256) { const int x = c & 7, k = c >> 3, R1 = ntile >> 6, rem = ntile & 63;
            int ntx = rem > x ? (rem - x + 7) >> 3 : 0; if (ntx > 7) ntx = 0;
            const int U = 8 * (8 * R1 + ntx), Hc = 4 * ntx, Lc = 32 - Hc;
            int ra = (U - 2 * Lc) >> 5; if (ra < 0) ra = 0;
            int idx;
            if (i < ra) idx = i * 32 + k; else { if (k < Hc) return false; idx = ra * 32 + (i - ra) * Lc + (k - Hc); }
            if (idx >= U) return false;
            const int rp = idx >> 3; pn = idx & 7;
            rt = rp < 8 * R1 ? ((rp >> 3) * 64 + x * 8 + (rp & 7)) : (R1 * 64 + (rp - 8 * R1) * 8 + x); }
        else { const long L = (long)i * G + c; if (L >= (long)ntile * 8) return false; rt = (int)(L >> 3); pn = (int)(L & 7); }
        u.pm = rt; u.pn = pn; u.pb = tile_e[rt] * 8 + pn; u.ko = 0; return true; }
#ifdef HO_NOWAIT
    __device__ __forceinline__ void a_ready(const Unit&) const {}
#else
    __device__ __forceinline__ void a_ready(const Unit& u) const {
        const bool fr_ = (G == 256) && u.pm < ((ntile >> 6) << 6);
        if (fr_ && fd) return;
        const unsigned* w_ = fr_ ? full + 64 * (c & 7) : cnt + 64 * u.pm; const unsigned nd_ = fr_ ? 256u : need;
        if (threadIdx.x < 64) { unsigned polls = 0;
            while ((unsigned)__builtin_amdgcn_readfirstlane(__hip_atomic_load(w_, __ATOMIC_RELAXED, __HIP_MEMORY_SCOPE_AGENT)) < nd_) {
                __builtin_amdgcn_s_sleep(2); if (++polls > (1u << 22)) break; }
            __builtin_amdgcn_fence(__ATOMIC_ACQUIRE, "agent");
            asm volatile("s_waitcnt vmcnt(0)" ::: "memory"); }
        asm volatile("" ::: "memory"); __builtin_amdgcn_s_barrier(); asm volatile("" ::: "memory");
        if (fr_) fd = true; }
#endif
    __device__ __forceinline__ void done(const Unit&) const {}
};

__device__ __forceinline__ unsigned cvt_pk_bf16(float lo, float hi) { unsigned r; asm volatile("v_cvt_pk_bf16_f32 %0, %1, %2" : "=v"(r) : "v"(lo), "v"(hi)); return r; }
__device__ __forceinline__ float bf_lo(unsigned w) { return __uint_as_float(w << 16); }
__device__ __forceinline__ float bf_hi(unsigned w) { return __uint_as_float(w & 0xffff0000u); }
__device__ __forceinline__ f32x2 gelu_pk(f32x2 v) {
    const f32x2 av = __builtin_elementwise_abs(v), d = av * 0.2316418882f + 1.0f;
    f32x2 t; t.x = __builtin_amdgcn_rcpf(d.x); t.y = __builtin_amdgcn_rcpf(d.y);
    f32x2 q = t * 0.5307027145f + (-0.7265760135f); q = q * t + 0.7107068705f; q = q * t + (-0.142248368f); q = q * t + 0.127414796f; q = q * t;
    const f32x2 s = (v * v) * (-0.72134752044f);
    f32x2 e; e.x = __builtin_amdgcn_exp2f(s.x); e.y = __builtin_amdgcn_exp2f(s.y);
    const f32x2 m = v * (q * e), r = v - m;
    f32x2 o; o.x = v.x < 0.f ? m.x : r.x; o.y = v.y < 0.f ? m.y : r.y; return o;
}
__device__ __forceinline__ float silu_f(float x) { return x * __builtin_amdgcn_rcpf(1.0f + __builtin_amdgcn_exp2f(-1.4426950408889634f * x)); }

enum { EM_PLAIN = 0, EM_WIN = 1, EM_RESID = 2, EM_LOGITS = 3, EM_SWIGLU = 4, EM_ROWSCALE = 5, EM_VT8 = 7, EM_RESID_ST = 8, EM_XQ = 9, EM_RESID_LN = 10, EM_SWIGLU_WT = 11   };
typedef unsigned u32x2 __attribute__((ext_vector_type(2)));
__device__ __forceinline__ unsigned pk_fp8x4(float a, float b, float c, float d) { int w = __builtin_amdgcn_cvt_pk_fp8_f32(a, b, __builtin_bit_cast(int, a), false); w = __builtin_amdgcn_cvt_pk_fp8_f32(c, d, w, true); return (unsigned)w; }
__device__ __forceinline__ unsigned pk_fp8x4o(float a, float b, float c, float d, int old) { int w = __builtin_amdgcn_cvt_pk_fp8_f32(a, b, old, false); w = __builtin_amdgcn_cvt_pk_fp8_f32(c, d, w, true); return (unsigned)w; }
template <int MODE> struct Epi {
    static constexpr bool PERM = true, AFTER_DRAIN = false;
    bf16_t* O; int ldc;
    const bf16_t* R;
    const float* aux;
    float* OF;
    int lyr;
    float alpha;
    const float* aux2 = nullptr; const float* aux3 = nullptr;
    __device__ __forceinline__ void store8(bf16_t* p, f32x4 v0, f32x4 v1) const {
        u32x4 w; w.x = cvt_pk_bf16(v0[0], v0[1]); w.y = cvt_pk_bf16(v0[2], v0[3]); w.z = cvt_pk_bf16(v1[0], v1[1]); w.w = cvt_pk_bf16(v1[2], v1[3]); *(u32x4*)p = w; }
    __device__ __forceinline__ void store8_wt(bf16_t* p, f32x4 v0, f32x4 v1) const {
        u32x4 w; w.x = cvt_pk_bf16(v0[0], v0[1]); w.y = cvt_pk_bf16(v0[2], v0[3]); w.z = cvt_pk_bf16(v1[0], v1[1]); w.w = cvt_pk_bf16(v1[2], v1[3]);
        asm volatile("global_store_dwordx4 %0, %1, off sc1\n\ts_nop 1" :: "v"(p), "v"(w) : "memory"); }
    __device__ __forceinline__ void operator()(const f32x4 (&acc)[2][2][4][2], const Unit& u, int wr, int wc, int fr, int fq) const {
        const int row0 = u.pm * BM + wr * 64 + fr;
        if constexpr (MODE == EM_LOGITS) {
            if (wc < 2) {
#pragma unroll
                for (int ai = 0; ai < 2; ++ai)
#pragma unroll
                    for (int m = 0; m < 4; ++m) { float* p = OF + (size_t)u.pn * (32768 * 64) + (size_t)(row0 + ai * HALF + m * 16) * 64 + wc * 32 + 8 * fq;
                        *(f32x4*)p = acc[ai][0][m][0]; *(f32x4*)(p + 4) = acc[ai][0][m][1]; }
            }
        } else if constexpr (MODE == EM_VT8) {
            unsigned char* O8 = (unsigned char*)O;
#pragma unroll
            for (int ai = 0; ai < 2; ++ai)
#pragma unroll
                for (int m = 0; m < 4; ++m) { const int row = row0 + ai * HALF + m * 16;
#pragma unroll
                    for (int bj = 0; bj < 2; ++bj) { const int col0 = u.pn * BM + bj * HALF + wc * 32 + 8 * fq; const f32x4 v0 = acc[ai][bj][m][0] * alpha, v1 = acc[ai][bj][m][1] * alpha;
                        u32x2 w; w.x = pk_fp8x4(v0[0], v0[1], v0[2], v0[3]); w.y = pk_fp8x4(v1[0], v1[1], v1[2], v1[3]);
                        unsigned char* bp = O8 + ((size_t)(col0 >> 14) * 1024 + row) * 16384 + (col0 & 16383 & ~63); const int g = (col0 & 63) >> 2, d = 4 * (g >> 3) + ((g & 7) >> 1);
                        *(unsigned*)(bp + 4 * d) = w.x; *(unsigned*)(bp + 4 * d + 32) = w.y; } }
        } else if constexpr (MODE == EM_SWIGLU || MODE == EM_SWIGLU_WT) {
            const int col0 = u.pn * HALF + wc * 32 + 8 * fq;
#pragma unroll
            for (int ai = 0; ai < 2; ++ai)
#pragma unroll
                for (int m = 0; m < 4; ++m) { f32x4 v0, v1;
#pragma unroll
                    for (int j = 0; j < 4; ++j) { v0[j] = silu_f(acc[ai][0][m][0][j]) * acc[ai][1][m][0][j]; v1[j] = silu_f(acc[ai][0][m][1][j]) * acc[ai][1][m][1][j]; }
                    if constexpr (MODE == EM_SWIGLU_WT) store8_wt(O + (size_t)(row0 + ai * HALF + m * 16) * ldc + col0, v0, v1);
                    else store8(O + (size_t)(row0 + ai * HALF + m * 16) * ldc + col0, v0, v1); }
        } else {
            const int col0 = u.pn * BM + wc * 32 + 8 * fq;
            const bool rope = (MODE == EM_WIN) && lyr == 0 && u.pn < 8 && wc == 0;
            const bool gelu = (MODE == EM_WIN) && lyr == 1 && u.pn < 8;
            const bool glu = (MODE == EM_WIN) && lyr == 0 && u.pn >= 12;
            f32x4 cA[2][2], cB[2][2];
            if constexpr (MODE == EM_XQ) {
#pragma unroll
                for (int bj = 0; bj < 2; ++bj)
#pragma unroll
                    for (int n = 0; n < 2; ++n) { cA[bj][n] = *(const f32x4*)(OF + col0 + bj * HALF + 4 * n); cB[bj][n] = *(const f32x4*)(OF + 512 + col0 + bj * HALF + 4 * n); } }
            if constexpr (MODE == EM_RESID_LN) {
#pragma unroll
                for (int bj = 0; bj < 2; ++bj)
#pragma unroll
                    for (int n = 0; n < 2; ++n) { cA[bj][n] = *(const f32x4*)(aux2 + col0 + bj * HALF + 4 * n) * alpha; cB[bj][n] = *(const f32x4*)(aux3 + col0 + bj * HALF + 4 * n) * alpha; } }
#pragma unroll
            for (int ai = 0; ai < 2; ++ai)
#pragma unroll
                for (int m = 0; m < 4; ++m) { const int row = row0 + ai * HALF + m * 16; bf16_t* rowp = O + (size_t)row * ldc + col0;
                    float rs = 1.f; if constexpr (MODE == EM_ROWSCALE) rs = aux[row];
                    f32x2 mr = (f32x2){0.f, 1.f}; if constexpr (MODE == EM_XQ || MODE == EM_RESID_LN) mr = *(const f32x2*)(aux + 2 * (size_t)row);
                    float s1 = 0.f, s2 = 0.f;
                    f32x4 cs0, cs1, sn0, sn1;
                    if constexpr (MODE == EM_WIN) { if (rope) { const float* cp = aux + (size_t)row * 32 + (fq & 1) * 8; cs0 = *(const f32x4*)cp; cs1 = *(const f32x4*)(cp + 4); sn0 = *(const f32x4*)(cp + 16); sn1 = *(const f32x4*)(cp + 20); } }
                    if (MODE == EM_WIN && glu) { f32x4 c0, c1;
#pragma unroll
                        for (int j = 0; j < 4; ++j) { c0[j] = acc[ai][0][m][0][j] * __builtin_amdgcn_rcpf(1.0f + __builtin_amdgcn_exp2f(-1.4426950408889634f * acc[ai][1][m][0][j]));
                                                      c1[j] = acc[ai][0][m][1][j] * __builtin_amdgcn_rcpf(1.0f + __builtin_amdgcn_exp2f(-1.4426950408889634f * acc[ai][1][m][1][j])); }
                        store8(O + (size_t)row * ldc + 3072 + (u.pn - 12) * HALF + wc * 32 + 8 * fq, c0, c1); continue; }
#pragma unroll
                    for (int bj = 0; bj < 2; ++bj) { f32x4 v0 = acc[ai][bj][m][0], v1 = acc[ai][bj][m][1];
                        if constexpr (MODE == EM_WIN) {
                            if (rope) {
                                f32x4 p0, p1;
#pragma unroll
                                for (int j = 0; j < 4; ++j) { p0[j] = __shfl_xor(v0[j], 32); p1[j] = __shfl_xor(v1[j], 32); }
                                const float sg = (fq < 2) ? -1.f : 1.f;
#pragma unroll
                                for (int j = 0; j < 4; ++j) { v0[j] = v0[j] * cs0[j] + sg * p0[j] * sn0[j]; v1[j] = v1[j] * cs1[j] + sg * p1[j] * sn1[j]; }
                            } else if (gelu) {
                                f32x2 a = gelu_pk((f32x2){v0[0], v0[1]}), b = gelu_pk((f32x2){v0[2], v0[3]}), c = gelu_pk((f32x2){v1[0], v1[1]}), d = gelu_pk((f32x2){v1[2], v1[3]});
                                v0 = (f32x4){a.x, a.y, b.x, b.y}; v1 = (f32x4){c.x, c.y, d.x, d.y};
                            }
                        }
                        if constexpr (MODE == EM_XQ) { const float t = -mr.x * mr.y; v0 = v0 * mr.y + (cA[bj][0] * t + cB[bj][0]); v1 = v1 * mr.y + (cA[bj][1] * t + cB[bj][1]); }
                        if constexpr (MODE == EM_RESID_LN) { const u32x4 rw = __builtin_nontemporal_load((const u32x4*)(R + (size_t)row * ldc + col0 + bj * HALF));
                            const f32x4 y0 = ((f32x4){bf_lo(rw.x), bf_hi(rw.x), bf_lo(rw.y), bf_hi(rw.y)} - mr.x) * mr.y, y1 = ((f32x4){bf_lo(rw.z), bf_hi(rw.z), bf_lo(rw.w), bf_hi(rw.w)} - mr.x) * mr.y;
                            v0 = v0 + (y0 * cA[bj][0] + cB[bj][0]); v1 = v1 + (y1 * cA[bj][1] + cB[bj][1]); }
                        if constexpr (MODE == EM_RESID || MODE == EM_RESID_ST) { const u32x4 rw = __builtin_nontemporal_load((const u32x4*)(R + (size_t)row * ldc + col0 + bj * HALF));
                            v0[0] += alpha * bf_lo(rw.x); v0[1] += alpha * bf_hi(rw.x); v0[2] += alpha * bf_lo(rw.y); v0[3] += alpha * bf_hi(rw.y);
                            v1[0] += alpha * bf_lo(rw.z); v1[1] += alpha * bf_hi(rw.z); v1[2] += alpha * bf_lo(rw.w); v1[3] += alpha * bf_hi(rw.w); }
                        if constexpr (MODE == EM_RESID_ST) { s1 += ((v0[0] + v0[1]) + (v0[2] + v0[3])) + ((v1[0] + v1[1]) + (v1[2] + v1[3]));
                            s2 += ((v0[0] * v0[0] + v0[1] * v0[1]) + (v0[2] * v0[2] + v0[3] * v0[3])) + ((v1[0] * v1[0] + v1[1] * v1[1]) + (v1[2] * v1[2] + v1[3] * v1[3])); }
                        if constexpr (MODE == EM_ROWSCALE) { v0 = v0 * rs; v1 = v1 * rs; }
                        if (MODE == EM_WIN && lyr == 0 && u.pn < 8) {
                            u32x2 w8; w8.x = pk_fp8x4(v0[0], v0[1], v0[2], v0[3]); w8.y = pk_fp8x4(v1[0], v1[1], v1[2], v1[3]);
                            *(u32x2*)((unsigned char*)OF + (size_t)row * 2048 + col0 + bj * HALF) = w8; }
                        else store8(rowp + bj * HALF, v0, v1); }
                    if constexpr (MODE == EM_RESID_ST) { s1 += __shfl_xor(s1, 16); s2 += __shfl_xor(s2, 16); s1 += __shfl_xor(s1, 32); s2 += __shfl_xor(s2, 32);
                        if (fq == 0) *(f32x2*)(OF + ((size_t)row * 32 + u.pn * 4 + wc) * 2) = (f32x2){s1, s2}; } }
        }
    }
};

template <class Epi, class Sched, bool ALIGN_EPI = false, bool SP2 = false>
__device__ __forceinline__ void gemm_phase(PG8_LAS unsigned char* lds, const Gemm g, const Sched& S, const Epi& E) {
    int tid_ = threadIdx.x; asm volatile("" : "+v"(tid_)); const int tid = tid_, wid = __builtin_amdgcn_readfirstlane(tid >> 6), lane = tid & 63, wr = wid >> 2, wc = wid & 3, fr = lane & 15, fq = lane >> 4;
    const int K = g.K, nt = K / BK, LD = g.ld;
    unsigned voffA[2], voffB[2];
#pragma unroll
    for (int i = 0; i < 2; ++i) { int R, C; stage_rc(tid * 16 + i * 8192, R, C); const int Rb = Epi::PERM ? ((R & ~31) + perm32(R & 31)) : R;
        voffA[i] = (unsigned)(R * LD + C) * 2u; voffB[i] = (unsigned)(Rb * LD + C) * 2u; }
    const size_t kstep = (size_t)(BK * 2);
    const size_t hstep = (size_t)HALF * LD * 2;
    const size_t tstep = 2 * hstep;
    const unsigned ldsw = (unsigned)wid * 1024u;
    const int aoff = lds_byte(wr * 64 + fr, fq * 8), boff = lds_byte(wc * 32 + fr, fq * 8);
#define PG8_SA(b, h) (((b) * 2 + (h)) * HTB)
#define PG8_SB(b, h) ((4 + (b) * 2 + (h)) * HTB)
#define PG8_STAGE(bufoff, gbase, voff) do { _Pragma("unroll") for (int _i = 0; _i < 2; ++_i) \
        __builtin_amdgcn_global_load_lds((const unsigned*)((const char*)(gbase) + (voff)[_i]), (PG8_LAS unsigned*)(lds + (bufoff) + ldsw + _i * 8192), 16, 0, 0); } while (0)
#define PG8_LDA(dst, b, h) do { _Pragma("unroll") for (int m = 0; m < 4; ++m) _Pragma("unroll") for (int k = 0; k < 2; ++k) dst[m][k] = *(const PG8_LAS bf16x8*)(lds + PG8_SA(b, h) + aoff + m * 2048 + k * 1024); } while (0)
#define PG8_LDB(dst, b, h) do { _Pragma("unroll") for (int n = 0; n < 2; ++n) _Pragma("unroll") for (int k = 0; k < 2; ++k) dst[n][k] = *(const PG8_LAS bf16x8*)(lds + PG8_SB(b, h) + boff + n * 2048 + k * 1024); } while (0)
#define PG8_MMA(ai, bj, At, Bt) do { __builtin_amdgcn_s_setprio(1); _Pragma("unroll") for (int m = 0; m < 4; ++m) _Pragma("unroll") for (int n = 0; n < 2; ++n) _Pragma("unroll") for (int k = 0; k < 2; ++k) \
        acc[ai][bj][m][n] = __builtin_amdgcn_mfma_f32_16x16x32_bf16(Bt[n][k], At[m][k], acc[ai][bj][m][n], 0, 0, 0); __builtin_amdgcn_s_setprio(0); } while (0)
#define PG8_WAIT_V(n) asm volatile("s_waitcnt vmcnt(" #n ")" ::: "memory")
#define PG8_WAIT_L(n) asm volatile("s_waitcnt lgkmcnt(" #n ")" ::: "memory")
#define PG8_BAR __builtin_amdgcn_s_barrier()
#define PG8_SCHED __builtin_amdgcn_sched_barrier(0)
    Unit cur, nxt; int ui = 0;
    if (!S.next(0, cur)) return;
    f32x4 acc[2][2][4][2];
#pragma unroll
    for (int a = 0; a < 2; ++a)
#pragma unroll
        for (int b = 0; b < 2; ++b)
#pragma unroll
            for (int m = 0; m < 4; ++m)
#pragma unroll
                for (int n = 0; n < 2; ++n) acc[a][b][m][n] = (f32x4){0.f, 0.f, 0.f, 0.f};
    bf16x8 At[4][2], B0[2][2], B1[2][2];
    const char* cA = (const char*)g.A + (size_t)cur.pm * tstep + (size_t)cur.ko * 2; const char* cB = (const char*)g.Bt + (size_t)cur.pb * tstep + (size_t)cur.ko * 2;
    S.a_ready(cur);
    if constexpr (SP2) {
        PG8_STAGE(PG8_SB(0, 0), cB, voffB); PG8_STAGE(PG8_SB(0, 1), cB + hstep, voffB); PG8_STAGE(PG8_SA(0, 0), cA, voffA); PG8_STAGE(PG8_SA(0, 1), cA + hstep, voffA);
        if (wr == 1) PG8_BAR;
        PG8_WAIT_V(2); PG8_BAR;
        PG8_STAGE(PG8_SB(1, 0), cB + kstep, voffB); PG8_STAGE(PG8_SA(1, 0), cA + kstep, voffA); PG8_STAGE(PG8_SB(1, 1), cB + hstep + kstep, voffB);
        PG8_WAIT_V(6); PG8_BAR;
    } else {
        PG8_STAGE(PG8_SB(0, 0), cB, voffB); PG8_STAGE(PG8_SA(0, 0), cA, voffA); PG8_STAGE(PG8_SB(0, 1), cB + hstep, voffB); PG8_STAGE(PG8_SA(0, 1), cA + hstep, voffA);
        if (wr == 1) PG8_BAR;
        PG8_WAIT_V(4); PG8_BAR;
        PG8_STAGE(PG8_SB(1, 0), cB + kstep, voffB); PG8_STAGE(PG8_SA(1, 0), cA + kstep, voffA); PG8_STAGE(PG8_SB(1, 1), cB + hstep + kstep, voffB);
        PG8_WAIT_V(6); PG8_BAR;
    }
    for (;;) {
        const bool has_next = S.next(ui + 1, nxt);
        const char* nA = has_next ? (const char*)g.A + (size_t)nxt.pm * tstep + (size_t)nxt.ko * 2 : cA; const char* nB = has_next ? (const char*)g.Bt + (size_t)nxt.pb * tstep + (size_t)nxt.ko * 2 : cB;
        for (int t = 0; t < nt; t += 2) {
            const bool last = (t == nt - 2);
            const char* a1 = cA + (size_t)(t + 1) * kstep;
            const char* a2 = last ? nA : cA + (size_t)(t + 2) * kstep; const char* b2 = last ? nB : cB + (size_t)(t + 2) * kstep;
            const char* a3 = a2 + kstep; const char* b3 = b2 + kstep;
            if (last && has_next) S.a_ready(nxt);
            if constexpr (SP2) {
            PG8_LDB(B0, 0, 0); PG8_LDB(B1, 0, 1); PG8_SCHED; PG8_LDA(At, 0, 0); PG8_STAGE(PG8_SA(1, 1), a1 + hstep, voffA);
            PG8_WAIT_V(8); PG8_WAIT_L(0); PG8_BAR; PG8_MMA(0, 0, At, B0); PG8_MMA(0, 1, At, B1); PG8_BAR; PG8_SCHED;
            PG8_LDA(At, 0, 1); PG8_STAGE(PG8_SB(0, 0), b2, voffB); PG8_STAGE(PG8_SB(0, 1), b2 + hstep, voffB); PG8_STAGE(PG8_SA(0, 0), a2, voffA);
            PG8_WAIT_V(8); PG8_WAIT_L(0); PG8_BAR; PG8_MMA(1, 0, At, B0); PG8_MMA(1, 1, At, B1); PG8_BAR; PG8_SCHED;
            PG8_LDB(B0, 1, 0); PG8_LDB(B1, 1, 1); PG8_SCHED; PG8_LDA(At, 1, 0); PG8_STAGE(PG8_SA(0, 1), a2 + hstep, voffA);
            PG8_WAIT_V(8); PG8_WAIT_L(0); PG8_BAR; PG8_MMA(0, 0, At, B0); PG8_MMA(0, 1, At, B1); PG8_BAR; PG8_SCHED;
            PG8_LDA(At, 1, 1); PG8_STAGE(PG8_SB(1, 0), b3, voffB); PG8_STAGE(PG8_SB(1, 1), b3 + hstep, voffB); PG8_STAGE(PG8_SA(1, 0), a3, voffA);
            PG8_WAIT_V(8); PG8_WAIT_L(0); PG8_BAR; PG8_MMA(1, 0, At, B0); PG8_MMA(1, 1, At, B1); PG8_BAR; PG8_SCHED;
            } else {
            PG8_LDB(B0, 0, 0); PG8_SCHED; PG8_LDA(At, 0, 0); PG8_STAGE(PG8_SA(1, 1), a1 + hstep, voffA);
            PG8_WAIT_L(8); PG8_BAR; PG8_WAIT_L(0); PG8_MMA(0, 0, At, B0); PG8_BAR; PG8_SCHED;
            PG8_LDB(B1, 0, 1); PG8_STAGE(PG8_SB(0, 0), b2, voffB);
            PG8_BAR; PG8_WAIT_L(0); PG8_MMA(0, 1, At, B1); PG8_BAR;
            PG8_LDA(At, 0, 1); PG8_STAGE(PG8_SA(0, 0), a2, voffA);
            PG8_BAR; PG8_WAIT_L(0); PG8_MMA(1, 0, At, B0); PG8_BAR; PG8_SCHED;
            PG8_STAGE(PG8_SB(0, 1), b2 + hstep, voffB);
            PG8_WAIT_V(6); PG8_BAR; PG8_MMA(1, 1, At, B1); PG8_BAR;
            PG8_LDB(B0, 1, 0); PG8_SCHED; PG8_LDA(At, 1, 0); PG8_STAGE(PG8_SA(0, 1), a2 + hstep, voffA);
            PG8_WAIT_L(8); PG8_BAR; PG8_WAIT_L(0); PG8_MMA(0, 0, At, B0); PG8_BAR; PG8_SCHED;
            PG8_LDB(B1, 1, 1); PG8_STAGE(PG8_SB(1, 0), b3, voffB);
            PG8_BAR; PG8_WAIT_L(0); PG8_MMA(0, 1, At, B1); PG8_BAR;
            PG8_LDA(At, 1, 1); PG8_STAGE(PG8_SA(1, 0), a3, voffA);
            PG8_BAR; PG8_WAIT_L(0); PG8_MMA(1, 0, At, B0); PG8_BAR; PG8_SCHED;
            PG8_STAGE(PG8_SB(1, 1), b3 + hstep, voffB);
            PG8_WAIT_V(6); PG8_BAR; PG8_MMA(1, 1, At, B1); PG8_BAR;
            }
        }
        if constexpr (ALIGN_EPI) { if (wr == 0) PG8_BAR; }
        if constexpr (!Epi::AFTER_DRAIN) { int fr_ = fr, fq_ = fq; asm volatile("" : "+v"(fr_), "+v"(fq_));
            E(acc, cur, wr, wc, fr_, fq_); S.done(cur); }
        if (!has_next) break;
#pragma unroll
        for (int a = 0; a < 2; ++a)
#pragma unroll
            for (int b = 0; b < 2; ++b)
#pragma unroll
                for (int m = 0; m < 4; ++m)
#pragma unroll
                    for (int n = 0; n < 2; ++n) acc[a][b][m][n] = (f32x4){0.f, 0.f, 0.f, 0.f};
        cur = nxt; cA = nA; cB = nB; ++ui;
        if constexpr (ALIGN_EPI) { if (wr == 1) PG8_BAR; }
    }
    PG8_WAIT_V(0);
    if constexpr (!ALIGN_EPI) { if (wr == 0) PG8_BAR; }
    PG8_BAR;
    if constexpr (Epi::AFTER_DRAIN) { E.fused(acc, cur, wr, wc, fr, fq, lds, wid, lane); S.done(cur); }
#undef PG8_SA
#undef PG8_SB
#undef PG8_STAGE
#undef PG8_LDA
#undef PG8_LDB
#undef PG8_MMA
#undef PG8_WAIT_V
#undef PG8_WAIT_L
#undef PG8_BAR
#undef PG8_SCHED
}
template <class Epi, class Sched, bool ALIGN_EPI = false, bool SP2 = true>
__device__ __forceinline__ void gemm_phase_g(PG8_LAS unsigned char* lds, const Gemm g, const Sched& S, const Epi& E) {
    int tid_ = threadIdx.x; asm volatile("" : "+v"(tid_)); const int tid = tid_, wid = __builtin_amdgcn_readfirstlane(tid >> 6), lane = tid & 63, wr = wid >> 2, wc = wid & 3, fr = lane & 15, fq = lane >> 4;
    const int K = g.K, nt = K / BK, LD = g.ld;
    unsigned voffA[2], voffB[2];
#pragma unroll
    for (int i = 0; i < 2; ++i) { int R, C; stage_rc(tid * 16 + i * 8192, R, C); const int Rb = Epi::PERM ? ((R & ~31) + perm32(R & 31)) : R;
        voffA[i] = (unsigned)(R * LD + C) * 2u; voffB[i] = (unsigned)(Rb * LD + C) * 2u; }
    static_assert(SP2, "gather variant: SP2 loop only");
    unsigned gac[2][2], gan[2][2];
#define PG8_ROWOFF(dst, ui_) do { _Pragma("unroll") for (int i_ = 0; i_ < 2; ++i_) { int R_, C_; stage_rc(tid * 16 + i_ * 8192, R_, C_); \
        _Pragma("unroll") for (int h_ = 0; h_ < 2; ++h_) dst[h_][i_] = (unsigned)S.rtab[(ui_) * 256 + h_ * 128 + R_] * (unsigned)(LD * 2) + (unsigned)C_ * 2u; } } while (0)
    const size_t kstep = (size_t)(BK * 2);
    const size_t hstep = (size_t)HALF * LD * 2;
    const size_t tstep = 2 * hstep;
    const unsigned ldsw = (unsigned)wid * 1024u;
    const int aoff = lds_byte(wr * 64 + fr, fq * 8), boff = lds_byte(wc * 32 + fr, fq * 8);
#define PG8_SA(b, h) (((b) * 2 + (h)) * HTB)
#define PG8_SB(b, h) ((4 + (b) * 2 + (h)) * HTB)
#define PG8_STAGE(bufoff, gbase, voff) do { _Pragma("unroll") for (int _i = 0; _i < 2; ++_i) \
        __builtin_amdgcn_global_load_lds((const unsigned*)((const char*)(gbase) + (voff)[_i]), (PG8_LAS unsigned*)(lds + (bufoff) + ldsw + _i * 8192), 16, 0, 0); } while (0)
#define PG8_LDA(dst, b, h) do { _Pragma("unroll") for (int m = 0; m < 4; ++m) _Pragma("unroll") for (int k = 0; k < 2; ++k) dst[m][k] = *(const PG8_LAS bf16x8*)(lds + PG8_SA(b, h) + aoff + m * 2048 + k * 1024); } while (0)
#define PG8_LDB(dst, b, h) do { _Pragma("unroll") for (int n = 0; n < 2; ++n) _Pragma("unroll") for (int k = 0; k < 2; ++k) dst[n][k] = *(const PG8_LAS bf16x8*)(lds + PG8_SB(b, h) + boff + n * 2048 + k * 1024); } while (0)
#define PG8_MMA(ai, bj, At, Bt) do { __builtin_amdgcn_s_setprio(1); _Pragma("unroll") for (int m = 0; m < 4; ++m) _Pragma("unroll") for (int n = 0; n < 2; ++n) _Pragma("unroll") for (int k = 0; k < 2; ++k) \
        acc[ai][bj][m][n] = __builtin_amdgcn_mfma_f32_16x16x32_bf16(Bt[n][k], At[m][k], acc[ai][bj][m][n], 0, 0, 0); __builtin_amdgcn_s_setprio(0); } while (0)
#define PG8_WAIT_V(n) asm volatile("s_waitcnt vmcnt(" #n ")" ::: "memory")
#define PG8_WAIT_L(n) asm volatile("s_waitcnt lgkmcnt(" #n ")" ::: "memory")
#define PG8_BAR __builtin_amdgcn_s_barrier()
#define PG8_SCHED __builtin_amdgcn_sched_barrier(0)
    Unit cur, nxt; int ui = 0;
    if (!S.next(0, cur)) return;
    f32x4 acc[2][2][4][2];
#pragma unroll
    for (int a = 0; a < 2; ++a)
#pragma unroll
        for (int b = 0; b < 2; ++b)
#pragma unroll
            for (int m = 0; m < 4; ++m)
#pragma unroll
                for (int n = 0; n < 2; ++n) acc[a][b][m][n] = (f32x4){0.f, 0.f, 0.f, 0.f};
    bf16x8 At[4][2], B0[2][2], B1[2][2];
    PG8_ROWOFF(gac, 0);
    const char* cA = (const char*)g.A + (size_t)cur.ko * 2; const char* cB = (const char*)g.Bt + (size_t)cur.pb * tstep + (size_t)cur.ko * 2;
    S.a_ready(cur);
    if constexpr (SP2) {
        PG8_STAGE(PG8_SB(0, 0), cB, voffB); PG8_STAGE(PG8_SB(0, 1), cB + hstep, voffB); PG8_STAGE(PG8_SA(0, 0), cA, gac[0]); PG8_STAGE(PG8_SA(0, 1), cA, gac[1]);
        if (wr == 1) PG8_BAR;
        PG8_WAIT_V(2); PG8_BAR;
        PG8_STAGE(PG8_SB(1, 0), cB + kstep, voffB); PG8_STAGE(PG8_SA(1, 0), cA + kstep, gac[0]); PG8_STAGE(PG8_SB(1, 1), cB + hstep + kstep, voffB);
        PG8_WAIT_V(6); PG8_BAR;
    } else {
        PG8_STAGE(PG8_SB(0, 0), cB, voffB); PG8_STAGE(PG8_SA(0, 0), cA, voffA); PG8_STAGE(PG8_SB(0, 1), cB + hstep, voffB); PG8_STAGE(PG8_SA(0, 1), cA + hstep, voffA);
        if (wr == 1) PG8_BAR;
        PG8_WAIT_V(4); PG8_BAR;
        PG8_STAGE(PG8_SB(1, 0), cB + kstep, voffB); PG8_STAGE(PG8_SA(1, 0), cA + kstep, gac[0]); PG8_STAGE(PG8_SB(1, 1), cB + hstep + kstep, voffB);
        PG8_WAIT_V(6); PG8_BAR;
    }
    for (;;) {
        const bool has_next = S.next(ui + 1, nxt);
        if (has_next) PG8_ROWOFF(gan, ui + 1); else { gan[0][0] = gac[0][0]; gan[0][1] = gac[0][1]; gan[1][0] = gac[1][0]; gan[1][1] = gac[1][1]; }
        const char* nA = has_next ? (const char*)g.A + (size_t)nxt.ko * 2 : cA; const char* nB = has_next ? (const char*)g.Bt + (size_t)nxt.pb * tstep + (size_t)nxt.ko * 2 : cB;
        for (int t = 0; t < nt; t += 2) {
            const bool last = (t == nt - 2);
            const char* a1 = cA + (size_t)(t + 1) * kstep;
            const char* a2 = last ? nA : cA + (size_t)(t + 2) * kstep; const char* b2 = last ? nB : cB + (size_t)(t + 2) * kstep;
            const char* a3 = a2 + kstep; const char* b3 = b2 + kstep;
            const unsigned g2a[2] = {last ? gan[0][0] : gac[0][0], last ? gan[0][1] : gac[0][1]}, g2b[2] = {last ? gan[1][0] : gac[1][0], last ? gan[1][1] : gac[1][1]};
            if (last && has_next) S.a_ready(nxt);
            if constexpr (SP2) {
            PG8_LDB(B0, 0, 0); PG8_LDB(B1, 0, 1); PG8_SCHED; PG8_LDA(At, 0, 0); PG8_STAGE(PG8_SA(1, 1), a1, gac[1]);
            PG8_WAIT_V(8); PG8_WAIT_L(0); PG8_BAR; PG8_MMA(0, 0, At, B0); PG8_MMA(0, 1, At, B1); PG8_BAR; PG8_SCHED;
            PG8_LDA(At, 0, 1); PG8_STAGE(PG8_SB(0, 0), b2, voffB); PG8_STAGE(PG8_SB(0, 1), b2 + hstep, voffB); PG8_STAGE(PG8_SA(0, 0), a2, g2a);
            PG8_WAIT_V(8); PG8_WAIT_L(0); PG8_BAR; PG8_MMA(1, 0, At, B0); PG8_MMA(1, 1, At, B1); PG8_BAR; PG8_SCHED;
            PG8_LDB(B0, 1, 0); PG8_LDB(B1, 1, 1); PG8_SCHED; PG8_LDA(At, 1, 0); PG8_STAGE(PG8_SA(0, 1), a2, g2b);
            PG8_WAIT_V(8); PG8_WAIT_L(0); PG8_BAR; PG8_MMA(0, 0, At, B0); PG8_MMA(0, 1, At, B1); PG8_BAR; PG8_SCHED;
            PG8_LDA(At, 1, 1); PG8_STAGE(PG8_SB(1, 0), b3, voffB); PG8_STAGE(PG8_SB(1, 1), b3 + hstep, voffB); PG8_STAGE(PG8_SA(1, 0), a3, g2a);
            PG8_WAIT_V(8); PG8_WAIT_L(0); PG8_BAR; PG8_MMA(1, 0, At, B0); PG8_MMA(1, 1, At, B1); PG8_BAR; PG8_SCHED;
            } else {
            PG8_LDB(B0, 0, 0); PG8_SCHED; PG8_LDA(At, 0, 0); PG8_STAGE(PG8_SA(1, 1), a1, gac[1]);
            PG8_WAIT_L(8); PG8_BAR; PG8_WAIT_L(0); PG8_MMA(0, 0, At, B0); PG8_BAR; PG8_SCHED;
            PG8_LDB(B1, 0, 1); PG8_STAGE(PG8_SB(0, 0), b2, voffB);
            PG8_BAR; PG8_WAIT_L(0); PG8_MMA(0, 1, At, B1); PG8_BAR;
            PG8_LDA(At, 0, 1); PG8_STAGE(PG8_SA(0, 0), a2, g2a);
            PG8_BAR; PG8_WAIT_L(0); PG8_MMA(1, 0, At, B0); PG8_BAR; PG8_SCHED;
            PG8_STAGE(PG8_SB(0, 1), b2 + hstep, voffB);
            PG8_WAIT_V(6); PG8_BAR; PG8_MMA(1, 1, At, B1); PG8_BAR;
            PG8_LDB(B0, 1, 0); PG8_SCHED; PG8_LDA(At, 1, 0); PG8_STAGE(PG8_SA(0, 1), a2, g2b);
            PG8_WAIT_L(8); PG8_BAR; PG8_WAIT_L(0); PG8_MMA(0, 0, At, B0); PG8_BAR; PG8_SCHED;
            PG8_LDB(B1, 1, 1); PG8_STAGE(PG8_SB(1, 0), b3, voffB);
            PG8_BAR; PG8_WAIT_L(0); PG8_MMA(0, 1, At, B1); PG8_BAR;
            PG8_LDA(At, 1, 1); PG8_STAGE(PG8_SA(1, 0), a3, g2a);
            PG8_BAR; PG8_WAIT_L(0); PG8_MMA(1, 0, At, B0); PG8_BAR; PG8_SCHED;
            PG8_STAGE(PG8_SB(1, 1), b3 + hstep, voffB);
            PG8_WAIT_V(6); PG8_BAR; PG8_MMA(1, 1, At, B1); PG8_BAR;
            }
        }
        if constexpr (ALIGN_EPI) { if (wr == 0) PG8_BAR; }
        if constexpr (!Epi::AFTER_DRAIN) { int fr_ = fr, fq_ = fq; asm volatile("" : "+v"(fr_), "+v"(fq_));
            E(acc, cur, wr, wc, fr_, fq_); S.done(cur); }
        if (!has_next) break;
#pragma unroll
        for (int a = 0; a < 2; ++a)
#pragma unroll
            for (int b = 0; b < 2; ++b)
#pragma unroll
                for (int m = 0; m < 4; ++m)
#pragma unroll
                    for (int n = 0; n < 2; ++n) acc[a][b][m][n] = (f32x4){0.f, 0.f, 0.f, 0.f};
        cur = nxt; cA = nA; cB = nB; ++ui; gac[0][0] = gan[0][0]; gac[0][1] = gan[0][1]; gac[1][0] = gan[1][0]; gac[1][1] = gan[1][1];
        if constexpr (ALIGN_EPI) { if (wr == 1) PG8_BAR; }
    }
    PG8_WAIT_V(0);
    if constexpr (!ALIGN_EPI) { if (wr == 0) PG8_BAR; }
    PG8_BAR;
    if constexpr (Epi::AFTER_DRAIN) { E.fused(acc, cur, wr, wc, fr, fq, lds, wid, lane); S.done(cur); }
#undef PG8_SA
#undef PG8_SB
#undef PG8_STAGE
#undef PG8_LDA
#undef PG8_LDB
#undef PG8_MMA
#undef PG8_WAIT_V
#undef PG8_WAIT_L
#undef PG8_BAR
#undef PG8_SCHED
#undef PG8_ROWOFF
}
}
namespace att {
constexpr int D = 128;
constexpr float THR = 8.f;
constexpr bool WSKIP = false;
constexpr float SCALE = 0.08838834764831845f;
constexpr int NW = 8, QBLK = 32, KVBLK = 64, QB = NW * QBLK;
constexpr int SHM_V = KVBLK * D * 2, SHM_K = KVBLK * D * 2;
constexpr int LDS_BYTES = 2 * SHM_V + 2 * SHM_K + NW * 64 * 4;

using bf16 = __hip_bfloat16;
typedef short bf16x8 __attribute__((ext_vector_type(8)));
typedef short s16x4 __attribute__((ext_vector_type(4)));
typedef float f32x16 __attribute__((ext_vector_type(16)));
typedef float f32x4 __attribute__((ext_vector_type(4)));
typedef unsigned u32x4 __attribute__((ext_vector_type(4)));
template <class A, class Bt> struct same_t { static constexpr bool v = false; };
template <class A> struct same_t<A, A> { static constexpr bool v = true; };

#define KSWZ(row, colB) ((row) * 256 + ((colB) ^ (((row) & 7) << 4)))
#define SBAR() __builtin_amdgcn_sched_barrier(0)
__device__ __forceinline__ int v_st(int k, int c) { const int kk = (k & ~0xC) | ((k & 4) << 1) | ((k & 8) >> 1); return ((kk >> 3) * 4 + (c >> 5)) * 512 + ((kk & 7) * 32 + (c & 31)) * 2; }
__device__ __forceinline__ int v_rd_base(int lane) { return ((lane & 3) << 3) | (((lane >> 2) & 3) << 6) | (((lane >> 4) & 1) << 5) | (((lane >> 5) & 1) << 8); }
constexpr int v_rd_off(int d0, int ks, int half) { return d0 * 512 + ks * 4096 + half * 2048; }
__device__ __forceinline__ int crow(int r, int hi) { return (r & 3) + 8 * (r >> 2) + 4 * hi; }
__device__ __forceinline__ unsigned cvtpk(float lo, float hi) {
    unsigned r; asm volatile("v_cvt_pk_bf16_f32 %0, %1, %2" : "=v"(r) : "v"(lo), "v"(hi)); return r;
}
__device__ __forceinline__ bf16x8 pack8(f32x4 a, f32x4 b) {
    u32x4 w = {cvtpk(a[0], a[1]), cvtpk(a[2], a[3]), cvtpk(b[0], b[1]), cvtpk(b[2], b[3])};
    return *reinterpret_cast<bf16x8*>(&w);
}
template <class T> __device__ __forceinline__ bf16x8 load8(const T* p) {
    if constexpr (same_t<T, float>::v) { return pack8(*(const f32x4*)p, *(const f32x4*)(p + 4)); }
    else { return *reinterpret_cast<const bf16x8*>(p); }
}
__device__ __forceinline__ void mask_tile(f32x16& p0, f32x16& p1, int dq, unsigned W) {
    const float NEG = -__builtin_inff();
#pragma unroll
    for (int r = 0; r < 16; ++r) {
        const int c = (r & 3) + 8 * (r >> 2);
        if ((unsigned)(dq - c) >= W) p0[r] = NEG;
        if ((unsigned)(dq - c - 32) >= W) p1[r] = NEG;
    }
}
__device__ __forceinline__ void partialSM(f32x16& p0, f32x16& p1, float& m_reg, float& mn, float& alpha) {
    float pmax = p0[0]; for (int r = 1; r < 16; ++r) pmax = fmaxf(pmax, p0[r]); for (int r = 0; r < 16; ++r) pmax = fmaxf(pmax, p1[r]);
    { auto rr = __builtin_amdgcn_permlane32_swap(__float_as_uint(pmax), __float_as_uint(pmax), false, false);
      pmax = fmaxf(__uint_as_float(rr[0]), __uint_as_float(rr[1])); }
    constexpr float C2 = 1.4426950408889634f * SCALE;
    if (__builtin_expect(__all((pmax - m_reg) * SCALE <= THR), 1)) { mn = m_reg; alpha = 1.f; }
    else { mn = fmaxf(m_reg, pmax); alpha = __builtin_amdgcn_exp2f((m_reg - mn) * C2); m_reg = mn; }
    const float mnL = -mn * C2;
    for (int r = 0; r < 16; ++r) p0[r] = fmaf(p0[r], C2, mnL); for (int r = 0; r < 16; ++r) p1[r] = fmaf(p1[r], C2, mnL);
    for (int r = 0; r < 16; ++r) p0[r] = __builtin_amdgcn_exp2f(p0[r]);
}
__device__ __forceinline__ void finishSM(f32x16& p0, f32x16& p1, float alpha, float& l_reg, bf16x8& pa0, bf16x8& pa1, bf16x8& pa2, bf16x8& pa3) {
    for (int r = 0; r < 16; ++r) p1[r] = __builtin_amdgcn_exp2f(p1[r]);
    float ps = 0; for (int r = 0; r < 16; ++r) ps += p0[r]; for (int r = 0; r < 16; ++r) ps += p1[r];
    { auto rr = __builtin_amdgcn_permlane32_swap(__float_as_uint(ps), __float_as_uint(ps), false, false);
      ps = __uint_as_float(rr[0]) + __uint_as_float(rr[1]); }
    l_reg = l_reg * alpha + ps;
#define PK4(P, B_, OUT) do { unsigned a0 = cvtpk(P[B_+0], P[B_+1]), a1 = cvtpk(P[B_+2], P[B_+3]);                          \
        unsigned b0 = cvtpk(P[B_+4], P[B_+5]), b1 = cvtpk(P[B_+6], P[B_+7]);                                             \
        auto r0 = __builtin_amdgcn_permlane32_swap(a0, b0, false, false); auto r1 = __builtin_amdgcn_permlane32_swap(a1, b1, false, false); \
        u32x4 w = {r0[0], r1[0], r0[1], r1[1]}; OUT = *reinterpret_cast<bf16x8*>(&w); } while (0)
    PK4(p0, 0, pa0); PK4(p0, 8, pa1); PK4(p1, 0, pa2); PK4(p1, 8, pa3);
#undef PK4
}
template <int KB, bool SK>
__device__ __forceinline__ void qkt(f32x16& p0, f32x16& p1, const char* K_lds, int r32, int hi, const bf16x8* qr, bool act) {
    if (SK && !act) { const float NEG = -__builtin_inff();
#pragma unroll
        for (int r = 0; r < 16; ++r) { p0[r] = NEG; p1[r] = NEG; } return; }
    p0 = f32x16{}; p1 = f32x16{};
    const char* kb[4];
#pragma unroll
    for (int dd = 0; dd < 4; ++dd) kb[dd] = K_lds + KB * SHM_K + KSWZ(r32, (dd * 16 + hi * 8) * 2);
#pragma unroll
    for (int d0 = 0; d0 < 8; ++d0) { const char* a = kb[d0 & 3] + (d0 >> 2) * 128;
        bf16x8 b0 = *reinterpret_cast<const bf16x8*>(a);
        bf16x8 b1 = *reinterpret_cast<const bf16x8*>(a + 32 * 256);
        p0 = __builtin_amdgcn_mfma_f32_32x32x16_bf16(b0, qr[d0], p0, 0, 0, 0);
        p1 = __builtin_amdgcn_mfma_f32_32x32x16_bf16(b1, qr[d0], p1, 0, 0, 0); }
}
template <int VB, bool SK>
__device__ __forceinline__ void pv_tile(f32x16* o, int vb0, bf16x8 pa0, bf16x8 pa1, bf16x8 pa2, bf16x8 pa3, bool act) {
    if (SK && !act) return;
#define TRRD(dst, off) asm volatile("ds_read_b64_tr_b16 %0, %1 offset:%2" : "=&v"(dst) : "v"(vb0), "i"(off) : "memory")
#define PV_D0(d0) do { s16x4 l0, l1, l2, l3, h0, h1, h2, h3; constexpr int b_ = VB * SHM_V + v_rd_off(d0, 0, 0);     \
        TRRD(l0, b_); TRRD(h0, b_ + 2048); TRRD(l1, b_ + 4096); TRRD(h1, b_ + 6144); TRRD(l2, b_ + 8192); TRRD(h2, b_ + 10240); TRRD(l3, b_ + 12288); TRRD(h3, b_ + 14336); \
        asm volatile("s_waitcnt lgkmcnt(0)" ::: "memory"); SBAR();                 \
        o[d0] = __builtin_amdgcn_mfma_f32_32x32x16_bf16(pa0, (bf16x8){l0[0], l0[1], l0[2], l0[3], h0[0], h0[1], h0[2], h0[3]}, o[d0], 0, 0, 0);   \
        o[d0] = __builtin_amdgcn_mfma_f32_32x32x16_bf16(pa1, (bf16x8){l1[0], l1[1], l1[2], l1[3], h1[0], h1[1], h1[2], h1[3]}, o[d0], 0, 0, 0);   \
        o[d0] = __builtin_amdgcn_mfma_f32_32x32x16_bf16(pa2, (bf16x8){l2[0], l2[1], l2[2], l2[3], h2[0], h2[1], h2[2], h2[3]}, o[d0], 0, 0, 0);   \
        o[d0] = __builtin_amdgcn_mfma_f32_32x32x16_bf16(pa3, (bf16x8){l3[0], l3[1], l3[2], l3[3], h3[0], h3[1], h3[2], h3[3]}, o[d0], 0, 0, 0); } while (0)
    PV_D0(0); PV_D0(1); PV_D0(2); PV_D0(3);
#undef PV_D0
#undef TRRD
}

template <class TIn, class TOut> struct BlockRef { const TIn* Q; const TIn* K; const TIn* V; TOut* O; int P0; };
template <class TIn> struct Seam {
    bf16x8 qr[8];
    bf16x8 st_v0, st_v1, st_k0, st_k1; f32x4 sf0, sf1, sf2, sf3;
    f32x4 tq[16];
};
__device__ __forceinline__ int swa_jlo(int P0, int W) { const int lowk = P0 - W + 1; return lowk > 0 ? lowk / KVBLK : 0; }
#define ROW(p, k0, rr) ((p) + (size_t)(k0) * KVP + (unsigned)((rr) * KVP + sc))
#define VMW() asm volatile("s_waitcnt vmcnt(0)" ::: "memory")
#define VMWN(n) asm volatile("s_waitcnt vmcnt(%0)" :: "i"(n) : "memory")
#define SLOAD_H(Kp, Vp, k0) do { S.st_v0 = load8<TIn>(ROW(Vp, k0, sr)); S.st_v1 = load8<TIn>(ROW(Vp, k0, 32 + sr));              \
                         S.st_k0 = load8<TIn>(ROW(Kp, k0, sr)); S.st_k1 = load8<TIn>(ROW(Kp, k0, 32 + sr)); } while (0)
#define SWRITE_HK(bf) do { *(bf16x8*)(K_lds + (bf) * SHM_K + kws) = S.st_k0; *(bf16x8*)(K_lds + (bf) * SHM_K + kws + 32 * 256) = S.st_k1; } while (0)
#define SWRITE_HV(bf) do { *(bf16x8*)(V_lds + (bf) * SHM_V + vst0) = S.st_v0; *(bf16x8*)(V_lds + (bf) * SHM_V + vst1) = S.st_v1; } while (0)
#define SWRITE_H(bf) do { SWRITE_HV(bf); SWRITE_HK(bf); } while (0)
#define SLOAD_F(p, k0) do { S.sf0 = *(const f32x4*)ROW(p, k0, sr); S.sf1 = *(const f32x4*)(ROW(p, k0, sr) + 4);                \
                            S.sf2 = *(const f32x4*)ROW(p, k0, 32 + sr); S.sf3 = *(const f32x4*)(ROW(p, k0, 32 + sr) + 4); } while (0)
#define SWRITE_KF(bf) do { *(bf16x8*)(K_lds + (bf) * SHM_K + kws) = pack8(S.sf0, S.sf1); *(bf16x8*)(K_lds + (bf) * SHM_K + kws + 32 * 256) = pack8(S.sf2, S.sf3); } while (0)
#define SWRITE_VF(bf) do { *(bf16x8*)(V_lds + (bf) * SHM_V + vst0) = pack8(S.sf0, S.sf1); *(bf16x8*)(V_lds + (bf) * SHM_V + vst1) = pack8(S.sf2, S.sf3); } while (0)
template <class TIn, class TOut, int QP, int KVP, int OPI>
__device__ __forceinline__ void causal_swa_prime(const BlockRef<TIn, TOut>& cur, int W, char* lds, Seam<TIn>& S) {
    constexpr bool F32 = same_t<TIn, float>::v;
    int tid_ = threadIdx.x; asm volatile("" : "+v"(tid_)); const int tid = tid_, wid = __builtin_amdgcn_readfirstlane(tid >> 6), lane = tid & 63, r32 = lane & 31, hi = lane >> 5;
    const int sr = tid >> 4, sc = (tid & 15) * 8, kws = KSWZ(sr, sc * 2); char* K_lds = lds + 2 * SHM_V;
    const int kb0 = swa_jlo(cur.P0, W) * KVBLK;
    for (int d0 = 0; d0 < 8; ++d0) S.qr[d0] = load8<TIn>(cur.Q + (unsigned)((wid * QBLK + r32) * QP + d0 * 16 + hi * 8));
    if constexpr (F32) { SLOAD_F((const float*)cur.K, kb0); VMW(); SWRITE_KF(0); SBAR(); SLOAD_F((const float*)cur.V, kb0); }
    else { SLOAD_H(cur.K, cur.V, kb0); VMW(); SWRITE_HK(0); }
    __syncthreads();
}
template <class TIn, class TOut, int QP, int KVP, int OPI>
__device__ __forceinline__ void causal_swa_block(const BlockRef<TIn, TOut>& cur, const BlockRef<TIn, TOut>& nxt, int skv, int W, char* lds, Seam<TIn>& S) {
    constexpr bool F32 = same_t<TIn, float>::v;
    int tid_ = threadIdx.x; asm volatile("" : "+v"(tid_)); const int tid = tid_, wid = __builtin_amdgcn_readfirstlane(tid >> 6), lane = tid & 63, r32 = lane & 31, hi = lane >> 5;
    const int j_lo = swa_jlo(cur.P0, W);
    int j_hi = (cur.P0 + QB - 1) / KVBLK + 1; if (j_hi > skv / KVBLK) j_hi = skv / KVBLK;
    const int NT = j_hi - j_lo;
    const int kbn = swa_jlo(nxt.P0, W) * KVBLK;
    const int qlo = cur.P0 + wid * QBLK, qm = qlo + r32 - 4 * hi;
    char* V_lds = lds; char* K_lds = lds + 2 * SHM_V;
    float* ws = (float*)(lds + 2 * SHM_V + 2 * SHM_K) + wid * 64; float* li_l = ws, * al_l = ws + 32;
    float m_reg = -1e30f, l_reg = 0; f32x16 o[4] = {};
    const int sr = tid >> 4, sc = (tid & 15) * 8, vst0 = v_st(sr, sc), vst1 = v_st(32 + sr, sc), kws = KSWZ(sr, sc * 2);
    const int vb0 = (int)(uintptr_t)V_lds + v_rd_base(lane);
    const TIn* Kh = cur.K; const TIn* Vh = cur.V;
#define RESC(a) do { if (__any((a) < 1.f)) { if (hi == 0) al_l[r32] = (a); asm volatile("s_waitcnt lgkmcnt(0)" ::: "memory");              \
                     for (int d_ = 0; d_ < 4; ++d_) for (int r = 0; r < 16; ++r) o[d_][r] *= al_l[crow(r, hi)]; } } while (0)
#define KBASE(t) ((j_lo + (t)) * KVBLK)
#define ACT(t) (KBASE(t) <= qlo + QBLK - 1 && KBASE(t) + KVBLK - 1 >= qlo - W + 1)
#define MASKT(P0_, P1_, t) do { const int kb_ = KBASE(t); if ((!SK || ACT(t)) && (kb_ + KVBLK - 1 > qlo || kb_ <= qlo + QBLK - 1 - W)) mask_tile(P0_, P1_, qm - kb_, (unsigned)W); } while (0)
    constexpr int NQL = F32 ? 16 : 8;
    constexpr bool SK = WSKIP && !F32;
#define SEAM_K0() do { VMWN(NQL); if constexpr (F32) { SWRITE_KF(0); SBAR(); SLOAD_F((const float*)nxt.V, kbn); } else { SWRITE_HK(0); } SBAR(); } while (0)
    f32x16 pA0, pA1, pB0, pB1; float mnA, mnB, alA, alB; bf16x8 pa0, pa1, pa2, pa3;
    if constexpr (F32) { VMW(); SWRITE_VF(0); SBAR(); } else { SWRITE_HV(0); SBAR(); }
    if (NT > 1) { if constexpr (F32) SLOAD_F((const float*)Kh, KBASE(1)); else SLOAD_H(Kh, Vh, KBASE(1)); }
    SBAR(); qkt<0, SK>(pA0, pA1, K_lds, r32, hi, S.qr, ACT(0));
    if constexpr (F32) { if (NT > 1) { VMW(); SWRITE_KF(1); SBAR(); SLOAD_F((const float*)Vh, KBASE(1)); } }
    MASKT(pA0, pA1, 0); partialSM(pA0, pA1, m_reg, mnA, alA);
    if (NT > 1) { VMW(); if constexpr (F32) { SWRITE_VF(1); SBAR(); if (NT > 2) SLOAD_F((const float*)Kh, KBASE(2)); } else SWRITE_H(1); }
    __syncthreads();
#define HALF_STEP(PX0, PX1, mnX, alX, PY0, PY1, alY, t, KB, VB, SB) do {                                                      \
        SBAR(); qkt<KB, SK>(PX0, PX1, K_lds, r32, hi, S.qr, ACT(t));                                             \
        finishSM(PY0, PY1, alY, l_reg, pa0, pa1, pa2, pa3); SBAR();                                                           \
        if ((t) + 1 < NT) { if constexpr (F32) { VMW(); SWRITE_KF(SB); SBAR(); SLOAD_F((const float*)Vh, KBASE((t) + 1)); }  \
                            else { SLOAD_H(Kh, Vh, KBASE((t) + 1)); } SBAR(); }                                               \
        pv_tile<VB, SK>(o, vb0, pa0, pa1, pa2, pa3, ACT((t) - 1)); MASKT(PX0, PX1, (t)); partialSM(PX0, PX1, m_reg, mnX, alX);                                        \
        __syncthreads();                                                                                                      \
        if ((t) + 1 < NT) { VMW(); if constexpr (F32) { SWRITE_VF(SB); SBAR(); if ((t) + 2 < NT) SLOAD_F((const float*)Kh, KBASE((t) + 2)); } \
                            else { SWRITE_H(SB); } }                                                                          \
        RESC(alX); __syncthreads(); } while (0)
    for (int t = 1; t + 1 < NT; t += 2) {
        HALF_STEP(pB0, pB1, mnB, alB, pA0, pA1, alA, t, 1, 0, 0);
        HALF_STEP(pA0, pA1, mnA, alA, pB0, pB1, alB, t + 1, 0, 1, 1);
    }
    const bool even = (NT & 1) == 0;
    if (even) { SBAR(); qkt<1, SK>(pB0, pB1, K_lds, r32, hi, S.qr, ACT(NT - 1)); SBAR(); }
#define QROW(e) (nxt.Q + (size_t)(wid * QBLK + r32) * QP + ((e) >> 1) * 16 + hi * 8 + ((e) & 1) * 4)
    if constexpr (F32) { SLOAD_F((const float*)nxt.K, kbn); SBAR();
#pragma unroll
        for (int e = 0; e < 8; ++e) S.tq[e] = *(const f32x4*)QROW(e); }
    else { SLOAD_H(nxt.K, nxt.V, kbn); SBAR();
#pragma unroll
        for (int d0 = 0; d0 < 8; ++d0) S.qr[d0] = load8<TIn>(nxt.Q + (unsigned)((wid * QBLK + r32) * QP + d0 * 16 + hi * 8)); }
    SBAR();
    finishSM(pA0, pA1, alA, l_reg, pa0, pa1, pa2, pa3); SBAR();
    if constexpr (F32) {
#pragma unroll
        for (int e = 8; e < 16; ++e) S.tq[e] = *(const f32x4*)QROW(e); SBAR(); }
#undef QROW
    pv_tile<0, SK>(o, vb0, pa0, pa1, pa2, pa3, ACT(even ? NT - 2 : NT - 1));
    if (even) { MASKT(pB0, pB1, NT - 1); partialSM(pB0, pB1, m_reg, mnB, alB); __syncthreads(); RESC(alB);
        finishSM(pB0, pB1, alB, l_reg, pa0, pa1, pa2, pa3); SBAR(); pv_tile<1, SK>(o, vb0, pa0, pa1, pa2, pa3, ACT(NT - 1)); }
    SBAR(); SEAM_K0();
    if (hi == 0) li_l[r32] = l_reg; asm volatile("s_waitcnt lgkmcnt(0)" ::: "memory");
    float rli[16];
#pragma unroll
    for (int r = 0; r < 16; ++r) rli[r] = __builtin_amdgcn_rcpf(li_l[crow(r, hi)]);
    TOut* Ow = cur.O + (unsigned)((wid * QBLK) * OPI);
#pragma unroll
    for (int r = 0; r < 16; ++r) { const int orow = crow(r, hi);
#pragma unroll
        for (int d0 = 0; d0 < 4; ++d0) { const float v = o[d0][r] * rli[r];
            if constexpr (same_t<TOut, float>::v) { Ow[(size_t)orow * OPI + d0 * 32 + r32] = v; }
            else { const float vn = __shfl_xor(v, 1);
                   if ((r32 & 1) == 0) *(unsigned*)(Ow + (unsigned)(orow * OPI + d0 * 32 + r32)) = cvtpk(v, vn); } } }
    if constexpr (F32) {
#pragma unroll
        for (int d0 = 0; d0 < 8; ++d0) S.qr[d0] = pack8(S.tq[2 * d0], S.tq[2 * d0 + 1]); }
    __syncthreads();
#undef RESC
#undef KBASE
#undef ACT
#undef MASKT
#undef SEAM_K0
#undef HALF_STEP
}
#undef ROW
#undef VMW
#undef VMWN
#undef SLOAD_H
#undef SWRITE_HK
#undef SWRITE_HV
#undef SWRITE_H
#undef SLOAD_F
#undef SWRITE_KF
#undef SWRITE_VF

}

#ifndef ATT_SATMODE
#define ATT_SATMODE 1
#endif
#if ATT_SATMODE
#define ATT_CL(x) (x)
#else
#define ATT_CL(x) fminf((x), 448.f)
#endif
#ifndef ATT_STATPRIO
#define ATT_STATPRIO 0
#endif
#ifndef ATT_PSH
#define ATT_PSH 1.0f
#endif
#ifndef ATT_TAU
#define ATT_TAU 3.0f
#endif
#ifndef ATT_SCHED
#define ATT_SCHED { _Pragma("unroll") for (int sg_ = 0; sg_ < 6; ++sg_) { __builtin_amdgcn_sched_group_barrier(0x008, 1, 0); __builtin_amdgcn_sched_group_barrier(0x402, ATT_VPM, 0); } }
#endif
#ifndef ATT_VPM
#define ATT_VPM 10
#endif
namespace att2 {
using att::bf16; using att::bf16x8; using att::s16x4; using att::f32x16; using att::f32x4; using att::u32x4;
constexpr float SCALE = 0.08838834764831845f;
constexpr int MX3_OFF = 132096  , AL3_OFF = MX3_OFF + 2048, LI3_OFF = AL3_OFF + 1024;
constexpr int V7_OFF = 0  , K7_OFF = 32768  , PB7_OFF = 49152  ;
template <int OPI>
__device__ __forceinline__ void diff_block7(const unsigned char* Q8, const unsigned char* K8, const unsigned char* VT8, bf16* O, int P0, char* lds) {
    typedef int v4i_ __attribute__((ext_vector_type(4))); typedef int v8i_ __attribute__((ext_vector_type(8)));
    typedef __attribute__((address_space(1))) unsigned char gcu8_; typedef __attribute__((address_space(1))) v4i_ gv4i_;
    int tid_ = threadIdx.x; asm volatile("" : "+v"(tid_));
    const int tid = tid_, wid = __builtin_amdgcn_readfirstlane(tid >> 6), lane = tid & 63, r32 = lane & 31, hi = lane >> 5;
    const int pr = wid & 3, role = wid >> 2;
    const int NT = P0 / 64 + 2;
    char* V_lds = lds + V7_OFF; char* K_lds = lds + K7_OFF; char* pb_l = lds + PB7_OFF;
    float* mx_l = (float*)(lds + MX3_OFF); float* al_l = (float*)(lds + AL3_OFF) + wid * 32; float* li_l = (float*)(lds + LI3_OFF);
    const int kkey = role * 32 + r32, ksw = (kkey >> 1) & 7;
    const char* kbase = K_lds + kkey * 128;
    const int skey = tid >> 3, sch = tid & 7, kws8 = skey * 128 + ((sch ^ ((skey >> 1) & 7)) << 4);
    const int svr = tid >> 2, sg0 = (tid & 3) * 4;
    int vws[4];
#pragma unroll
    for (int e = 0; e < 4; ++e) { const int g = sg0 + e, d = (g & 1) * 8 + 4 * (g >> 3) + ((g & 7) >> 1); vws[e] = svr * 64 + ((((d >> 2) ^ ((svr >> 2) & 3)) << 2) | (d & 3)) * 4; }
    const int vrow = role * 128 + r32, vsw = (vrow >> 2) & 3;
    const char* vbase = V_lds + vrow * 64;
    const int vc0 = ((2 * hi) ^ vsw) << 4, vc1 = ((2 * hi + 1) ^ vsw) << 4;
    const int qpos = P0 + pr * 32 + r32, qlo = P0 + pr * 32;
    constexpr float C2 = 1.4426950408889634f * SCALE;
    v8i_ qr8[2];
#pragma unroll
    for (int c = 0; c < 2; ++c) { const unsigned char* qp = Q8 + (unsigned)((pr * 32 + r32) * 2048 + 64 * c + 32 * hi);
        qr8[c] = __builtin_shufflevector(*(const v4i_*)qp, *(const v4i_*)(qp + 16), 0, 1, 2, 3, 4, 5, 6, 7); }
    typedef __attribute__((address_space(3))) unsigned las_u32_;
    const int dk_key = wid * 8 + (lane >> 3);
    unsigned dk_off = (unsigned)(dk_key * 2048 + (((lane & 7) ^ ((dk_key >> 1) & 7)) << 4));
    const int dv_r0 = wid * 32 + (lane >> 2), dv_r1 = dv_r0 + 16;
    unsigned dv_off0 = (unsigned)(dv_r0 * 16384 + (((lane & 3) ^ ((dv_r0 >> 2) & 3)) << 4)), dv_off1 = (unsigned)(dv_r1 * 16384 + (((lane & 3) ^ ((dv_r1 >> 2) & 3)) << 4));
    asm volatile("" : "+v"(dk_off), "+v"(dv_off0), "+v"(dv_off1));
#define DMAK(bf, k0) do { const gcu8_* kp_ = (const gcu8_*)K8 + (size_t)(k0) * 2048; asm volatile("" : "+s"(kp_)); \
        __builtin_amdgcn_global_load_lds((const __attribute__((address_space(1))) unsigned*)(kp_ + dk_off), (las_u32_*)(K_lds + (bf) * 8192 + wid * 1024), 16, 0, 0); } while (0)
#define DMAV(bf, k0) do { const gcu8_* vp_ = (const gcu8_*)VT8 + (k0); asm volatile("" : "+s"(vp_)); \
        __builtin_amdgcn_global_load_lds((const __attribute__((address_space(1))) unsigned*)(vp_ + dv_off0), (las_u32_*)(V_lds + (bf) * 16384 + wid * 2048), 16, 0, 0); \
        __builtin_amdgcn_global_load_lds((const __attribute__((address_space(1))) unsigned*)(vp_ + dv_off1), (las_u32_*)(V_lds + (bf) * 16384 + wid * 2048 + 1024), 16, 0, 0); } while (0)
#define VMW() asm volatile("s_waitcnt vmcnt(0)" ::: "memory")
#define QKM(dst, BUF) do { dst = (f32x16){}; \
        _Pragma("unroll") for (int c = 0; c < 2; ++c) { const char* kp2_ = kbase + (BUF) * 8192; \
            const v8i_ kf = __builtin_shufflevector(*(const v4i_*)(kp2_ + (((4 * c + 2 * hi) ^ ksw) << 4)), *(const v4i_*)(kp2_ + (((4 * c + 2 * hi + 1) ^ ksw) << 4)), 0, 1, 2, 3, 4, 5, 6, 7); \
            dst = __builtin_amdgcn_mfma_scale_f32_32x32x64_f8f6f4(kf, qr8[c], dst, 0, 0, 0, 0x7F7F7F7F, 0, 0x7F7F7F7F); } } while (0)
#define MASK(p, t) \
        { const int kb_ = (t) * 64 + role * 32; if (kb_ + 31 > qlo) { const int dq = qpos - kb_ - 4 * hi; const float NEG = -__builtin_inff(); \
            _Pragma("unroll") for (int r = 0; r < 16; ++r) { const int c = (r & 3) + 8 * (r >> 2); if (c > dq) p[r] = NEG; } } }
#define MX3(a, b, c) fmaxf(fmaxf((a), (b)), (c))
#define PMAX(p) \
        float pmax = fmaxf(MX3(MX3(p[0], p[1], p[2]), MX3(p[3], p[4], p[5]), MX3(p[6], p[7], p[8])), MX3(MX3(p[9], p[10], p[11]), MX3(p[12], p[13], p[14]), p[15])); \
        { auto rr_ = __builtin_amdgcn_permlane32_swap(__float_as_uint(pmax), __float_as_uint(pmax), false, false); pmax = MX3(__uint_as_float(rr_[0]), __uint_as_float(rr_[1]), -3.0e38f); }
#define SOFTPUB(p, SL) \
        { p = p * C2 + mnL;                                                \
          _Pragma("unroll") for (int r = 0; r < 16; ++r) p[r] = __builtin_amdgcn_exp2f(p[r]); \
          l4 += ((f32x4){p[0], p[1], p[2], p[3]} + (f32x4){p[4], p[5], p[6], p[7]}) + ((f32x4){p[8], p[9], p[10], p[11]} + (f32x4){p[12], p[13], p[14], p[15]}); }     \
        { _Pragma("unroll") for (int q4 = 0; q4 < 4; ++q4) ownw[q4] = (int)pg8::pk_fp8x4o(ATT_CL(p[4 * q4]), ATT_CL(p[4 * q4 + 1]), ATT_CL(p[4 * q4 + 2]), ATT_CL(p[4 * q4 + 3]), ownw[q4]); mx_own = pmax; \
          *(v4i_*)(pb_l + (SL) * 8192 + wid * 1024 + lane * 16) = ownw; } \
        if (hi == 0) mx_l[(SL) * 256 + wid * 32 + r32] = pmax;
#define PVLOAD(VB, SL) \
        const v4i_ h0 = *(const v4i_*)(pb_l + (SL) * 8192 + (wid & 3) * 1024 + lane * 16), h1 = *(const v4i_*)(pb_l + (SL) * 8192 + ((wid & 3) + 4) * 1024 + lane * 16); \
        v8i_ vf[4]; _Pragma("unroll") for (int d0 = 0; d0 < 4; ++d0) { const char* vp3_ = vbase + (VB) * 16384 + d0 * 2048; \
            vf[d0] = __builtin_shufflevector(*(const v4i_*)(vp3_ + vc0), *(const v4i_*)(vp3_ + vc1), 0, 1, 2, 3, 4, 5, 6, 7); }
#define PVMMA(SCA) do { const v8i_ pa = __builtin_shufflevector(h0, h1, 0, 1, 2, 3, 4, 5, 6, 7); \
        _Pragma("unroll") for (int d0 = 0; d0 < 4; ++d0) o[d0] = __builtin_amdgcn_mfma_scale_f32_32x32x64_f8f6f4(pa, vf[d0], o[d0], 0, 0, 0, (SCA), 0, 0x7F7F7F7F); } while (0)
#define PVT(VB, SL) do { PVLOAD(VB, SL) PVMMA(0x7F7F7F7F); } while (0)
    float ref = 0.f, mnL = 0.f, mx_own = 0.f;
    f32x4 l4 = {0.f, 0.f, 0.f, 0.f}; f32x16 o[4] = {};
    f32x16 pA, pB;
    v4i_ ownw = {0, 0, 0, 0};
    DMAK(0, 0); DMAK(1, 64); DMAV(0, 0);
    VMW();
    __syncthreads();
    QKM(pA, 0); QKM(pB, 1);
    MASK(pA, 0) MASK(pB, 1)
    { PMAX(pA)
      if (hi == 0) mx_l[256 + wid * 32 + r32] = pmax;
      __syncthreads();
 ref = __builtin_ceilf(fmaxf(pmax, mx_l[256 + (wid ^ 4) * 32 + r32]) * C2); mnL = ATT_PSH - ref;
      if (2 < NT) DMAK(0, 128);
      SOFTPUB(pA, 0)
      VMW();
      __syncthreads(); }
#define SEG(BUF, t, cur, nxt) do { \
        if ((t) + 2 < NT) DMAK(BUF, ((t) + 2) * 64);                        \
        DMAV(BUF, (t) * 64); \
        const float pm2 = mx_l[((BUF) ^ 1) * 256 + (wid ^ 4) * 32 + r32]; \
        PVLOAD((BUF) ^ 1, (BUF) ^ 1) \
        int sca = 0x7F7F7F7F; \
        { const float mc2 = fmaxf(mx_own, pm2) * C2;                         \
          const bool up_ = mc2 - ref > ATT_TAU;                              \
          if (__any(up_)) { const float rn = up_ ? __builtin_ceilf(mc2) : ref; const float dl = ref - rn; const float alpha = __builtin_amdgcn_exp2f(dl); ref = rn; mnL = ATT_PSH - rn; l4 = l4 * alpha; \
              sca = (127 + (int)dl) * 0x01010101; \
              if (hi == 0) al_l[r32] = alpha; asm volatile("s_waitcnt lgkmcnt(0)" ::: "memory"); \
              _Pragma("unroll") for (int d_ = 0; d_ < 4; ++d_) _Pragma("unroll") for (int r = 0; r < 16; ++r) o[d_][r] *= al_l[att::crow(r, hi)]; } } \
        QKM(nxt, (BUF) ^ 1);                                                \
        PVMMA(sca); \
        { PMAX(cur) \
          SOFTPUB(cur, BUF) } \
        ATT_SCHED \
        if ((t) + 1 < NT) MASK(nxt, (t) + 1) \
        VMW(); \
        __syncthreads(); \
    } while (0)
    SEG(1, 1, pB, pA);
    for (int t = 2; t < NT; t += 2) { SEG(0, t, pA, pB); SEG(1, t + 1, pB, pA); }
    PVT(1, 1);
    float l_reg = (l4[0] + l4[1]) + (l4[2] + l4[3]);
    { auto rr = __builtin_amdgcn_permlane32_swap(__float_as_uint(l_reg), __float_as_uint(l_reg), false, false); l_reg = __uint_as_float(rr[0]) + __uint_as_float(rr[1]); }
    if (hi == 0) li_l[wid * 32 + r32] = l_reg;
    __syncthreads();
    { const float lt = (l_reg + li_l[(wid ^ 4) * 32 + r32]) * 4.0f; if (hi == 0) al_l[r32] = lt; asm volatile("s_waitcnt lgkmcnt(0)" ::: "memory"); }
    float rli[16];
#pragma unroll
    for (int r = 0; r < 16; ++r) rli[r] = __builtin_amdgcn_rcpf(al_l[att::crow(r, hi)]);
    bf16* Ow = O + (unsigned)((pr * 32) * OPI + role * 128);
#pragma unroll
    for (int r = 0; r < 16; ++r) { const int orow = att::crow(r, hi);
#pragma unroll
        for (int d0 = 0; d0 < 4; ++d0) { const float v = o[d0][r] * rli[r]; const float vn = __shfl_xor(v, 1);
            if ((r32 & 1) == 0) *(unsigned*)(Ow + (unsigned)(orow * OPI + d0 * 32 + r32)) = att::cvtpk(v, vn); } }
    __syncthreads();
#undef SEG
#undef PVT
#undef PVMMA
#undef PVLOAD
#undef SOFTPUB
#undef QKM
#undef MASK
#undef PMAX
#undef MX3
#undef VMW
#undef DMAV
#undef DMAK
}
}

constexpr int T = 32768, DM = 2048, SEQ = 16384, INW = 5120, NMEMT = 512, RMAX = 73728;
constexpr int NWAVES = 8;
constexpr float ALPHA = 1.4142135623730951f;
constexpr float LN_EPS = 1e-5f;
constexpr size_t MiB = 1u << 20;
constexpr size_t WS_CTL = 0, CTL_ZERO_BYTES = 1 * MiB;
constexpr size_t WS_CSN = 1 * MiB, WS_LOG = 5 * MiB;
constexpr size_t WS_TOKE = 13 * MiB, WS_TOKW = WS_TOKE + 256 * 1024, WS_TOKD = WS_TOKW + 256 * 1024, WS_WGC = WS_TOKD + 256 * 1024;
constexpr size_t WS_ROWW = 14 * MiB, WS_TILE = WS_ROWW + 512 * 1024, WS_ROWT = WS_TILE + 64 * 1024;
constexpr size_t WS_RS = 15 * MiB, WS_CSQ = 15 * MiB + 512 * 1024;
constexpr size_t WS_MEMB = 16 * MiB, WS_KV = 18 * MiB, WS_VTM = 19 * MiB;
constexpr size_t WS_WIN = 20 * MiB, WS_WOUT = 60 * MiB, WS_XQ = 76 * MiB, WS_XO = 80 * MiB, WS_MEMKV = 84 * MiB, WS_ROUT = 88 * MiB, WS_W13 = 90 * MiB, WS_W2 = 346 * MiB;
constexpr size_t WS_XA = 474 * MiB, WS_XB = 602 * MiB, WS_H = 730 * MiB, WS_QK8 = 1050 * MiB, WS_VT8 = 1114 * MiB, WS_END = 1146 * MiB;
constexpr size_t DO_MIX = 0, DO_OP = 128 * MiB, DO_QC = 0, DO_OC = 32 * MiB, DO_HB = 0;
constexpr int CW_BAR = 4096, CW_HO = 16384;
constexpr int RING_BYTES = 131072;
constexpr int LDSCTL_OFF = RING_BYTES, MISC_OFF = LDSCTL_OFF + 320, SCR_OFF = LDSCTL_OFF + 1024;
constexpr int LDS_BYTES = 147456;

#define GAS __attribute__((address_space(1)))
#define LAS __attribute__((address_space(3)))
typedef unsigned short bf16;
typedef unsigned v4u __attribute__((ext_vector_type(4)));
typedef unsigned v2u __attribute__((ext_vector_type(2)));
typedef float f32x4 __attribute__((ext_vector_type(4)));
typedef float f32x2 __attribute__((ext_vector_type(2)));
typedef float f32x16 __attribute__((ext_vector_type(16)));
typedef short bf16x8 __attribute__((ext_vector_type(8)));
typedef GAS unsigned gu32;
typedef GAS unsigned long long gu64;
#define RLX_AGENT __ATOMIC_RELAXED, __HIP_MEMORY_SCOPE_AGENT
#define LDS_WAIT() asm volatile("s_waitcnt lgkmcnt(0)" ::: "memory")
#define VM_WAIT() asm volatile("s_waitcnt vmcnt(0)" ::: "memory")
__device__ __forceinline__ unsigned f2bf(float f) { unsigned u = __builtin_bit_cast(unsigned, f); return (u + 0x7fffu + ((u >> 16) & 1u)) >> 16; }
__device__ __forceinline__ unsigned pk2(float lo, float hi) { return f2bf(lo) | (f2bf(hi) << 16); }
__device__ __forceinline__ float bflo(unsigned w) { return __uint_as_float(w << 16); }
__device__ __forceinline__ float bfhi(unsigned w) { return __uint_as_float(w & 0xffff0000u); }

#define XB_TMO      128
#define XB_XCNT(j)  (256  + 64 * (j))
#define XB_XSUB(j)  (1280 + 64 * (j))
#define XB_XGEN(j)  (2304 + 64 * (j))
#define XB_TOP      3328
#define XB_TOPGEN   3392
#define XCD_BAR_WORDS 3456
#define XB_SPIN_CAP (1u << 20)

__device__ __forceinline__ unsigned xb_ld(unsigned* p)              { return __hip_atomic_load(p, __ATOMIC_RELAXED, __HIP_MEMORY_SCOPE_AGENT); }
__device__ __forceinline__ unsigned xb_add(unsigned* p, unsigned v) { return __hip_atomic_fetch_add(p, v, __ATOMIC_RELAXED, __HIP_MEMORY_SCOPE_AGENT); }
__device__ __forceinline__ unsigned xb_xcc_id() { return (unsigned)__builtin_amdgcn_s_getreg((3 << 11) | 20) & 0xFu; }
#define XB_SPIN(cond, bar) do { unsigned _sp = 0; while (cond) { __builtin_amdgcn_s_sleep(1); \
    if ((++_sp & 255u) == 0u) { if (xb_ld(&(bar)[XB_TMO])) break; if (_sp > XB_SPIN_CAP) { atomicAdd(&(bar)[XB_TMO], 1u); break; } } } } while (0)

struct XcdBarrier { unsigned* bar; unsigned x; volatile LAS unsigned* st; };
__device__ __forceinline__ XcdBarrier xcd_barrier_post(unsigned* bar, volatile LAS unsigned* st) {
    XcdBarrier b; b.bar = bar; b.x = xb_xcc_id(); b.st = st;
    if (threadIdx.x == 0) (void)xb_add(&bar[XB_XCNT(b.x)], 1u);
    return b;
}
__device__ __forceinline__ void xcd_barrier_complete(unsigned* bar, unsigned x, unsigned& nloc, unsigned& nx) {
    const unsigned G = gridDim.x * gridDim.y * gridDim.z;
    unsigned sum, cnt, mine, sp = 0u;
    for (;;) {
        sum = 0u; cnt = 0u; mine = 0u;
#pragma unroll
        for (unsigned j = 0; j < 16; ++j) { const unsigned c = xb_ld(&bar[XB_XCNT(j)]); sum += c; cnt += (c > 0u) ? 1u : 0u; mine = (j == x) ? c : mine; }
        if (sum == G) break;
        __builtin_amdgcn_s_sleep(1);
        if ((++sp & 255u) == 0u) { if (xb_ld(&bar[XB_TMO])) break; if (sp > XB_SPIN_CAP) { atomicAdd(&bar[XB_TMO], 1u); break; } }
    }
    nloc = mine > 0u ? mine : 1u; nx = cnt > 0u ? cnt : 1u;
}
__device__ __forceinline__ void xcd_barrier(const XcdBarrier& b) {
    asm volatile("s_waitcnt vmcnt(0)" ::: "memory");
    __syncthreads();
    if (threadIdx.x == 0) {
        unsigned* bar = b.bar;
        __builtin_amdgcn_s_waitcnt(0);
        unsigned nloc = b.st[0], nx = b.st[1];
        if (nloc == 0u) { xcd_barrier_complete(bar, b.x, nloc, nx); b.st[0] = nloc; b.st[1] = nx; }
        const unsigned old = xb_add(&bar[XB_XSUB(b.x)], 1u);
        const unsigned gen = old / nloc;
        if (old + 1u == (gen + 1u) * nloc) {
            __builtin_amdgcn_fence(__ATOMIC_RELEASE, "agent");
            asm volatile("s_waitcnt vmcnt(0)" ::: "memory");
            const unsigned og = xb_add(&bar[XB_TOP], 1u);
            const unsigned tg = og / nx;
            if (og + 1u == (tg + 1u) * nx) xb_add(&bar[XB_TOPGEN], 1u);
            else XB_SPIN(xb_ld(&bar[XB_TOPGEN]) == tg, bar);
            __builtin_amdgcn_fence(__ATOMIC_ACQUIRE, "agent");
            xb_add(&bar[XB_XGEN(b.x)], 1u);
            asm volatile("s_waitcnt vmcnt(0)" ::: "memory");
        } else {
            XB_SPIN(xb_ld(&bar[XB_XGEN(b.x)]) == gen, bar);
            __builtin_amdgcn_fence(__ATOMIC_ACQUIRE, "agent");
            asm volatile("s_waitcnt vmcnt(0)" ::: "memory");
        }
    }
    __syncthreads();
}

struct Args { const void* in[35]; unsigned char* out; unsigned char* ws; int ph_lo, ph_hi; };
struct Frame {
    LAS unsigned char* lds; volatile LAS unsigned* MISC;
    int tid, lane, wave, G, bx;
};
constexpr int TAB_OFF = LDSCTL_OFF + 512;
__device__ __forceinline__ unsigned char* tabp(const Frame& F, int k) {
    const volatile LAS unsigned* t = (const volatile LAS unsigned*)(F.lds + TAB_OFF) + 2 * k;
    const unsigned lo = __builtin_amdgcn_readfirstlane(t[0]), hi = __builtin_amdgcn_readfirstlane(t[1]);
    return (unsigned char*)((GAS unsigned char*)(((unsigned long long)hi << 32) | lo));
}
#define INP(k) ((const float*)tabp(F, (k)))
#define INPI(k) ((const int*)tabp(F, (k)))
#define WSP() (tabp(F, 36))
#define OUTP() (tabp(F, 35))
__device__ __forceinline__ void refresh(Frame& F) {
    int t = F.tid; asm volatile("" : "+v"(t)); F.tid = t; F.lane = t & 63; F.wave = __builtin_amdgcn_readfirstlane(t >> 6);
    int g = F.G, b = F.bx; asm volatile("" : "+s"(g), "+s"(b)); F.G = g; F.bx = b;
}
template <int CTRL> __device__ __forceinline__ float dpp_f(float v) { return __builtin_bit_cast(float, __builtin_amdgcn_update_dpp(0, __builtin_bit_cast(int, v), CTRL, 0xF, 0xF, false)); }
__device__ __forceinline__ float wave_sum(float v) {
    v += dpp_f<0xB1>(v);
    v += dpp_f<0x4E>(v);
    v += dpp_f<0x141>(v);
    v += dpp_f<0x140>(v);
    { auto r = __builtin_amdgcn_permlane16_swap(__float_as_uint(v), __float_as_uint(v), false, false); v = __uint_as_float(r[0]) + __uint_as_float(r[1]); }
    { auto r = __builtin_amdgcn_permlane32_swap(__float_as_uint(v), __float_as_uint(v), false, false); v = __uint_as_float(r[0]) + __uint_as_float(r[1]); }
    return v;
}
__constant__ double INVF_REV[16] = {0.15915494309189535, 0.0700865215877985, 0.03086376340470123, 0.013591370636193905, 0.005985185712713705, 0.002635675898667414,
    0.001160663641240061, 0.0005111175045375439, 0.00022507907903927653, 9.911730936901935e-05, 4.364795279280289e-05, 1.9221100684944863e-05,
    8.464330808241401e-06, 3.727408601915352e-06, 1.6414262627950345e-06, 7.228293068832865e-07};

struct TDesc { const float* src; bf16* dst; int N, K; const float* gs; };
__device__ __forceinline__ TDesc tr_decode(const Frame& F, unsigned char* ws, int it) {
    int r = it; const float* W; bf16* WT; int K, N, nblk, q; int mode = 0; const float* gs = nullptr;
    if (r < 5120) { const int l = r / 2560; q = r % 2560; W = INP(3) + (size_t)l * 2048 * 5120; K = 2048; N = 5120; nblk = 80; WT = (bf16*)(ws + WS_WIN) + (size_t)l * 5120 * 2048; if (l == 0) mode = 4; }
    else if ((r -= 5120) < 2048) { const int l = r / 1024; q = r % 1024; W = INP(4) + (size_t)l * 2048 * 2048; K = 2048; N = 2048; nblk = 32; WT = (bf16*)(ws + WS_WOUT) + (size_t)l * 2048 * 2048; }
    else if ((r -= 2048) < 512) { const int l = r / 256; q = r % 256; W = INP(26) + (size_t)l * 2048 * 512; K = 2048; N = 512; nblk = 8; WT = (bf16*)(ws + WS_XQ) + (size_t)l * 512 * 2048; gs = INP(5) + l * 2048; }
    else if ((r -= 512) < 512) { const int l = r / 256; q = r % 256; W = INP(27) + (size_t)l * 512 * 2048; K = 512; N = 2048; nblk = 32; WT = (bf16*)(ws + WS_XO) + (size_t)l * 2048 * 512; }
    else if ((r -= 512) < 512) { q = r; W = INP(25); K = 2048; N = 1024; nblk = 16; WT = (bf16*)(ws + WS_MEMKV); }
    else if ((r -= 512) < 16384) { const int le = r / 256; q = r % 256; W = INP(32) + (size_t)le * 2048 * 512; K = 2048; N = 512; nblk = 8; WT = (bf16*)(ws + WS_W13) + (size_t)le * 1024 * 2048; mode = 1; }
    else if ((r -= 16384) < 16384) { const int le = r / 256; q = r % 256; W = INP(33) + (size_t)le * 2048 * 512; K = 2048; N = 512; nblk = 8; WT = (bf16*)(ws + WS_W13) + (size_t)le * 1024 * 2048; mode = 2; }
    else { r -= 16384; const int le = r / 256; q = r % 256; W = INP(34) + (size_t)le * 512 * 2048; K = 512; N = 2048; nblk = 32; WT = (bf16*)(ws + WS_W2) + (size_t)le * 2048 * 512; }
    const int kb = q / nblk, nb = q % nblk, n0 = 64 * nb, k0 = 64 * kb;
    int drow = n0; if (mode == 1 || mode == 2) drow = (n0 >> 7) * 256 + (n0 & 127) + (mode == 2 ? 128 : 0);
    if (mode == 4) { mode = 0;
        if (n0 >= 4096) { const int cc = n0 - 4096; drow = 3072 + (cc >> 7) * 256 + 128 + (cc & 127); } else if (n0 >= 3072) { const int cc = n0 - 3072; drow = 3072 + (cc >> 7) * 256 + (cc & 127); } }
    TDesc d; d.src = W + (size_t)k0 * N + n0 + F.lane; d.dst = WT + (size_t)drow * K + k0; d.N = N; d.K = K; d.gs = gs ? gs + k0 : nullptr; return d;
}
#define TR_LOAD(d, wv) do { _Pragma("unroll") for (int i_ = 0; i_ < 64; ++i_) wv[i_] = __builtin_nontemporal_load((d).src + (size_t)i_ * (d).N); } while (0)
#define TR_STORE(d, wv) do { \
        if ((d).gs) { _Pragma("unroll") for (int i_ = 0; i_ < 64; ++i_) wv[i_] *= (d).gs[i_]; } \
        _Pragma("unroll") for (int i_ = 0; i_ < 32; ++i_) scr[F.lane * 33 + i_] = pk2(wv[2 * i_], wv[2 * i_ + 1]); \
        LDS_WAIT(); asm volatile("" ::: "memory"); \
        { const int c_ = F.lane & 7; \
          _Pragma("unroll") for (int j_ = 0; j_ < 8; ++j_) { const int n_ = (F.lane >> 3) + 8 * j_; const LAS unsigned* s_ = scr + n_ * 33 + 4 * c_; \
              v4u o_; o_.x = s_[0]; o_.y = s_[1]; o_.z = s_[2]; o_.w = s_[3]; \
              __builtin_nontemporal_store(o_, (v4u*)((d).dst + (size_t)n_ * (d).K + 8 * c_)); } } \
        LDS_WAIT(); asm volatile("" ::: "memory"); } while (0)
__device__ __forceinline__ void p_prologue(Frame& F, int dummy_) {
    unsigned char* ws = WSP();
    LAS unsigned* scr = (LAS unsigned*)(F.lds + F.wave * 16384);
    const int gw = F.bx * NWAVES + F.wave, NGW = F.G * NWAVES;
    constexpr int NITEMS = 5120 + 2048 + 512 + 512 + 512 + 16384 * 3;
    if (gw < NITEMS) {
        int it = gw; TDesc da = tr_decode(F, ws, it), db = da; float A[64], B[64]; TR_LOAD(da, A);
        for (;;) {
            const int itb = it + NGW; const bool hb = itb < NITEMS;
            if (hb) { db = tr_decode(F, ws, itb); TR_LOAD(db, B); }
            TR_STORE(da, A);
            if (!hb) break;
            const int ita = itb + NGW; const bool ha = ita < NITEMS;
            if (ha) { da = tr_decode(F, ws, ita); TR_LOAD(da, A); }
            TR_STORE(db, B);
            if (!ha) break;
            it = ita;
        }
    }
    const int gt = F.bx * 512 + F.tid, NT = F.G * 512;
    { bf16* RO = (bf16*)(ws + WS_ROUT); const float* rg = INP(28); const float* re = INP(30);
      for (int i = gt; i < 2 * 256 * 2048; i += NT) { const int l = i >> 19, n = (i >> 11) & 255, k = i & 2047;
          float v = 0.f; if (n < 4) v = rg[(size_t)l * 2048 * 4 + k * 4 + n]; else if (n < 36) v = re[(size_t)l * 2048 * 32 + k * 32 + (n - 4)];
          RO[i] = (bf16)f2bf(v); } }
    { const f32x4* x = (const f32x4*)INP(0); v4u* xa = (v4u*)(ws + WS_XA);
      for (int i0 = gt; i0 < T * DM / 8; i0 += 4 * NT) { f32x4 p[4], q[4];
#pragma unroll
          for (int u = 0; u < 4; ++u) { const int i = i0 + u * NT; if (i < T * DM / 8) { p[u] = __builtin_nontemporal_load(x + 2 * (size_t)i); q[u] = __builtin_nontemporal_load(x + 2 * (size_t)i + 1); } }
#pragma unroll
          for (int u = 0; u < 4; ++u) { const int i = i0 + u * NT; if (i < T * DM / 8) { v4u o; o.x = pk2(p[u][0], p[u][1]); o.y = pk2(p[u][2], p[u][3]); o.z = pk2(q[u][0], q[u][1]); o.w = pk2(q[u][2], q[u][3]); __builtin_nontemporal_store(o, xa + i); } } }
      const f32x4* m = (const f32x4*)INP(1); v4u* mb = (v4u*)(ws + WS_MEMB);
      for (int i = gt; i < NMEMT * DM / 8; i += NT) { const f32x4 p = m[2 * (size_t)i], q = m[2 * (size_t)i + 1]; v4u o; o.x = pk2(p[0], p[1]); o.y = pk2(p[2], p[3]); o.z = pk2(q[0], q[1]); o.w = pk2(q[2], q[3]); mb[i] = o; } }
    { const float* wq = INP(26); const float* g1 = INP(5); const float* b1 = INP(6); float* csq = (float*)(ws + WS_CSQ); LAS float* red = (LAS float*)(F.lds + SCR_OFF);
      for (int blk = F.bx; blk < 256; blk += F.G) { const int l = blk >> 7, n0 = (blk & 127) * 4, c = F.tid & 3, ks = F.tid >> 2;
          float s = 0.f, q = 0.f;
#pragma unroll
          for (int i = 0; i < 16; ++i) { const int k = ks * 16 + i; const float w = wq[((size_t)l * 2048 + k) * 512 + n0 + c]; s += __uint_as_float(f2bf(g1[l * 2048 + k] * w) << 16); q += b1[l * 2048 + k] * w; }
#pragma unroll
          for (int o = 4; o < 64; o <<= 1) { s += __shfl_xor(s, o); q += __shfl_xor(q, o); }
          __syncthreads();
          if (F.lane < 4) { red[F.wave * 8 + F.lane * 2] = s; red[F.wave * 8 + F.lane * 2 + 1] = q; }
          __syncthreads();
          if (F.tid < 8) { float a = 0.f;
#pragma unroll
              for (int w8 = 0; w8 < 8; ++w8) a += red[w8 * 8 + F.tid];
              csq[l * 1024 + (F.tid & 1) * 512 + n0 + (F.tid >> 1)] = a; } } }
    { const int* pos = INPI(2); float* csn = (float*)(ws + WS_CSN);
      for (int i = gt; i < T * 16; i += NT) { const int row = i >> 4, j = i & 15; double rev = (double)pos[row] * INVF_REV[j]; rev -= __builtin_rint(rev); const float f = (float)rev;
          csn[row * 32 + j] = __builtin_amdgcn_cosf(f); csn[row * 32 + 16 + j] = __builtin_amdgcn_sinf(f); } }
}

typedef att::BlockRef<att::bf16, att::bf16> ABlk;
#define DIFFBLK diff_block3
__device__ __forceinline__ void p_diff_attn2(Frame& F, char* lds, const bf16* H, bf16* OP) {
#if ATT_SATMODE
    __builtin_amdgcn_s_setreg((0 << 11) | (23 << 6) | 1, 1);
#endif
#if ATT_STATPRIO
    if (F.wave >= 4) __builtin_amdgcn_s_setprio(1);
#endif
    for (int L = F.bx; L < 1024; L += F.G) {
        const int c = L & 255, i = L >> 8, x = c & 7, k = c >> 3, combo = 2 * x + (i >> 1), b = combo >> 3, h = (combo >> 1) & 3, m = combo & 1, j = (i & 1) * 32 + k;
        const size_t row0 = (size_t)b * SEQ;
        for (int pass = 0; pass < 2; ++pass) { const int qb = pass ? 127 - j : j;
            const unsigned char* QK8 = WSP() + WS_QK8; const unsigned char* VT8 = WSP() + WS_VT8;
            att2::diff_block7<2048>(QK8 + (row0 + (size_t)qb * 128) * 2048 + (2 * h + m) * 128, QK8 + row0 * 2048 + 1024 + (2 * h + m) * 128,
                VT8 + ((size_t)b * 1024 + h * 256) * 16384, (att::bf16*)(OP + (row0 + (size_t)qb * 128) * 2048 + m * 1024 + h * 256), qb * 128, lds); }
    }
#if ATT_STATPRIO
    __builtin_amdgcn_s_setprio(0);
#endif
#if ATT_SATMODE
    __builtin_amdgcn_s_setreg((0 << 11) | (23 << 6) | 1, 0);
#endif
}
__device__ __forceinline__ ABlk cross_ref(const bf16* QC, const bf16* KV, bf16* OC, int L) {
    const int b = L >> 8, head = (L >> 6) & 3, qb = L & 63;
    ABlk r; const size_t row0 = (size_t)b * SEQ + (size_t)qb * 256;
    r.Q = (const att::bf16*)(QC + row0 * 512 + head * 128);
    r.K = (const att::bf16*)(KV + (size_t)b * 256 * 1024 + head * 128);
    r.V = (const att::bf16*)(KV + (size_t)b * 256 * 1024 + 512 + head * 128);
    r.O = (att::bf16*)(OC + row0 * 512 + head * 128);
    r.P0 = 1 << 20; return r;
}
__device__ __forceinline__ void p_cross_attn(Frame& F, char* lds, const bf16* QC, const bf16* KV, bf16* OC) {
    const int nblk = (512 - F.bx + F.G - 1) / F.G;
    if (nblk <= 0) return;
    att::Seam<att::bf16> S;
    ABlk cur = cross_ref(QC, KV, OC, F.bx);
    att::causal_swa_prime<att::bf16, att::bf16, 512, 1024, 512>(cur, 1 << 30, lds, S);
    for (int n = 0;; ++n) {
        const bool last = (n + 1 >= nblk);
        const ABlk nxt = last ? cur : cross_ref(QC, KV, OC, F.bx + (n + 1) * F.G);
        att::causal_swa_block<att::bf16, att::bf16, 512, 1024, 512>(cur, nxt, 256, 1 << 30, lds, S);
        if (last) break;
        cur = nxt;
    }
}

__device__ __forceinline__ void p_cross_attn2(Frame& F, char* lds, const bf16* QC, const bf16* KV, const bf16* VTM, bf16* OC) {
    typedef float f32x16_ __attribute__((ext_vector_type(16)));
    const int tid = F.tid, lane = F.lane, wid = F.wave, r32 = lane & 31, hi = lane >> 5;
    char* Kl = lds; char* Vl = lds + 65536;
    constexpr float C2 = 1.4426950408889634f * 0.08838834764831845f;
    for (int it = F.bx; it < 256; it += F.G) {
        const int bh = it >> 5, b = bh >> 2, head = bh & 3;
        __syncthreads();
        for (int i = tid; i < 4096; i += 512) { const int key = i >> 4, c = i & 15;
            const v4u x = *(const v4u*)(KV + ((size_t)(b * 256 + key)) * 1024 + head * 128 + c * 8);
            *(v4u*)(Kl + key * 256 + ((c ^ (key & 15)) << 4)) = x; }
        for (int i = tid; i < 2048; i += 512) { const int v = i >> 4, sg = i & 15; const bf16* src = VTM + (size_t)(head * 128 + v) * 512 + b * 256 + sg * 16;
            const v4u A = *(const v4u*)src, B = *(const v4u*)(src + 8);
            *(v4u*)(Vl + v * 512 + (((2 * sg) ^ (v & 31)) << 4)) = (v4u){A.x, A.y, B.x, B.y};
            *(v4u*)(Vl + v * 512 + (((2 * sg + 1) ^ (v & 31)) << 4)) = (v4u){A.z, A.w, B.z, B.w}; }
        __syncthreads();
        for (int qq = 0; qq < 2; ++qq) {
            const size_t row0 = (size_t)b * SEQ + (size_t)((it & 31) * 2 + qq) * 256 + wid * 32;
            bf16x8 qf[8];
#pragma unroll
            for (int ks = 0; ks < 8; ++ks) qf[ks] = *(const bf16x8*)(QC + (row0 + r32) * 512 + head * 128 + ks * 16 + hi * 8);
            f32x16_ o[4] = {}; float m = -3.0e38f, l = 0.f;
#pragma unroll
            for (int hf = 0; hf < 2; ++hf) {
                f32x16_ s[4];
#pragma unroll
                for (int kq = 0; kq < 4; ++kq) { s[kq] = (f32x16_){}; const int krow = (hf * 4 + kq) * 32 + r32;
#pragma unroll
                    for (int ks = 0; ks < 8; ++ks) { const bf16x8 kf = *(const bf16x8*)(Kl + krow * 256 + (((2 * ks + hi) ^ (krow & 15)) << 4));
                        s[kq] = __builtin_amdgcn_mfma_f32_32x32x16_bf16(kf, qf[ks], s[kq], 0, 0, 0); } }
                float mh = s[0][0];
#pragma unroll
                for (int kq = 0; kq < 4; ++kq)
#pragma unroll
                    for (int r = 0; r < 16; ++r) mh = fmaxf(mh, s[kq][r]);
                { auto rr = __builtin_amdgcn_permlane32_swap(__float_as_uint(mh), __float_as_uint(mh), false, false); mh = fmaxf(__uint_as_float(rr[0]), __uint_as_float(rr[1])); }
                const float mn = fmaxf(m, mh);
                if (hf == 1) { const float al = __builtin_amdgcn_exp2f((m - mn) * C2); l *= al;
#pragma unroll
                    for (int vb = 0; vb < 4; ++vb) o[vb] = o[vb] * al; }
                m = mn; const float mo = -m * C2; float lh = 0.f;
#pragma unroll
                for (int kq = 0; kq < 4; ++kq)
#pragma unroll
                    for (int r = 0; r < 16; ++r) { const float e = __builtin_amdgcn_exp2f(s[kq][r] * C2 + mo); s[kq][r] = e; lh += e; }
                { auto rr = __builtin_amdgcn_permlane32_swap(__float_as_uint(lh), __float_as_uint(lh), false, false); lh = __uint_as_float(rr[0]) + __uint_as_float(rr[1]); }
                l += lh;
#pragma unroll
                for (int kq = 0; kq < 4; ++kq)
#pragma unroll
                    for (int u = 0; u < 2; ++u) { v4u pw; pw.x = pg8::cvt_pk_bf16(s[kq][8 * u], s[kq][8 * u + 1]); pw.y = pg8::cvt_pk_bf16(s[kq][8 * u + 2], s[kq][8 * u + 3]);
                        pw.z = pg8::cvt_pk_bf16(s[kq][8 * u + 4], s[kq][8 * u + 5]); pw.w = pg8::cvt_pk_bf16(s[kq][8 * u + 6], s[kq][8 * u + 7]);
                        const bf16x8 pb = __builtin_bit_cast(bf16x8, pw);
#pragma unroll
                        for (int vb = 0; vb < 4; ++vb) { const int vrow = vb * 32 + r32;
                            const bf16x8 vf = *(const bf16x8*)(Vl + vrow * 512 + (((2 * (2 * (hf * 4 + kq) + u) + hi) ^ (vrow & 31)) << 4));
                            o[vb] = __builtin_amdgcn_mfma_f32_32x32x16_bf16(vf, pb, o[vb], 0, 0, 0); } }
            }
            const float rl = __builtin_amdgcn_rcpf(l);
            bf16* op = OC + (row0 + r32) * 512 + head * 128 + 4 * hi;
#pragma unroll
            for (int vb = 0; vb < 4; ++vb)
#pragma unroll
                for (int g = 0; g < 4; ++g) { v2u w; w.x = pg8::cvt_pk_bf16(o[vb][4 * g] * rl, o[vb][4 * g + 1] * rl); w.y = pg8::cvt_pk_bf16(o[vb][4 * g + 2] * rl, o[vb][4 * g + 3] * rl);
                    *(v2u*)(op + 32 * vb + 8 * g) = w; }
        }
    }
    __syncthreads();
}

__device__ __forceinline__ void p_combine(Frame& F, int dummy_, const bf16* OP, bf16* MIX) {
    const float* lq1 = INP(11); const float* lk1 = INP(12); const float* lq2 = INP(13); const float* lk2 = INP(14);
    const float* sg = INP(15);
    const int l = F.lane;
    const float d1 = wave_sum(lq1[l] * lk1[l] + lq1[l + 64] * lk1[l + 64]), d2 = wave_sum(lq2[l] * lk2[l] + lq2[l + 64] * lk2[l + 64]);
    const float lam = __expf(d1) - __expf(d2) + 0.2f;
    const int h = l >> 4, d0 = (l & 15) * 16;
    float g[16];
#pragma unroll
    for (int j = 0; j < 16; ++j) g[j] = sg[d0 + j] * 0.8f;
    const int gw = F.bx * NWAVES + F.wave, NGW = F.G * NWAVES;
    for (int row = gw; row < T; row += NGW) {
        const v4u* p1 = (const v4u*)(OP + (size_t)row * 2048 + h * 256 + d0); const v4u* p2 = (const v4u*)(OP + (size_t)row * 2048 + 1024 + h * 256 + d0);
        const v4u a0 = __builtin_nontemporal_load(p1), a1 = __builtin_nontemporal_load(p1 + 1), b0 = __builtin_nontemporal_load(p2), b1 = __builtin_nontemporal_load(p2 + 1);
        float o[16];
        o[0] = bflo(a0.x) - lam * bflo(b0.x); o[1] = bfhi(a0.x) - lam * bfhi(b0.x); o[2] = bflo(a0.y) - lam * bflo(b0.y); o[3] = bfhi(a0.y) - lam * bfhi(b0.y);
        o[4] = bflo(a0.z) - lam * bflo(b0.z); o[5] = bfhi(a0.z) - lam * bfhi(b0.z); o[6] = bflo(a0.w) - lam * bflo(b0.w); o[7] = bfhi(a0.w) - lam * bfhi(b0.w);
        o[8] = bflo(a1.x) - lam * bflo(b1.x); o[9] = bfhi(a1.x) - lam * bfhi(b1.x); o[10] = bflo(a1.y) - lam * bflo(b1.y); o[11] = bfhi(a1.y) - lam * bfhi(b1.y);
        o[12] = bflo(a1.z) - lam * bflo(b1.z); o[13] = bfhi(a1.z) - lam * bfhi(b1.z); o[14] = bflo(a1.w) - lam * bflo(b1.w); o[15] = bfhi(a1.w) - lam * bfhi(b1.w);
        float ss = 0.f;
#pragma unroll
        for (int j = 0; j < 16; ++j) ss += o[j] * o[j];
        ss += __shfl_xor(ss, 1); ss += __shfl_xor(ss, 2); ss += __shfl_xor(ss, 4); ss += __shfl_xor(ss, 8);
        const float rs = 1.0f / sqrtf(ss * (1.0f / 256.0f) + LN_EPS);
        v4u w0, w1;
        w0.x = pk2(o[0] * rs * g[0], o[1] * rs * g[1]); w0.y = pk2(o[2] * rs * g[2], o[3] * rs * g[3]); w0.z = pk2(o[4] * rs * g[4], o[5] * rs * g[5]); w0.w = pk2(o[6] * rs * g[6], o[7] * rs * g[7]);
        w1.x = pk2(o[8] * rs * g[8], o[9] * rs * g[9]); w1.y = pk2(o[10] * rs * g[10], o[11] * rs * g[11]); w1.z = pk2(o[12] * rs * g[12], o[13] * rs * g[13]); w1.w = pk2(o[14] * rs * g[14], o[15] * rs * g[15]);
        v4u* q = (v4u*)(MIX + (size_t)row * 2048 + h * 256 + d0); q[0] = w0; q[1] = w1;
    }
}

constexpr int CW_WQ = 8192;
__device__ __forceinline__ int wq_next(Frame& F, int k) {
    LAS int* slot = (LAS int*)(F.lds + SCR_OFF + 8192);
    __syncthreads();
    if (F.tid == 0) *slot = (int)__hip_atomic_fetch_add((unsigned*)(WSP() + WS_CTL) + CW_WQ + 64 * k, 1u, __ATOMIC_RELAXED, __HIP_MEMORY_SCOPE_AGENT);
    __syncthreads();
    return *slot;
}
template <int R> __device__ __forceinline__ void conv_rows(f32x2 (&acc)[32], const f32x2 (&w)[31], const LAS unsigned* ctt) {
    if constexpr (R < 62) {
        const unsigned p = ctt[R * 512]; const f32x2 val = (f32x2){bflo(p), bfhi(p)};
#pragma unroll
        for (int j = 0; j < 31; ++j) { if (R - j >= 0 && R - j < 32) acc[(R - j) & 31] = w[j] * val + acc[(R - j) & 31]; }
        conv_rows<R + 1>(acc, w, ctt);
    }
}
__device__ __forceinline__ void p_conformer(Frame& F, int dummy_, const bf16* H, bf16* MIX) {
    const float* cw = INP(16); const float* cb = INP(17); const float* cg = INP(18); const float* cbeta = INP(19);
    LAS unsigned* ct = (LAS unsigned*)F.lds;
    LAS float* red = (LAS float*)(F.lds + SCR_OFF);
    LAS float* stat = (LAS float*)(F.lds + SCR_OFF + 1024);
    const int tid = F.tid;
    f32x2 w[31];
#pragma unroll
    for (int j = 0; j < 31; ++j) w[j] = *(const f32x2*)(cw + j * 1024 + 2 * tid);
    const f32x2 bb = *(const f32x2*)(cb + 2 * tid), gg = *(const f32x2*)(cg + 2 * tid), be = *(const f32x2*)(cbeta + 2 * tid);
    for (;;) {
        const int item = wq_next(F, 0); if (item >= T / 32) break;
        const int t0 = item * 32, tl0 = t0 & (SEQ - 1);
        { const int cgp = tid & 127, rq = tid >> 7;
#pragma unroll 4
          for (int r = rq; r < 64; r += 4) { const int tl = tl0 - 30 + r; v4u o = (v4u){0u, 0u, 0u, 0u};
              if (r < 62 && tl >= 0) o = *(const v4u*)(H + (size_t)(t0 - 30 + r) * INW + 3072 + cgp * 8);
              if (r < 62) *(LAS v4u*)(ct + r * 512 + cgp * 4) = o; } }
        __syncthreads();
        f32x2 acc[32];
#pragma unroll
        for (int t = 0; t < 32; ++t) acc[t] = bb;
        conv_rows<0>(acc, w, ct + tid);
#pragma unroll
        for (int t = 0; t < 32; ++t) { const float s = wave_sum(acc[t].x + acc[t].y); if (F.lane == 0) red[F.wave * 32 + t] = s; }
        __syncthreads();
        if (tid < 32) { float s = 0.f;
#pragma unroll
            for (int k = 0; k < 8; ++k) s += red[k * 32 + tid]; stat[tid] = s * (1.0f / 1024.0f); }
        __syncthreads();
#pragma unroll
        for (int t = 0; t < 32; ++t) { const float mu = stat[t]; acc[t] = acc[t] - mu; }
        __syncthreads();
#pragma unroll
        for (int t = 0; t < 32; ++t) { const float s = wave_sum(acc[t].x * acc[t].x + acc[t].y * acc[t].y); if (F.lane == 0) red[F.wave * 32 + t] = s; }
        __syncthreads();
        if (tid < 32) { float s = 0.f;
#pragma unroll
            for (int k = 0; k < 8; ++k) s += red[k * 32 + tid]; stat[tid] = 1.0f / sqrtf(s * (1.0f / 1024.0f) + LN_EPS); }
        __syncthreads();
#pragma unroll
        for (int t = 0; t < 32; ++t) { const float rs = stat[t]; const float y0 = acc[t].x * rs * gg.x + be.x, y1 = acc[t].y * rs * gg.y + be.y;
            const float s0 = y0 * __builtin_amdgcn_rcpf(1.f + __expf(-y0)), s1 = y1 * __builtin_amdgcn_rcpf(1.f + __expf(-y1));
            *(unsigned*)(MIX + (size_t)(t0 + t) * 2048 + 1024 + 2 * tid) = pk2(s0, s1); }
    }
    __syncthreads();
}

__device__ __forceinline__ void p_sgu(Frame& F, int dummy_, const bf16* H, bf16* MIX) {
    const float* lg = INP(20); const float* lb = INP(21); const float* sw = INP(22); const float* sb = INP(23);
    constexpr int VP = 136;
    constexpr int OPP = 264;
    LAS bf16* vgt = (LAS bf16*)F.lds;
    LAS bf16* wl = (LAS bf16*)(F.lds + 256 * VP * 2);
    LAS float* st = (LAS float*)(F.lds + 256 * VP * 2 + 128 * VP * 2);
    const int tid = F.tid, lane = F.lane, wid = F.wave;
    const int wt = tid >> 2, wsq = tid & 3;
    const int s2 = tid & 63, cq = tid >> 6;
    const int c8 = (tid & 31) * 8, tq = tid >> 5;
    for (int chunk = F.bx; chunk < T / 128; chunk += F.G) {
        const size_t r0 = (size_t)chunk * 128;
        __syncthreads();
        f32x4 wp[8]; v4u za[4], zb[4];
#define SGU_LOADG(g_) do { const float* wp_ = sw + ((size_t)(g_) * 128 + wt) * 128 + wsq * 32; _Pragma("unroll") for (int k = 0; k < 8; ++k) wp[k] = *(const f32x4*)(wp_ + 4 * k); \
            const bf16* zp_ = H + (r0 + 2 * s2) * INW + 1024 + (g_) * 256 + cq * 32; _Pragma("unroll") for (int k = 0; k < 4; ++k) { za[k] = *(const v4u*)(zp_ + 8 * k); zb[k] = *(const v4u*)(zp_ + INW + 8 * k); } } while (0)
        SGU_LOADG(0);
        for (int r8 = 0; r8 < 16; r8 += 8) { v4u z0[8], z1[8];
#pragma unroll
          for (int i = 0; i < 8; ++i) { const bf16* zp = H + (r0 + wid * 16 + r8 + i) * INW + 1024 + lane * 8; z0[i] = *(const v4u*)zp; z1[i] = *(const v4u*)(zp + 512); }
#pragma unroll
          for (int i = 0; i < 8; ++i) {
              float v[16] = {bflo(z0[i].x), bfhi(z0[i].x), bflo(z0[i].y), bfhi(z0[i].y), bflo(z0[i].z), bfhi(z0[i].z), bflo(z0[i].w), bfhi(z0[i].w), bflo(z1[i].x), bfhi(z1[i].x), bflo(z1[i].y), bfhi(z1[i].y), bflo(z1[i].z), bfhi(z1[i].z), bflo(z1[i].w), bfhi(z1[i].w)};
              float sm = 0.f;
#pragma unroll
              for (int j = 0; j < 16; ++j) sm += v[j];
              const float mu = wave_sum(sm) * (1.0f / 1024.0f); float q = 0.f;
#pragma unroll
              for (int j = 0; j < 16; ++j) { const float d = v[j] - mu; q += d * d; }
              const float rs = 1.0f / sqrtf(wave_sum(q) * (1.0f / 1024.0f) + LN_EPS);
              if (lane == 0) { st[2 * (wid * 16 + r8 + i)] = mu; st[2 * (wid * 16 + r8 + i) + 1] = rs; } } }
        for (int g = 0; g < 4; ++g) {
            __syncthreads();
            {
#pragma unroll
              for (int k = 0; k < 4; ++k) { const f32x4 p = wp[2 * k], q = wp[2 * k + 1]; const int s0 = wsq * 32 + 8 * k, t = wt;
                  v4u o; o.x = pk2(s0 + 0 <= t ? p[0] : 0.f, s0 + 1 <= t ? p[1] : 0.f); o.y = pk2(s0 + 2 <= t ? p[2] : 0.f, s0 + 3 <= t ? p[3] : 0.f);
                  o.z = pk2(s0 + 4 <= t ? q[0] : 0.f, s0 + 5 <= t ? q[1] : 0.f); o.w = pk2(s0 + 6 <= t ? q[2] : 0.f, s0 + 7 <= t ? q[3] : 0.f);
                  *(LAS v4u*)(wl + t * VP + s0) = o; } }
            { const float mu0 = st[4 * s2], rs0 = st[4 * s2 + 1], mu1 = st[4 * s2 + 2], rs1 = st[4 * s2 + 3];
#pragma unroll
              for (int k = 0; k < 4; ++k) { const int c0 = cq * 32 + 8 * k; const float* gp = lg + g * 256 + c0; const float* bp = lb + g * 256 + c0;
                  const f32x4 g0 = *(const f32x4*)gp, g1 = *(const f32x4*)(gp + 4), b0 = *(const f32x4*)bp, b1 = *(const f32x4*)(bp + 4);
                  LAS unsigned* vo = (LAS unsigned*)(vgt + c0 * VP + 2 * s2);
#define NRM(zw, half, gv, bv, mu_, rs_) ((half ? bfhi(zw) : bflo(zw)) - mu_) * rs_ * gv + bv
                  vo[0 * (VP / 2)] = pk2(NRM(za[k].x, 0, g0[0], b0[0], mu0, rs0), NRM(zb[k].x, 0, g0[0], b0[0], mu1, rs1));
                  vo[1 * (VP / 2)] = pk2(NRM(za[k].x, 1, g0[1], b0[1], mu0, rs0), NRM(zb[k].x, 1, g0[1], b0[1], mu1, rs1));
                  vo[2 * (VP / 2)] = pk2(NRM(za[k].y, 0, g0[2], b0[2], mu0, rs0), NRM(zb[k].y, 0, g0[2], b0[2], mu1, rs1));
                  vo[3 * (VP / 2)] = pk2(NRM(za[k].y, 1, g0[3], b0[3], mu0, rs0), NRM(zb[k].y, 1, g0[3], b0[3], mu1, rs1));
                  vo[4 * (VP / 2)] = pk2(NRM(za[k].z, 0, g1[0], b1[0], mu0, rs0), NRM(zb[k].z, 0, g1[0], b1[0], mu1, rs1));
                  vo[5 * (VP / 2)] = pk2(NRM(za[k].z, 1, g1[1], b1[1], mu0, rs0), NRM(zb[k].z, 1, g1[1], b1[1], mu1, rs1));
                  vo[6 * (VP / 2)] = pk2(NRM(za[k].w, 0, g1[2], b1[2], mu0, rs0), NRM(zb[k].w, 0, g1[2], b1[2], mu1, rs1));
                  vo[7 * (VP / 2)] = pk2(NRM(za[k].w, 1, g1[3], b1[3], mu0, rs0), NRM(zb[k].w, 1, g1[3], b1[3], mu1, rs1));
#undef NRM
              } }
            if (g + 1 < 4) SGU_LOADG(g + 1);
            __syncthreads();
            const int wr = wid >> 1, wc = wid & 1, r32 = lane & 31, hi = lane >> 5;
            f32x16 acc[4] = {};
            for (int ks = 0; ks < 2 * wr + 2; ++ks) { const bf16x8 af = *(const LAS bf16x8*)(wl + (wr * 32 + r32) * VP + ks * 16 + hi * 8);
#pragma unroll
                for (int cb = 0; cb < 4; ++cb) { const bf16x8 bfr = *(const LAS bf16x8*)(vgt + (wc * 128 + cb * 32 + r32) * VP + ks * 16 + hi * 8);
                    acc[cb] = __builtin_amdgcn_mfma_f32_32x32x16_bf16(af, bfr, acc[cb], 0, 0, 0); } }
            __syncthreads();
            LAS bf16* ot = vgt;
#pragma unroll
            for (int r = 0; r < 16; ++r) { const int t = wr * 32 + (r & 3) + 8 * (r >> 2) + 4 * hi; const float bias = sb[g * 128 + t];
#pragma unroll
                for (int cb = 0; cb < 4; ++cb) ot[t * OPP + wc * 128 + cb * 32 + r32] = (bf16)f2bf(acc[cb][r] + bias); }
            __syncthreads();
#pragma unroll
            for (int k = 0; k < 8; ++k) { const int t = tq + 16 * k; const v4u sv = *(const LAS v4u*)(ot + t * OPP + c8); v4u o; const v4u uk = *(const v4u*)(H + (r0 + t) * INW + g * 256 + c8);
                o.x = pk2(bflo(uk.x) * bflo(sv.x), bfhi(uk.x) * bfhi(sv.x)); o.y = pk2(bflo(uk.y) * bflo(sv.y), bfhi(uk.y) * bfhi(sv.y));
                o.z = pk2(bflo(uk.z) * bflo(sv.z), bfhi(uk.z) * bfhi(sv.z)); o.w = pk2(bflo(uk.w) * bflo(sv.w), bfhi(uk.w) * bfhi(sv.w));
                *(v4u*)(MIX + (r0 + t) * 2048 + g * 256 + c8) = o; }
        }
#undef SGU_LOADG
    }
    __syncthreads();
}
__device__ __forceinline__ void p_sconv(Frame& F, int dummy_, const bf16* H, bf16* MIX) {
    const float* scw = INP(24);
    const int cgp = F.tid & 127, run = F.tid >> 7;
    float w0[8], w1[8], w2[8];
#pragma unroll
    for (int j = 0; j < 8; ++j) { w0[j] = scw[cgp * 8 + j]; w1[j] = scw[1024 + cgp * 8 + j]; w2[j] = scw[2048 + cgp * 8 + j]; }
    for (;;) {
        const int item = wq_next(F, 1); if (item >= T / 64) break;
        const int t0 = item * 64 + run * 16; const int tl0 = t0 & (SEQ - 1);
        float pm2[8], pm1[8];
#pragma unroll
        for (int j = 0; j < 8; ++j) { pm2[j] = 0.f; pm1[j] = 0.f; }
        for (int tt = -2; tt < 16; ++tt) {
            if (tl0 + tt < 0) continue;
            const bf16* hp = H + (size_t)(t0 + tt) * INW + 2048 + cgp * 8;
            const v4u gc = __builtin_nontemporal_load((const v4u*)(hp + 1024)), xi = __builtin_nontemporal_load((const v4u*)(hp + 2048));
            float p[8] = {bflo(gc.x) * bflo(xi.x), bfhi(gc.x) * bfhi(xi.x), bflo(gc.y) * bflo(xi.y), bfhi(gc.y) * bfhi(xi.y), bflo(gc.z) * bflo(xi.z), bfhi(gc.z) * bfhi(xi.z), bflo(gc.w) * bflo(xi.w), bfhi(gc.w) * bfhi(xi.w)};
            if (tt >= 0) { const v4u gb = __builtin_nontemporal_load((const v4u*)hp); const float gbf[8] = {bflo(gb.x), bfhi(gb.x), bflo(gb.y), bfhi(gb.y), bflo(gb.z), bfhi(gb.z), bflo(gb.w), bfhi(gb.w)};
                float o[8];
#pragma unroll
                for (int j = 0; j < 8; ++j) o[j] = gbf[j] * (w0[j] * pm2[j] + w1[j] * pm1[j] + w2[j] * p[j]);
                v4u w; w.x = pk2(o[0], o[1]); w.y = pk2(o[2], o[3]); w.z = pk2(o[4], o[5]); w.w = pk2(o[6], o[7]);
                *(v4u*)(MIX + (size_t)(t0 + tt) * 2048 + 1024 + cgp * 8) = w; }
#pragma unroll
            for (int j = 0; j < 8; ++j) { pm2[j] = pm1[j]; pm1[j] = p[j]; }
        }
    }
}

template <int MODE>
__device__ __forceinline__ void p_ln(Frame& F, bf16* Y, const bf16* YE, const int* tokd, float* OUTF, const float* gam, const float* bet) {
    const int l = F.lane;
    f32x4 g[8], b[8];
#pragma unroll
    for (int j = 0; j < 4; ++j) { g[2 * j] = *(const f32x4*)(gam + 8 * l + 512 * j); g[2 * j + 1] = *(const f32x4*)(gam + 8 * l + 512 * j + 4); b[2 * j] = *(const f32x4*)(bet + 8 * l + 512 * j); b[2 * j + 1] = *(const f32x4*)(bet + 8 * l + 512 * j + 4); }
    const int gw = F.bx * NWAVES + F.wave, NGW = F.G * NWAVES;
    for (int rowb = gw; rowb < T; rowb += 2 * NGW) {
        v4u w[2][4], e0[2][4], e1[2][4];
#pragma unroll
        for (int u = 0; u < 2; ++u) { const int row = rowb + u * NGW; if (row < T) { const bf16* yp = Y + (size_t)row * 2048 + 8 * l;
#pragma unroll
            for (int j = 0; j < 4; ++j) w[u][j] = __builtin_nontemporal_load((const v4u*)(yp + 512 * j));
            if constexpr (MODE == 1 || MODE == 2) { const int d0 = tokd[2 * row], d1 = tokd[2 * row + 1];
                const bf16* p0 = YE + (size_t)d0 * 2048 + 8 * l; const bf16* p1 = YE + (size_t)d1 * 2048 + 8 * l;
#pragma unroll
                for (int j = 0; j < 4; ++j) { e0[u][j] = __builtin_nontemporal_load((const v4u*)(p0 + 512 * j)); e1[u][j] = __builtin_nontemporal_load((const v4u*)(p1 + 512 * j));     } } } }
#pragma unroll
        for (int u = 0; u < 2; ++u) { const int row = rowb + u * NGW; if (row < T) {
            f32x4 v[8];
#pragma unroll
            for (int j = 0; j < 4; ++j) { v[2 * j] = (f32x4){bflo(w[u][j].x), bfhi(w[u][j].x), bflo(w[u][j].y), bfhi(w[u][j].y)}; v[2 * j + 1] = (f32x4){bflo(w[u][j].z), bfhi(w[u][j].z), bflo(w[u][j].w), bfhi(w[u][j].w)}; }
            if constexpr (MODE == 1 || MODE == 2) {
#pragma unroll
                for (int j = 0; j < 4; ++j) { const v4u w0 = e0[u][j], w1 = e1[u][j];
                    v[2 * j] = v[2 * j] * ALPHA + ((f32x4){bflo(w0.x), bfhi(w0.x), bflo(w0.y), bfhi(w0.y)} + (f32x4){bflo(w1.x), bfhi(w1.x), bflo(w1.y), bfhi(w1.y)});
                    v[2 * j + 1] = v[2 * j + 1] * ALPHA + ((f32x4){bflo(w0.z), bfhi(w0.z), bflo(w0.w), bfhi(w0.w)} + (f32x4){bflo(w1.z), bfhi(w1.z), bflo(w1.w), bfhi(w1.w)}); }
            }
            float sm = 0.f;
#pragma unroll
            for (int j = 0; j < 8; ++j) sm += (v[j][0] + v[j][1]) + (v[j][2] + v[j][3]);
            const float mu = wave_sum(sm) * (1.0f / 2048.0f); float q = 0.f;
#pragma unroll
            for (int j = 0; j < 8; ++j) { v[j] = v[j] - mu; q += (v[j][0] * v[j][0] + v[j][1] * v[j][1]) + (v[j][2] * v[j][2] + v[j][3] * v[j][3]); }
            const float rs = 1.0f / sqrtf(wave_sum(q) * (1.0f / 2048.0f) + LN_EPS);
#pragma unroll
            for (int j = 0; j < 8; ++j) v[j] = v[j] * rs * g[j] + b[j];
            if constexpr (MODE == 2) { float* op = OUTF + (size_t)row * 2048 + 8 * l;
#pragma unroll
                for (int j = 0; j < 4; ++j) { *(f32x4*)(op + 512 * j) = v[2 * j]; *(f32x4*)(op + 512 * j + 4) = v[2 * j + 1]; } }
            else { bf16* yp = (MODE == 3 ? (bf16*)OUTF : Y) + (size_t)row * 2048 + 8 * l;
#pragma unroll
                for (int j = 0; j < 4; ++j) { v4u o; o.x = pk2(v[2 * j][0], v[2 * j][1]); o.y = pk2(v[2 * j][2], v[2 * j][3]); o.z = pk2(v[2 * j + 1][0], v[2 * j + 1][1]); o.w = pk2(v[2 * j + 1][2], v[2 * j + 1][3]); *(v4u*)(yp + 512 * j) = o; } } } }
    }
}

__device__ __forceinline__ void p_router_route(Frame& F, int lyr, bf16* X, const float* gam, const float* bet) {
    typedef float f32x4_t __attribute__((ext_vector_type(4)));
    unsigned char* ws = WSP();
    const bf16* WR = (const bf16*)(ws + WS_ROUT) + (size_t)lyr * 256 * 2048;
    const float* rgb = INP(29) + lyr * 4; const float* reb = INP(31) + lyr * 32;
    int* toke = (int*)(ws + WS_TOKE); float* tokw = (float*)(ws + WS_TOKW); int* wgc = (int*)(ws + WS_WGC);
    constexpr int BP = 264;
    LAS bf16* Bs = (LAS bf16*)F.lds;
    LAS float* LGs = (LAS float*)(F.lds + 2 * 48 * BP * 2);
    LAS int* hist = (LAS int*)(F.lds + SCR_OFF);
    { int* rowt = (int*)(ws + WS_ROWT); for (int i = F.bx * 512 + F.tid; i < RMAX; i += F.G * 512) rowt[i] = 0; }
    const int tid = F.tid, lane = F.lane, wid = F.wave, r16 = lane & 15, kq = lane >> 4;
    for (int grp = F.bx; grp < T / 128; grp += F.G) {
        __syncthreads();
        if (tid < 32) hist[tid] = 0;
        { f32x4 g[8], b[8];
#pragma unroll
          for (int j = 0; j < 4; ++j) { g[2 * j] = *(const f32x4*)(gam + 8 * lane + 512 * j); g[2 * j + 1] = *(const f32x4*)(gam + 8 * lane + 512 * j + 4); b[2 * j] = *(const f32x4*)(bet + 8 * lane + 512 * j); b[2 * j + 1] = *(const f32x4*)(bet + 8 * lane + 512 * j + 4); }
          for (int it = 0; it < 8; ++it) { v4u w[2][4];
#pragma unroll
              for (int u = 0; u < 2; ++u) { const bf16* yp = X + ((size_t)grp * 128 + wid * 16 + 2 * it + u) * 2048 + 8 * lane;
#pragma unroll
                  for (int j = 0; j < 4; ++j) w[u][j] = *(const v4u*)(yp + 512 * j); }
#pragma unroll
              for (int u = 0; u < 2; ++u) { bf16* yp = X + ((size_t)grp * 128 + wid * 16 + 2 * it + u) * 2048 + 8 * lane; f32x4 v[8];
#pragma unroll
                  for (int j = 0; j < 4; ++j) { v[2 * j] = (f32x4){bflo(w[u][j].x), bfhi(w[u][j].x), bflo(w[u][j].y), bfhi(w[u][j].y)}; v[2 * j + 1] = (f32x4){bflo(w[u][j].z), bfhi(w[u][j].z), bflo(w[u][j].w), bfhi(w[u][j].w)}; }
                  float sm = 0.f;
#pragma unroll
                  for (int j = 0; j < 8; ++j) sm += (v[j][0] + v[j][1]) + (v[j][2] + v[j][3]);
                  const float mu = wave_sum(sm) * (1.0f / 2048.0f); float q = 0.f;
#pragma unroll
                  for (int j = 0; j < 8; ++j) { v[j] = v[j] - mu; q += (v[j][0] * v[j][0] + v[j][1] * v[j][1]) + (v[j][2] * v[j][2] + v[j][3] * v[j][3]); }
                  const float rs = 1.0f / sqrtf(wave_sum(q) * (1.0f / 2048.0f) + LN_EPS);
#pragma unroll
                  for (int j = 0; j < 4; ++j) { const f32x4 a0 = v[2 * j] * rs * g[2 * j] + b[2 * j], a1 = v[2 * j + 1] * rs * g[2 * j + 1] + b[2 * j + 1];
                      v4u o; o.x = pk2(a0[0], a0[1]); o.y = pk2(a0[2], a0[3]); o.z = pk2(a1[0], a1[1]); o.w = pk2(a1[2], a1[3]); *(v4u*)(yp + 512 * j) = o; } } }
          asm volatile("s_waitcnt vmcnt(0)" ::: "memory"); }
        const bf16* ap = X + ((size_t)grp * 128 + wid * 16 + r16) * 2048 + 8 * kq;
        f32x4_t acc[3] = {};
        bf16x8 a_cur[8], a_nxt[8]; v4u b_st[3];
#define RR_LOADB(ch) do { _Pragma("unroll") for (int j = 0; j < 3; ++j) { const int idx = tid + 512 * j, n = idx >> 5, c16 = idx & 31; b_st[j] = *(const v4u*)(WR + (size_t)n * 2048 + (ch) * 256 + 8 * c16); } } while (0)
#define RR_WRITEB(buf) do { _Pragma("unroll") for (int j = 0; j < 3; ++j) { const int idx = tid + 512 * j, n = idx >> 5, c16 = idx & 31; *(LAS v4u*)(Bs + (buf) * 48 * BP + n * BP + 8 * c16) = b_st[j]; } } while (0)
#define RR_LOADA(dst, ch) do { _Pragma("unroll") for (int ks = 0; ks < 8; ++ks) dst[ks] = *(const bf16x8*)(ap + (ch) * 256 + 32 * ks); } while (0)
        RR_LOADB(0); RR_LOADA(a_cur, 0);
        RR_WRITEB(0);
        __syncthreads();
#pragma unroll
        for (int ch = 0; ch < 8; ++ch) {
            if (ch + 1 < 8) { RR_LOADB(ch + 1); if (ch & 1) RR_LOADA(a_cur, ch + 1); else RR_LOADA(a_nxt, ch + 1); }
#pragma unroll
            for (int ks = 0; ks < 8; ++ks) { const bf16x8 af = (ch & 1) ? a_nxt[ks] : a_cur[ks];
#pragma unroll
                for (int cb = 0; cb < 3; ++cb) { const bf16x8 bfr = *(const LAS bf16x8*)(Bs + (ch & 1) * 48 * BP + (16 * cb + r16) * BP + 32 * ks + 8 * kq);
                    acc[cb] = __builtin_amdgcn_mfma_f32_16x16x32_bf16(af, bfr, acc[cb], 0, 0, 0); } }
            if (ch + 1 < 8) { RR_WRITEB((ch + 1) & 1); __syncthreads(); }
        }
#undef RR_LOADA
#undef RR_WRITEB
#undef RR_LOADB
#pragma unroll
        for (int cb = 0; cb < 3; ++cb)
#pragma unroll
            for (int t = 0; t < 4; ++t) LGs[(wid * 16 + 4 * kq + t) * 49 + 16 * cb + r16] = acc[cb][t];
        __syncthreads();
        if (tid < 128) { const int t = grp * 128 + tid; const LAS float* lp = LGs + tid * 49;
            float gl[4] = {lp[0] + rgb[0], lp[1] + rgb[1], lp[2] + rgb[2], lp[3] + rgb[3]};
            int gi = 0; float gm = gl[0];
#pragma unroll
            for (int j = 1; j < 4; ++j) if (gl[j] > gm) { gm = gl[j]; gi = j; }
            float den = 0.f;
#pragma unroll
            for (int j = 0; j < 4; ++j) den += __expf(gl[j] - gm);
            const float ggate = 1.0f / den;
            const LAS float* ep = lp + 4 + gi * 8; const float* rb = reb + gi * 8;
            float el[8] = {ep[0] + rb[0], ep[1] + rb[1], ep[2] + rb[2], ep[3] + rb[3], ep[4] + rb[4], ep[5] + rb[5], ep[6] + rb[6], ep[7] + rb[7]};
            int i0 = 0; float v0 = el[0];
#pragma unroll
            for (int j = 1; j < 8; ++j) if (el[j] > v0) { v0 = el[j]; i0 = j; }
            int i1 = -1; float v1 = -3.0e38f;
#pragma unroll
            for (int j = 0; j < 8; ++j) if (j != i0 && el[j] > v1) { v1 = el[j]; i1 = j; }
            const float p0 = 1.0f / (1.0f + __expf(v1 - v0)), p1 = 1.0f - p0;
            const int ea = gi * 8 + i0, eb = gi * 8 + i1;
            toke[2 * t] = ea; toke[2 * t + 1] = eb; tokw[2 * t] = p0 * ggate; tokw[2 * t + 1] = p1 * ggate;
            __hip_atomic_fetch_add(hist + ea, 1, __ATOMIC_RELAXED, __HIP_MEMORY_SCOPE_WORKGROUP); __hip_atomic_fetch_add(hist + eb, 1, __ATOMIC_RELAXED, __HIP_MEMORY_SCOPE_WORKGROUP); }
        __syncthreads();
        if (tid < 32) wgc[grp * 32 + tid] = hist[tid];
    }
    __syncthreads();
}
__device__ __forceinline__ void p_route(Frame& F, int dummy_, int lyr) {
    unsigned char* ws = WSP();
    const float* LG = (const float*)(OUTP() + DO_OP); const float* LG2 = LG + (size_t)T * 64; const float* rgb = INP(29) + lyr * 4; const float* reb = INP(31) + lyr * 32;
    int* toke = (int*)(ws + WS_TOKE); float* tokw = (float*)(ws + WS_TOKW); int* wgc = (int*)(ws + WS_WGC);
    LAS int* hist = (LAS int*)(F.lds + SCR_OFF);
    { int* rowt = (int*)(ws + WS_ROWT); for (int i = F.bx * 512 + F.tid; i < RMAX; i += F.G * 512) rowt[i] = 0; }
    for (int grp = F.bx; grp < T / 128; grp += F.G) {
        __syncthreads();
        if (F.tid < 32) hist[F.tid] = 0;
        __syncthreads();
        if (F.tid < 128) { const int t = grp * 128 + F.tid; const float* lp = LG + (size_t)t * 64;
            const float* lp2 = LG2 + (size_t)t * 64; const f32x4 gl4 = *(const f32x4*)lp + *(const f32x4*)lp2; float gl[4] = {gl4[0] + rgb[0], gl4[1] + rgb[1], gl4[2] + rgb[2], gl4[3] + rgb[3]};
            int gi = 0; float gm = gl[0];
#pragma unroll
            for (int j = 1; j < 4; ++j) if (gl[j] > gm) { gm = gl[j]; gi = j; }
            float den = 0.f;
#pragma unroll
            for (int j = 0; j < 4; ++j) den += __expf(gl[j] - gm);
            const float ggate = 1.0f / den;
            const f32x4 e0 = *(const f32x4*)(lp + 4 + gi * 8) + *(const f32x4*)(lp2 + 4 + gi * 8), e1 = *(const f32x4*)(lp + 8 + gi * 8) + *(const f32x4*)(lp2 + 8 + gi * 8); const float* rb = reb + gi * 8;
            float el[8] = {e0[0] + rb[0], e0[1] + rb[1], e0[2] + rb[2], e0[3] + rb[3], e1[0] + rb[4], e1[1] + rb[5], e1[2] + rb[6], e1[3] + rb[7]};
            int i0 = 0; float v0 = el[0];
#pragma unroll
            for (int j = 1; j < 8; ++j) if (el[j] > v0) { v0 = el[j]; i0 = j; }
            int i1 = -1; float v1 = -3.0e38f;
#pragma unroll
            for (int j = 0; j < 8; ++j) if (j != i0 && el[j] > v1) { v1 = el[j]; i1 = j; }
            const float p0 = 1.0f / (1.0f + __expf(v1 - v0)), p1 = 1.0f - p0;
            const int ea = gi * 8 + i0, eb = gi * 8 + i1;
            toke[2 * t] = ea; toke[2 * t + 1] = eb; tokw[2 * t] = p0 * ggate; tokw[2 * t + 1] = p1 * ggate;
            __hip_atomic_fetch_add(hist + ea, 1, __ATOMIC_RELAXED, __HIP_MEMORY_SCOPE_WORKGROUP); __hip_atomic_fetch_add(hist + eb, 1, __ATOMIC_RELAXED, __HIP_MEMORY_SCOPE_WORKGROUP); }
        __syncthreads();
        if (F.tid < 32) wgc[grp * 32 + F.tid] = hist[F.tid];
    }
    __syncthreads();
}
__device__ __forceinline__ void p_dispatch(Frame& F, int dummy_, const bf16* X, bf16* XG) {
    unsigned char* ws = WSP();
    const int* toke = (const int*)(ws + WS_TOKE); const float* tokw = (const float*)(ws + WS_TOKW); int* tokd = (int*)(ws + WS_TOKD); const int* wgc = (const int*)(ws + WS_WGC);
    float* roww = (float*)(ws + WS_ROWW); int* tile = (int*)(ws + WS_TILE); int* rowt = (int*)(ws + WS_ROWT);
    LAS int* part = (LAS int*)(F.lds + SCR_OFF);
    LAS int* base = part + 1024;
    LAS int* pst = base + 32;
    LAS int* earr = pst + 64;
    LAS int* darr = earr + 256;
    for (int grp = F.bx; grp < T / 128; grp += F.G) {
        __syncthreads();
        { const int e = F.tid & 31, p = F.tid >> 5; int below = 0, tot = 0;
          for (int i = p * 16; i < p * 16 + 16; ++i) { const int c = wgc[i * 32 + e]; tot += c; if (i < grp) below += c; }
          part[p * 32 + e] = below; part[512 + p * 32 + e] = tot; }
        __syncthreads();
        if (F.tid < 32) { int below = 0, tot = 0;
            for (int p = 0; p < 16; ++p) { below += part[p * 32 + F.tid]; tot += part[512 + p * 32 + F.tid]; }
            base[F.tid] = below; earr[F.tid] = tot; }
        __syncthreads();
        if (F.tid == 0) { int s = 0; for (int e = 0; e < 32; ++e) { pst[e] = s; s += (earr[e] + 255) & ~255; } pst[32] = s; }
        __syncthreads();
        if (grp == 0) {
            const int ntile = pst[32] >> 8;
            if (F.tid < 320) { int e = 0;
                for (int k = 1; k < 32; ++k) if (pst[k] <= F.tid * 256) e = k;
                tile[F.tid] = e; }
            if (F.tid == 0) tile[400] = ntile;
        }
        int mye = 0, mytok = 0;
        if (F.tid < 256) { mytok = grp * 128 + (F.tid >> 1); mye = toke[2 * mytok + (F.tid & 1)]; }
        __syncthreads();
        if (F.tid < 256) earr[F.tid] = mye;
        __syncthreads();
        if (F.tid < 256) { int rank = 0;
            for (int k = 0; k < F.tid; ++k) rank += (earr[k] == mye) ? 1 : 0;
            const int dest = pst[mye] + base[mye] + rank;
            tokd[2 * mytok + (F.tid & 1)] = dest; roww[dest] = tokw[2 * mytok + (F.tid & 1)]; rowt[dest] = mytok; }
        __syncthreads();
    }
    __syncthreads();
}

#ifndef ALIGN_SHORTK
#define ALIGN_SHORTK true
#endif
#ifndef ROUTER_GEMM
#define ROUTER_GEMM 0
#endif
#ifndef HO_BARRIER
#define HO_BARRIER false
#endif
#ifndef MIXSEL
#define MIXSEL 15
#endif
#ifndef PHMASK
#define PHMASK 0xFFFFFFFF
#endif
#define PH_ON(k) ((PHMASK >> (k)) & 1)
#ifndef DUPMASK
#define DUPMASK 0
#endif
#define REP(k) for (int rep_ = 0; rep_ < 1 + ((DUPMASK >> (k)) & 1); ++rep_)
__global__ void __launch_bounds__(NWAVES * 64, 2) fwd_kernel(Args args) {
    extern __shared__ __attribute__((aligned(16))) unsigned char lds[];
    Frame F;
    F.lds = (LAS unsigned char*)lds;
    F.MISC = (volatile LAS unsigned*)(F.lds + MISC_OFF);
    F.tid = threadIdx.x; F.lane = F.tid & 63; F.wave = __builtin_amdgcn_readfirstlane(F.tid >> 6);
    F.G = gridDim.x; F.bx = blockIdx.x;
    for (int u = F.tid; u < (LDS_BYTES - LDSCTL_OFF) / 4; u += NWAVES * 64) ((LAS unsigned*)(F.lds + LDSCTL_OFF))[u] = 0u;
    __syncthreads();
    if (F.tid < 37) { const unsigned long long p = F.tid < 35 ? (unsigned long long)args.in[F.tid] : (F.tid == 35 ? (unsigned long long)args.out : (unsigned long long)args.ws);
        LAS unsigned* t = (LAS unsigned*)(F.lds + TAB_OFF) + 2 * F.tid; t[0] = (unsigned)p; t[1] = (unsigned)(p >> 32); }
    const int lo = args.ph_lo, hi = args.ph_hi; int ph = 0;
    __syncthreads();
    XcdBarrier bar = xcd_barrier_post((unsigned*)(WSP() + WS_CTL) + CW_BAR, F.MISC + 8);
#define PHASE_BEGIN if (lo <= ph && ph < hi) { refresh(F); unsigned char* const ws = WSP(); unsigned char* const dout = OUTP(); (void)ws; (void)dout;
#define PHASE_END(sync) if ((sync) && ph + 1 < hi) xcd_barrier(bar); } ++ph;
#define XA_ ((bf16*)(ws + WS_XA))
#define XB_ ((bf16*)(ws + WS_XB))
#define HB_ ((bf16*)(ws + WS_H))
#define KV_ ((bf16*)(ws + WS_KV))
#define MIX_ ((bf16*)(dout + DO_MIX))
#define OPB_ ((bf16*)(dout + DO_OP))
#define QC_ ((bf16*)(dout + DO_QC))
#define OC_ ((bf16*)(dout + DO_OC))
#define HBM_ ((bf16*)(dout + DO_HB))

    PHASE_BEGIN
#if PH_ON(0)
        REP(0)
        p_prologue(F, 0);
#endif
#ifdef PROBE_BAR
        for (int xb_ = 0; xb_ < PROBE_BAR; ++xb_) xcd_barrier(bar);
#endif
    PHASE_END(true)
    for (int lyr = 0; lyr < 2; ++lyr) {
        PHASE_BEGIN
#if PH_ON(2)
        REP(2)
        {
            pg8::Gemm g{XA_, (const bf16*)(ws + WS_WIN) + (size_t)lyr * 5120 * 2048, T, INW, 2048, 2048}; pg8::StaticOrder S; S.init(T, lyr == 0 ? INW - 1024 : INW, F.G, F.bx);
            if (lyr == 0) { S.skip_lo = 8; S.skip_n = 4; }
            pg8::Epi<pg8::EM_WIN> E{HB_, INW, nullptr, (const float*)(ws + WS_CSN), (float*)(ws + WS_QK8), lyr, 0.f};
            pg8::gemm_phase<pg8::Epi<pg8::EM_WIN>, pg8::StaticOrder, true, true>(F.lds, g, S, E);
            if (lyr == 0) {
                pg8::Gemm g2{(const bf16*)(ws + WS_WIN) + (size_t)2048 * 2048, XA_, 1024, T, 2048, 2048}; pg8::StaticOrder S2; S2.init(1024, T, F.G, F.bx);
                pg8::Epi<pg8::EM_VT8> E2{(bf16*)(ws + WS_VT8), 0, nullptr, nullptr, nullptr, 0, 4.0f};
                pg8::gemm_phase<pg8::Epi<pg8::EM_VT8>, pg8::StaticOrder, true, true>(F.lds, g2, S2, E2);
            }
        }
#endif
        PHASE_END(true)
        PHASE_BEGIN
#if PH_ON(3)
        REP(3)
            if (lyr == 0) p_diff_attn2(F, (char*)lds, HB_, OPB_);
#endif
        PHASE_END(false)
        PHASE_BEGIN
#if PH_ON(1)
        REP(1)
        if (lyr == 0) {
            pg8::Gemm g{(const bf16*)(ws + WS_MEMB), (const bf16*)(ws + WS_MEMKV), NMEMT, 512, 2048, 2048}; pg8::StaticOrder S; S.init(NMEMT, 512, F.G, F.bx);
            pg8::Epi<pg8::EM_PLAIN> E{KV_, 1024, nullptr, nullptr, nullptr, 0, 0.f};
            pg8::gemm_phase<pg8::Epi<pg8::EM_PLAIN>, pg8::StaticOrder, true, true>(F.lds, g, S, E);
            pg8::Gemm g2{(const bf16*)(ws + WS_MEMKV) + (size_t)512 * 2048, (const bf16*)(ws + WS_MEMB), 512, NMEMT, 2048, 2048}; pg8::StaticOrder S2; S2.init(512, NMEMT, F.G, (F.bx + F.G - 4) % F.G);
            pg8::Epi<pg8::EM_PLAIN> E2{(bf16*)(ws + WS_VTM), 512, nullptr, nullptr, nullptr, 0, 0.f};
            pg8::gemm_phase<pg8::Epi<pg8::EM_PLAIN>, pg8::StaticOrder, true, true>(F.lds, g2, S2, E2);
        }
#endif
        PHASE_END(false)
        PHASE_BEGIN
#if PH_ON(4)
        REP(4)
            if (lyr == 0) p_conformer(F, 0, HB_, MIX_);
#endif
        PHASE_END(false)
        PHASE_BEGIN
#if PH_ON(5)
        REP(5)
            if (lyr == 1) p_sgu(F, 0, HB_, MIX_);
#endif
        PHASE_END(false)
        PHASE_BEGIN
#if PH_ON(6)
        REP(6)
            if (lyr == 1) p_sconv(F, 0, HB_, MIX_);
#endif
        PHASE_END(true)
        PHASE_BEGIN
#if PH_ON(7)
        REP(7)
            if (lyr == 0) p_combine(F, 0, OPB_, MIX_);
#endif
        PHASE_END(lyr == 0)
        PHASE_BEGIN
#if PH_ON(8)
        REP(8)
        {
            pg8::Gemm g{MIX_, (const bf16*)(ws + WS_WOUT) + (size_t)lyr * 2048 * 2048, T, 2048, 2048, 2048}; pg8::StaticOrder S; S.init(T, 2048, F.G, F.bx);
            pg8::Epi<pg8::EM_RESID_ST> E{XB_, 2048, XA_, nullptr, (float*)(ws + WS_LOG), 0, ALPHA};
            pg8::gemm_phase<pg8::Epi<pg8::EM_RESID_ST>, pg8::StaticOrder, true, true>(F.lds, g, S, E);
        }
#endif
        PHASE_END(true)
        PHASE_BEGIN
#if PH_ON(10)
        REP(10)
        {
            pg8::Gemm g{XB_, (const bf16*)(ws + WS_XQ) + (size_t)lyr * 512 * 2048, T, 512, 2048, 2048}; pg8::StaticOrder S; S.init(T, 512, F.G, F.bx);
            {
              const float* st = (const float*)(ws + WS_LOG); float* rs = (float*)(ws + WS_RS); pg8::Unit u;
              for (int i = 0; i < 8 && S.next(i, u); ++i) { const int row = u.pm * 256 + (F.tid >> 1), hf = F.tid & 1;
                  const f32x4* p = (const f32x4*)(st + ((size_t)row * 32 + hf * 16) * 2); float s1 = 0.f, s2 = 0.f;
#pragma unroll
                  for (int j = 0; j < 8; ++j) { const f32x4 v = p[j]; s1 += v[0] + v[2]; s2 += v[1] + v[3]; }
                  s1 += __shfl_xor(s1, 1); s2 += __shfl_xor(s2, 1);
                  const float mu = s1 * (1.0f / 2048.0f), var = fmaxf(s2 * (1.0f / 2048.0f) - mu * mu, 0.f);
                  if (hf == 0) *(f32x2*)(rs + 2 * (size_t)row) = (f32x2){mu, 1.0f / sqrtf(var + LN_EPS)}; }
              VM_WAIT(); __syncthreads(); }
            pg8::Epi<pg8::EM_XQ> E{QC_, 512, nullptr, (const float*)(ws + WS_RS), (float*)(ws + WS_CSQ) + lyr * 1024, 0, 0.f};
            pg8::gemm_phase<pg8::Epi<pg8::EM_XQ>, pg8::StaticOrder, true, true>(F.lds, g, S, E);
        }
#endif
        PHASE_END(true)
        PHASE_BEGIN
#if PH_ON(11)
        REP(11)
            p_cross_attn2(F, (char*)lds, QC_, KV_, (const bf16*)(ws + WS_VTM), OC_);
#endif
        PHASE_END(true)
        PHASE_BEGIN
#if PH_ON(12)
        REP(12)
        {
            pg8::Gemm g{OC_, (const bf16*)(ws + WS_XO) + (size_t)lyr * 2048 * 512, T, 2048, 512, 512}; pg8::StaticOrder S; S.init(T, 2048, F.G, F.bx);
            pg8::Epi<pg8::EM_RESID_LN> E{XA_, 2048, XB_, (const float*)(ws + WS_RS), nullptr, 0, ALPHA, INP(5) + lyr * 2048, INP(6) + lyr * 2048};
            pg8::gemm_phase<pg8::Epi<pg8::EM_RESID_LN>, pg8::StaticOrder, ALIGN_SHORTK, true>(F.lds, g, S, E);
        }
#endif
        PHASE_END(true)
#if ROUTER_GEMM
        PHASE_BEGIN
#if PH_ON(13)
        REP(13)
            p_ln<0>(F, XA_, nullptr, nullptr, nullptr, INP(7) + lyr * 2048, INP(8) + lyr * 2048);
#endif
        PHASE_END(true)
#endif
#if ROUTER_GEMM
        PHASE_BEGIN
#if PH_ON(14)
        REP(14)
        {
            pg8::Gemm g{XA_, (const bf16*)(ws + WS_ROUT) + (size_t)lyr * 256 * 2048, T, 256, 1024, 2048}; pg8::SplitK2Order S{T / 256, F.G, F.bx, 1024};
            pg8::Epi<pg8::EM_LOGITS> E{nullptr, 0, nullptr, nullptr, (float*)(dout + DO_OP), 0, 0.f};
            pg8::gemm_phase<pg8::Epi<pg8::EM_LOGITS>, pg8::SplitK2Order, true, true>(F.lds, g, S, E);
        }
#endif
        PHASE_END(true)
        PHASE_BEGIN
#if PH_ON(15)
        REP(15)
            p_route(F, 0, lyr);
#endif
        PHASE_END(true)
#else
        PHASE_BEGIN
#if PH_ON(14)
        REP(14)
            p_router_route(F, lyr, XA_, INP(7) + lyr * 2048, INP(8) + lyr * 2048);
#endif
        PHASE_END(true)
#endif
        PHASE_BEGIN
#if PH_ON(16)
        REP(16)
            p_dispatch(F, 0, XA_, HB_);
#endif
        PHASE_END(true)
        PHASE_BEGIN
#if PH_ON(17)
        REP(17)
        {
            const int* tile = (const int*)(ws + WS_TILE); const int ntile = tile[400];
            LAS int* rtab = (LAS int*)(F.lds + SCR_OFF);
            pg8::Gemm g{XA_, (const bf16*)(ws + WS_W13) + (size_t)lyr * 32 * 1024 * 2048, RMAX, 32 * 1024, 2048, 2048};
            pg8::MoeOrder1H S{tile, ntile, F.G, F.bx, rtab, (unsigned*)(ws + WS_CTL) + CW_HO + 64 * 288 * lyr, (unsigned*)(ws + WS_CTL) + CW_HO + 64 * (576 + 8 * lyr)};
            { const int* rowt = (const int*)(ws + WS_ROWT); pg8::Unit u;
              for (int i = 0; i < 8 && S.next(i, u); ++i) if (F.tid < 256) rtab[i * 256 + F.tid] = rowt[u.pm * 256 + F.tid];
              __syncthreads(); }
            pg8::Epi<pg8::EM_SWIGLU_WT> E{HBM_, 512, nullptr, nullptr, nullptr, 0, 0.f};
            pg8::gemm_phase_g<pg8::Epi<pg8::EM_SWIGLU_WT>, pg8::MoeOrder1H, true, true>(F.lds, g, S, E);
        }
#endif
        PHASE_END(HO_BARRIER)
        PHASE_BEGIN
#if PH_ON(18)
        REP(18)
        {
            const int* tile = (const int*)(ws + WS_TILE); const int ntile = tile[400];
            pg8::Gemm g{HBM_, (const bf16*)(ws + WS_W2) + (size_t)lyr * 32 * 2048 * 512, RMAX, 32 * 2048, 512, 512};
            pg8::MoeOrder2H S{tile, ntile, F.G, F.bx, (unsigned*)(ws + WS_CTL) + CW_HO + 64 * 288 * lyr, 32u, (unsigned*)(ws + WS_CTL) + CW_HO + 64 * (576 + 8 * lyr)};
            pg8::Epi<pg8::EM_ROWSCALE> E{HB_, 2048, nullptr, (const float*)(ws + WS_ROWW), nullptr, 0, 0.f};
            pg8::gemm_phase<pg8::Epi<pg8::EM_ROWSCALE>, pg8::MoeOrder2H, ALIGN_SHORTK, true>(F.lds, g, S, E);
        }
#endif
        PHASE_END(true)
        PHASE_BEGIN
#if PH_ON(19)
        REP(19)
            if (lyr == 0) p_ln<1>(F, XA_, HB_, (const int*)(ws + WS_TOKD), nullptr, INP(9), INP(10));
#endif
        PHASE_END(false)
        PHASE_BEGIN
#if PH_ON(20)
        REP(20)
            if (lyr == 1) p_ln<2>(F, XA_, HB_, (const int*)(ws + WS_TOKD), (float*)dout, INP(9) + 2048, INP(10) + 2048);
#endif
        PHASE_END(true)
    }
#undef PHASE_BEGIN
#undef PHASE_END
}

extern "C" void kernel_launch(void* const* d_in, const int* in_sizes, int n_in, void* d_out, int out_size, void* d_ws, size_t ws_size, hipStream_t stream) {
    static int grid = 0;
    if (grid == 0) {
        if (n_in != 35 || in_sizes[0] != T * DM || out_size != T * DM || ws_size < WS_END) { fprintf(stderr, "kernel_launch: unexpected shapes / workspace (n_in %d, ws %zu)\n", n_in, ws_size); grid = -1; return; }
        int dev = 0, cus = 0;
        if (hipGetDevice(&dev) != hipSuccess || hipDeviceGetAttribute(&cus, hipDeviceAttributeMultiprocessorCount, dev) != hipSuccess) { grid = -1; return; }
        if (hipFuncSetAttribute((const void*)fwd_kernel, hipFuncAttributeMaxDynamicSharedMemorySize, LDS_BYTES) != hipSuccess) { fprintf(stderr, "kernel_launch: hipFuncSetAttribute failed\n"); grid = -1; return; }
        int per_cu = 0;
        if (hipOccupancyMaxActiveBlocksPerMultiprocessor(&per_cu, (const void*)fwd_kernel, NWAVES * 64, LDS_BYTES) != hipSuccess || per_cu < 1) { fprintf(stderr, "kernel_launch: occupancy query says %d\n", per_cu); }
        (void)hipGetLastError();
        grid = cus > 0 ? cus : 256;
    }
    if (grid < 0) return;
    (void)hipMemsetAsync((char*)d_ws + WS_CTL, 0, CTL_ZERO_BYTES, stream);
    Args a{};
    for (int i = 0; i < 35; ++i) a.in[i] = d_in[i];
    a.out = (unsigned char*)d_out; a.ws = (unsigned char*)d_ws; a.ph_lo = 0; a.ph_hi = 1000;
    hipLaunchKernelGGL(fwd_kernel, dim3(grid), dim3(NWAVES * 64), LDS_BYTES, stream, a);
}
```
